# Optimizing an MI355X kernel written in HIP

```python
import math
import jax, jax.numpy as jnp
from jax import lax
import numpy as np


D_MODEL = 1024
BATCH = 16
SEQ = 2048
DEPTH = 4
DEC_BATCH = 8
DEC_SEQ = 2048
PAST_LEN = 128

HEAD_DIM = 64
HGRN_WIDTH = (3 * D_MODEL) // 8
HGRN_HEADS = HGRN_WIDTH // HEAD_DIM
RWKV_WIDTH = (3 * D_MODEL) // 8
RWKV_HEADS = RWKV_WIDTH // HEAD_DIM
CONV_WIDTH = D_MODEL - HGRN_WIDTH - RWKV_WIDTH
DECAY_LORA = 32
ICLR_LORA = 32
GATE_LORA = 64
CONV_KERNEL = 31
CONV_PAD = (CONV_KERNEL - 1) // 2
FFN_HIDDEN = 4 * D_MODEL
CHUNK = 32
LN_EPS = 1e-5
RMS_EPS = 1e-6
GN_EPS = 64e-5
DN_ALPHA = (2 * DEPTH) ** 0.25
DN_BETA = (8 * DEPTH) ** -0.25

N_HGRN_COLS = 5 * HGRN_WIDTH
N_RWKV_COLS = 3 * RWKV_WIDTH + 2 * DECAY_LORA + 2 * ICLR_LORA + GATE_LORA
N_CONV_COLS = 2 * CONV_WIDTH
N_IN = N_HGRN_COLS + N_RWKV_COLS + N_CONV_COLS
IN_SPLITS = (N_HGRN_COLS, N_HGRN_COLS + N_RWKV_COLS)
RWKV_SPLITS = (RWKV_WIDTH, 2 * RWKV_WIDTH, 3 * RWKV_WIDTH,
               3 * RWKV_WIDTH + 2 * DECAY_LORA,
               3 * RWKV_WIDTH + 2 * DECAY_LORA + 2 * ICLR_LORA)

kernel_name = 'hybrid_bidir_hgrn2_rwkv7_conformer_encoder'


def _layer_norm(x, g, b, eps=LN_EPS):
    xf = x.astype(jnp.float32)
    mu = jnp.mean(xf, -1, keepdims=True)
    var = jnp.mean(jnp.square(xf - mu), -1, keepdims=True)
    return ((xf - mu) * lax.rsqrt(var + eps) * g.astype(jnp.float32) + b.astype(jnp.float32)).astype(x.dtype)


def _fwd_bwd(t2):
    return jnp.stack([t2[0], jnp.flip(t2[1], axis=1)])


def _hgrn2_chunkwise(q, log_f, k, v):
    *lead, L, K = q.shape
    V = v.shape[-1]
    n = L // CHUNK
    def blk(t):
        return t.reshape(*lead, n, CHUNK, t.shape[-1])
    q, log_f, k, v = blk(q), blk(log_f), blk(k), blk(v)
    lam = jnp.cumsum(log_f, axis=-2)
    lam_end = lam[..., -1:, :]
    q_dec = q * jnp.exp(lam)
    k_inv = k * jnp.exp(-lam)
    k_end = k * jnp.exp(lam_end - lam)
    upto_t = jnp.tril(jnp.ones((CHUNK, CHUNK), dtype=bool))
    scores = jnp.where(upto_t, jnp.einsum('...tk,...sk->...ts', q_dec, k_inv), 0.0)
    o_intra = jnp.einsum('...ts,...sv->...tv', scores, v)
    d_state = jnp.einsum('...sk,...sv->...kv', k_end, v)
    block_decay = jnp.exp(lam_end[..., 0, :])

    def step(S, inp):
        dec, dS = inp
        return dec[..., None] * S + dS, S

    s0 = jnp.zeros((*lead, K, V), jnp.float32)
    _, s_in = lax.scan(step, s0, (jnp.moveaxis(block_decay, -2, 0), jnp.moveaxis(d_state, -3, 0)))
    s_in = jnp.moveaxis(s_in, 0, -3)
    o_inter = jnp.einsum('...tk,...kv->...tv', q_dec, s_in)
    return (o_intra + o_inter).reshape(*lead, L, V)


def _hgrn2_mixer(cols, lb, norm_g):
    B, L, _ = cols.shape
    q, f_fw, f_bw, inp, g = jnp.split(cols.astype(jnp.float32), 5, axis=-1)
    lb = lb.astype(jnp.float32)[:, None, None, :]
    f = lb + (1.0 - lb) * jax.nn.sigmoid(jnp.stack([f_fw, f_bw]))

    def heads(t2):
        t2 = _fwd_bwd(t2)
        return t2.reshape(2, B, L, HGRN_HEADS, HEAD_DIM).transpose(0, 1, 3, 2, 4)

    o = _hgrn2_chunkwise(heads(jnp.stack([q, q])), heads(jnp.log(f)), heads(1.0 - f),
                         heads(jnp.stack([inp, inp])))
    o = o[0] + jnp.flip(o[1], axis=2)
    o = o.transpose(0, 2, 1, 3)
    o = o * lax.rsqrt(jnp.mean(jnp.square(o), -1, keepdims=True) + RMS_EPS) \
        * norm_g.astype(jnp.float32).reshape(HGRN_HEADS, HEAD_DIM)
    return o.reshape(B, L, HGRN_WIDTH) * jax.nn.silu(g)


def _rwkv7_step(S, inp):
    r, decay, k, v, kk, a = inp
    sa = jnp.einsum('dbhvk,dbhk->dbhv', S, -kk)
    S = S * decay[..., None, :] + sa[..., None] * (kk * a)[..., None, :] + v[..., None] * k[..., None, :]
    o = jnp.einsum('dbhvk,dbhk->dbhv', S, r)
    return S, o


def _rwkv7_mixer(cols, shift_mu, w0, w_up, a0, a_up, g_up, k_k, k_a, r_k, gn_g, gn_b):
    B, L, _ = cols.shape
    H, K, W = RWKV_HEADS, HEAD_DIM, RWKV_WIDTH
    u = cols.astype(jnp.float32)
    u_prev = jnp.pad(u[:, :-1], ((0, 0), (1, 0), (0, 0)))
    u_next = jnp.pad(u[:, 1:], ((0, 0), (0, 1), (0, 0)))
    u = u + shift_mu[0] * (u_prev - u) + shift_mu[1] * (u_next - u)
    r, k, v, wd, ad, gd = jnp.split(u, list(RWKV_SPLITS), axis=-1)
    wd = jnp.tanh(wd).reshape(B, L, 2, DECAY_LORA)
    ad = ad.reshape(B, L, 2, ICLR_LORA)
    w = -jax.nn.softplus(-(w0[:, None, None, :] + jnp.einsum('bldr,drc->dblc', wd, w_up))) - 0.5
    decay = jnp.exp(-jnp.exp(w.astype(jnp.float32)))
    a = jax.nn.sigmoid((a0[:, None, None, :] + jnp.einsum('bldr,drc->dblc', ad, a_up)).astype(jnp.float32))
    g = jnp.einsum('blr,rc->blc', jax.nn.sigmoid(gd), g_up).astype(jnp.float32)
    kk = (k * k_k).reshape(B, L, H, K)
    kk = (kk / jnp.maximum(jnp.linalg.norm(kk, axis=-1, keepdims=True), 1e-12)).reshape(B, L, W)
    k_dir = (k * (1.0 + (a - 1.0) * k_a)).astype(jnp.float32)

    def seq(t2):
        t2 = _fwd_bwd(t2.astype(jnp.float32))
        return jnp.moveaxis(t2.reshape(2, B, L, H, K), 2, 0)

    def shared(t):
        return seq(jnp.stack([t, t]))

    s0 = jnp.zeros((2, B, H, K, K), jnp.float32)
    _, o = lax.scan(_rwkv7_step, s0, (shared(r), seq(decay), seq(k_dir), shared(v), shared(kk), seq(a)))
    o = jnp.moveaxis(o, 0, 2)
    o = o[0] + jnp.flip(o[1], axis=1)
    mu_o = jnp.mean(o, -1, keepdims=True)
    var_o = jnp.mean(jnp.square(o - mu_o), -1, keepdims=True)
    o = (o - mu_o) * lax.rsqrt(var_o + GN_EPS) * gn_g.reshape(H, K) + gn_b.reshape(H, K)
    rh = r.reshape(B, L, H, K)
    kh = (0.5 * (k_dir[0] + k_dir[1])).reshape(B, L, H, K)
    vh = v.reshape(B, L, H, K)
    bonus = jnp.sum(rh * kh * r_k, -1, keepdims=True) * vh
    return ((o + bonus).reshape(B, L, W) * g).astype(jnp.float32)


def _conv_mixer(cols, conv_w, conv_b, ln_g, ln_b):
    val, gate = jnp.split(cols, 2, axis=-1)
    z = val * jax.nn.sigmoid(gate)
    z = lax.conv_general_dilated(z, conv_w[:, None, :], window_strides=(1,),
                                 padding=[(CONV_PAD, CONV_PAD)],
                                 dimension_numbers=('NWC', 'WIO', 'NWC'),
                                 feature_group_count=CONV_WIDTH) + conv_b
    return jax.nn.silu(_layer_norm(z, ln_g, ln_b))


def _encode(x, ln_in_g, ln_in_b, hgrn_lb_logits, w_in, hgrn_norm_g, rwkv_shift_mu, rwkv_w0,
            rwkv_w_up, rwkv_a0, rwkv_a_up, rwkv_g_up, rwkv_k_k, rwkv_k_a, rwkv_r_k, rwkv_gn_g,
            rwkv_gn_b, conv_w, conv_b, conv_ln_g, conv_ln_b, w_out, ln1_g, ln1_b, w_ffn_up,
            w_ffn_down, ln2_g, ln2_b):
    x = _layer_norm(x, ln_in_g, ln_in_b)
    lb_all = jnp.cumsum(jax.nn.softmax(hgrn_lb_logits.astype(jnp.float32), axis=1), axis=1)[:, :DEPTH]
    for l in range(DEPTH):
        proj = jnp.einsum('bld,dn->bln', x, w_in[l])
        h_cols, r_cols, c_cols = jnp.split(proj, list(IN_SPLITS), axis=-1)
        y_h = _hgrn2_mixer(h_cols, lb_all[:, l], hgrn_norm_g[l]).astype(x.dtype)
        y_r = _rwkv7_mixer(r_cols, rwkv_shift_mu[l], rwkv_w0[l], rwkv_w_up[l], rwkv_a0[l],
                           rwkv_a_up[l], rwkv_g_up[l], rwkv_k_k[l], rwkv_k_a[l], rwkv_r_k[l],
                           rwkv_gn_g[l], rwkv_gn_b[l]).astype(x.dtype)
        y_c = _conv_mixer(c_cols, conv_w[l], conv_b[l], conv_ln_g[l], conv_ln_b[l]).astype(x.dtype)
        mix = jnp.concatenate([y_h, y_r, y_c], axis=-1)
        x = _layer_norm(DN_ALPHA * x + jnp.einsum('bld,de->ble', mix, w_out[l]), ln1_g[l], ln1_b[l])
        hid = jnp.square(jax.nn.relu(jnp.einsum('bld,df->blf', x, w_ffn_up[l])))
        x = _layer_norm(DN_ALPHA * x + jnp.einsum('blf,fd->bld', hid, w_ffn_down[l]), ln2_g[l], ln2_b[l])
    return x


def setup_inputs(seed: int = 0) -> dict:
    key = jax.random.key(seed)
    ks = jax.random.split(key, 32)
    f32 = jnp.float32
    D, W, R, C = D_MODEL, HGRN_WIDTH, RWKV_WIDTH, CONV_WIDTH

    def nrm(k, shape, scale):
        return scale * jax.random.normal(k, shape, f32)

    return {
        'x_prompt': nrm(ks[0], (BATCH, SEQ, D), 1.0),
        'x_sample': nrm(ks[1], (DEC_BATCH, DEC_SEQ, D), 1.0),
        'ln_in_g': 1.0 + nrm(ks[2], (D,), 0.02),
        'ln_in_b': nrm(ks[3], (D,), 0.02),
        'hgrn_lb_logits': nrm(ks[4], (2, DEPTH + 1, W), 0.1),
        'w_in': nrm(ks[5], (DEPTH, D, N_IN), D ** -0.5),
        'hgrn_norm_g': 1.0 + nrm(ks[6], (DEPTH, W), 0.02),
        'rwkv_shift_mu': jax.random.uniform(ks[7], (DEPTH, 2, N_RWKV_COLS), f32, 0.0, 0.5),
        'rwkv_w0': jax.random.uniform(ks[8], (DEPTH, 2, R), f32, -3.0, 1.0),
        'rwkv_w_up': nrm(ks[9], (DEPTH, 2, DECAY_LORA, R), 0.1 * DECAY_LORA ** -0.5),
        'rwkv_a0': nrm(ks[10], (DEPTH, 2, R), 0.5),
        'rwkv_a_up': nrm(ks[11], (DEPTH, 2, ICLR_LORA, R), 0.1 * ICLR_LORA ** -0.5),
        'rwkv_g_up': nrm(ks[12], (DEPTH, GATE_LORA, R), GATE_LORA ** -0.5),
        'rwkv_k_k': 0.85 + nrm(ks[13], (DEPTH, R), 0.05),
        'rwkv_k_a': 1.0 + nrm(ks[14], (DEPTH, R), 0.05),
        'rwkv_r_k': nrm(ks[15], (DEPTH, RWKV_HEADS, HEAD_DIM), 0.1),
        'rwkv_gn_g': 1.0 + nrm(ks[16], (DEPTH, R), 0.02),
        'rwkv_gn_b': nrm(ks[17], (DEPTH, R), 0.02),
        'conv_w': nrm(ks[18], (DEPTH, CONV_KERNEL, C), CONV_KERNEL ** -0.5),
        'conv_b': nrm(ks[19], (DEPTH, C), 0.02),
        'conv_ln_g': 1.0 + nrm(ks[20], (DEPTH, C), 0.02),
        'conv_ln_b': nrm(ks[21], (DEPTH, C), 0.02),
        'w_out': nrm(ks[22], (DEPTH, D, D), DN_BETA * D ** -0.5),
        'ln1_g': 1.0 + nrm(ks[23], (DEPTH, D), 0.02),
        'ln1_b': nrm(ks[24], (DEPTH, D), 0.02),
        'w_ffn_up': nrm(ks[25], (DEPTH, D, FFN_HIDDEN), DN_BETA * D ** -0.5),
        'w_ffn_down': nrm(ks[26], (DEPTH, FFN_HIDDEN, D), DN_BETA * FFN_HIDDEN ** -0.5),
        'ln2_g': 1.0 + nrm(ks[27], (DEPTH, D), 0.02),
        'ln2_b': nrm(ks[28], (DEPTH, D), 0.02),
    }


def reference(x_prompt, x_sample, ln_in_g, ln_in_b, hgrn_lb_logits, w_in, hgrn_norm_g, rwkv_shift_mu,
              rwkv_w0, rwkv_w_up, rwkv_a0, rwkv_a_up, rwkv_g_up, rwkv_k_k, rwkv_k_a, rwkv_r_k,
              rwkv_gn_g, rwkv_gn_b, conv_w, conv_b, conv_ln_g, conv_ln_b, w_out, ln1_g, ln1_b,
              w_ffn_up, w_ffn_down, ln2_g, ln2_b):
    y_prompt = _encode(x_prompt, ln_in_g, ln_in_b, hgrn_lb_logits, w_in, hgrn_norm_g, rwkv_shift_mu,
                       rwkv_w0, rwkv_w_up, rwkv_a0, rwkv_a_up, rwkv_g_up, rwkv_k_k, rwkv_k_a, rwkv_r_k,
                       rwkv_gn_g, rwkv_gn_b, conv_w, conv_b, conv_ln_g, conv_ln_b, w_out, ln1_g, ln1_b,
                       w_ffn_up, w_ffn_down, ln2_g, ln2_b)
    y_sample = _encode(x_sample, ln_in_g, ln_in_b, hgrn_lb_logits, w_in, hgrn_norm_g, rwkv_shift_mu,
                       rwkv_w0, rwkv_w_up, rwkv_a0, rwkv_a_up, rwkv_g_up, rwkv_k_k, rwkv_k_a, rwkv_r_k,
                       rwkv_gn_g, rwkv_gn_b, conv_w, conv_b, conv_ln_g, conv_ln_b, w_out, ln1_g, ln1_b,
                       w_ffn_up, w_ffn_down, ln2_g, ln2_b)
    return (y_prompt, y_sample)
```

```cpp
#include <hip/hip_runtime.h>
#include <hip/hip_cooperative_groups.h>
#include <cstdio>
#include <cstdint>
namespace cg = cooperative_groups;

#define LAS __attribute__((address_space(3)))
typedef unsigned short bf16_t;
typedef short bf16x8 __attribute__((ext_vector_type(8)));
typedef float f32x4 __attribute__((ext_vector_type(4)));
typedef unsigned u32x4 __attribute__((ext_vector_type(4)));
typedef unsigned u32x2 __attribute__((ext_vector_type(2)));

constexpr int D = 1024, SEQL = 2048, NSEQ = 24, MROWS = NSEQ * SEQL, DEPTH = 4, FFN = 4096;
constexpr int NIN = 3776, NINP = 3840, PS = 4096;
constexpr int RW = 384, NRW = 1344;
constexpr int P_YC = 0, P_Q = 256, P_I = 640, P_FF = 1024, P_FB = 1408, P_G = 1792;
constexpr int P_RW = 2176, P_R = P_RW, P_K = P_RW + 384, P_V = P_RW + 768, P_WD = P_RW + 1152, P_AD = P_RW + 1216, P_GD = P_RW + 1280;
constexpr int P_CV = 3520, P_CG = 3776;
constexpr float LN_EPS = 1e-5f, RMS_EPS = 1e-6f, GN_EPS = 64e-5f;
constexpr float DN_ALPHA = 1.681792830507429f;

constexpr size_t OFF_WIN = 0, SZ_WIN = (size_t)NINP * D * 2;
constexpr size_t OFF_WOUT = OFF_WIN + SZ_WIN, SZ_WOUT = (size_t)D * D * 2;
constexpr size_t OFF_WUP = OFF_WOUT + SZ_WOUT, SZ_WUP = (size_t)FFN * D * 2;
constexpr size_t OFF_WDN = OFF_WUP + SZ_WUP, SZ_WDN = (size_t)FFN * D * 2;
constexpr size_t OFF_PROJ = OFF_WDN + SZ_WDN, SZ_PROJ = (size_t)MROWS * PS * 2;
constexpr size_t OFF_T = OFF_PROJ + SZ_PROJ, SZ_T = (size_t)MROWS * D * 2;
constexpr size_t WS_END = OFF_T + SZ_T;
constexpr int LDS_BYTES = 131072;

struct Params {
    const float* in[29];
    float* out;
    unsigned char* ws;
};

__device__ __forceinline__ float bf2f(bf16_t b) { return __uint_as_float(((unsigned)b) << 16); }
__device__ __forceinline__ unsigned f2bf(float f) { unsigned u = __float_as_uint(f); u += 0x7FFFu + ((u >> 16) & 1u); return u >> 16; }
__device__ __forceinline__ unsigned pk2(float lo, float hi) { return f2bf(lo) | (f2bf(hi) << 16); }
__device__ __forceinline__ float wave_sum(float v) {
#pragma unroll
    for (int o = 1; o < 64; o <<= 1) v += __shfl_xor(v, o);
    return v;
}
__device__ __forceinline__ int opaque_tid() { int t = threadIdx.x; asm volatile("" : "+v"(t)); return t; }
__device__ __forceinline__ float sigmoidf_(float x) { return 1.0f / (1.0f + __expf(-x)); }
__device__ __forceinline__ float rdlane(float v, int l) { return __int_as_float(__builtin_amdgcn_readlane(__float_as_int(v), l)); }

namespace pg8 {
constexpr int BM = 256, BK = 64, HALF = 128, HTB = HALF * BK * 2, STAGE_BYTES = 8 * HTB, NXCD = 8, WGM = 8;
__device__ __forceinline__ int lds_byte(int r, int c) { const int st = (r >> 4) * 2 + (c >> 5), rr = r & 15, cc = c & 31, ob = rr * 64 + cc * 2; return st * 1024 + (ob ^ (((ob >> 9) & 1) << 5)); }
__device__ __forceinline__ void stage_rc(int b, int& R, int& C) { const int st = b / 1024, sb = b % 1024, swz = sb ^ (((sb >> 9) & 1) << 5); R = (st >> 1) * 16 + swz / 64; C = (st & 1) * 32 + (swz % 64) / 2; }
__device__ __forceinline__ int perm32(int rho) { const int n = rho >> 4, i = rho & 15; return 8 * (i >> 2) + 4 * n + (i & 3); }
struct Unit { int pm, pn; };
struct Gemm { const bf16_t* A; const bf16_t* Bt; int M, N, K, lda; };
struct StaticOrder {
    int nM, nN, nwg, G, c;
    __device__ void init(int M, int N, int G_, int c_) { nM = M / BM; nN = N / BM; nwg = nM * nN; G = G_; c = c_; }
    __device__ bool next(int i, Unit& u) const {
        const long L = (long)i * G + c; if (L >= nwg) return false;
        int wgid = (int)L; { const int q = nwg / NXCD, r = nwg % NXCD, xcd = wgid % NXCD, off = wgid / NXCD; wgid = (xcd < r ? xcd * (q + 1) : r * (q + 1) + (xcd - r) * q) + off; }
        const int nig = WGM * nN, gid = wgid / nig, fm = gid * WGM, gsz = (nM - fm) < WGM ? (nM - fm) : WGM;
        u.pm = fm + ((wgid % nig) % gsz); u.pn = (wgid % nig) / gsz; return true;
    }
};
__device__ __forceinline__ unsigned cvt_pk_bf16(float lo, float hi) { unsigned r; asm volatile("v_cvt_pk_bf16_f32 %0, %1, %2" : "=v"(r) : "v"(lo), "v"(hi)); return r; }

template <int ACT  > struct EpiBf16 {
    static constexpr bool PERM = true;
    bf16_t* O; int ldc;
    __device__ __forceinline__ void operator()(const f32x4 (&acc)[2][2][4][2], const Unit& u, int wr, int wc, int fr, int fq) const {
        const int row0 = u.pm * BM + wr * 64 + fr; const int col0 = u.pn * BM + wc * 32 + 8 * fq;
#pragma unroll
        for (int ai = 0; ai < 2; ++ai)
#pragma unroll
            for (int m = 0; m < 4; ++m) { bf16_t* rowp = O + (size_t)(row0 + ai * HALF + m * 16) * ldc + col0;
#pragma unroll
                for (int bj = 0; bj < 2; ++bj) { f32x4 v0 = acc[ai][bj][m][0], v1 = acc[ai][bj][m][1];
                    if (ACT == 1) {
#pragma unroll
                        for (int j = 0; j < 4; ++j) { float a = fmaxf(v0[j], 0.f), b = fmaxf(v1[j], 0.f); v0[j] = a * a; v1[j] = b * b; } }
                    u32x4 w; w.x = cvt_pk_bf16(v0[0], v0[1]); w.y = cvt_pk_bf16(v0[2], v0[3]); w.z = cvt_pk_bf16(v1[0], v1[1]); w.w = cvt_pk_bf16(v1[2], v1[3]);
                    *(u32x4*)(rowp + bj * HALF) = w; } }
    }
};
struct EpiResid {
    static constexpr bool PERM = false;
    float* C; int ldc; float alpha;
    __device__ __forceinline__ void operator()(const f32x4 (&acc)[2][2][4][2], const Unit& u, int wr, int wc, int fr, int fq) const {
        const int row0 = u.pm * BM + wr * 64 + fr, col0 = u.pn * BM + wc * 32 + 4 * fq;
#pragma unroll
        for (int ai = 0; ai < 2; ++ai)
#pragma unroll
            for (int m = 0; m < 4; ++m) { float* rowp = C + (size_t)(row0 + ai * HALF + m * 16) * ldc + col0;
                f32x4 old[2][2];
#pragma unroll
                for (int bj = 0; bj < 2; ++bj)
#pragma unroll
                    for (int n = 0; n < 2; ++n) old[bj][n] = *(const f32x4*)(rowp + bj * HALF + n * 16);
#pragma unroll
                for (int bj = 0; bj < 2; ++bj)
#pragma unroll
                    for (int n = 0; n < 2; ++n) *(f32x4*)(rowp + bj * HALF + n * 16) = old[bj][n] * alpha + acc[ai][bj][m][n]; }
    }
};

template <class Epi, class Sched>
__device__ __forceinline__ void gemm_phase(LAS unsigned char* lds, const Gemm g, const Sched& S, const Epi& E) {
    const int tid = opaque_tid(), wid = __builtin_amdgcn_readfirstlane(tid >> 6), lane = tid & 63, wr = wid >> 2, wc = wid & 3, fr = lane & 15, fq = lane >> 4;
    const int K = g.K, nt = K / BK, lda = g.lda;
    unsigned voffA[2], voffB[2];
#pragma unroll
    for (int i = 0; i < 2; ++i) { int R, C; stage_rc(tid * 16 + i * 8192, R, C); const int Rb = Epi::PERM ? ((R & ~31) + perm32(R & 31)) : R;
        voffA[i] = (unsigned)(R * lda + C) * 2u; voffB[i] = (unsigned)(Rb * K + C) * 2u; }
    const size_t kstep = (size_t)(BK * 2);
    const size_t hstepA = (size_t)HALF * lda * 2, hstepB = (size_t)HALF * K * 2;
    const size_t tstepA = 2 * hstepA, tstepB = 2 * hstepB;
    const unsigned ldsw = (unsigned)wid * 1024u;
    const int aoff = lds_byte(wr * 64 + fr, fq * 8), boff = lds_byte(wc * 32 + fr, fq * 8);
#define PG8_SA(b, h) (((b) * 2 + (h)) * HTB)
#define PG8_SB(b, h) ((4 + (b) * 2 + (h)) * HTB)
#define PG8_STAGE(bufoff, gbase, voff) do { _Pragma("unroll") for (int _i = 0; _i < 2; ++_i) \
        __builtin_amdgcn_global_load_lds((const unsigned*)((const char*)(gbase) + (voff)[_i]), (LAS unsigned*)(lds + (bufoff) + ldsw + _i * 8192), 16, 0, 0); } while (0)
#define PG8_LDA(dst, b, h) do { _Pragma("unroll") for (int m = 0; m < 4; ++m) _Pragma("unroll") for (int k = 0; k < 2; ++k) dst[m][k] = *(const LAS bf16x8*)(lds + PG8_SA(b, h) + aoff + m * 2048 + k * 1024); } while (0)
#define PG8_LDB(dst, b, h) do { _Pragma("unroll") for (int n = 0; n < 2; ++n) _Pragma("unroll") for (int k = 0; k < 2; ++k) dst[n][k] = *(const LAS bf16x8*)(lds + PG8_SB(b, h) + boff + n * 2048 + k * 1024); } while (0)
#define PG8_MMA(ai, bj, At, Bt) do { __builtin_amdgcn_s_setprio(1); _Pragma("unroll") for (int m = 0; m < 4; ++m) _Pragma("unroll") for (int n = 0; n < 2; ++n) _Pragma("unroll") for (int k = 0; k < 2; ++k) \
        acc[ai][bj][m][n] = __builtin_amdgcn_mfma_f32_16x16x32_bf16(Bt[n][k], At[m][k], acc[ai][bj][m][n], 0, 0, 0); __builtin_amdgcn_s_setprio(0); } while (0)
#define PG8_WAIT_V(n) asm volatile("s_waitcnt vmcnt(" #n ")" ::: "memory")
#define PG8_WAIT_L(n) asm volatile("s_waitcnt lgkmcnt(" #n ")" ::: "memory")
#define PG8_BAR __builtin_amdgcn_s_barrier()
#define PG8_SCHED __builtin_amdgcn_sched_barrier(0)
    Unit cur, nxt; int ui = 0;
    if (!S.next(0, cur)) return;
    f32x4 acc[2][2][4][2];
#pragma unroll
    for (int a = 0; a < 2; ++a)
#pragma unroll
        for (int b = 0; b < 2; ++b)
#pragma unroll
            for (int m = 0; m < 4; ++m)
#pragma unroll
                for (int n = 0; n < 2; ++n) acc[a][b][m][n] = (f32x4){0.f, 0.f, 0.f, 0.f};
    bf16x8 At[4][2], B0[2][2], B1[2][2];
    const char* cA = (const char*)g.A + (size_t)cur.pm * tstepA; const char* cB = (const char*)g.Bt + (size_t)cur.pn * tstepB;
    PG8_STAGE(PG8_SB(0, 0), cB, voffB); PG8_STAGE(PG8_SA(0, 0), cA, voffA); PG8_STAGE(PG8_SB(0, 1), cB + hstepB, voffB); PG8_STAGE(PG8_SA(0, 1), cA + hstepA, voffA);
    if (wr == 1) PG8_BAR;
    PG8_WAIT_V(4); PG8_BAR;
    PG8_STAGE(PG8_SB(1, 0), cB + kstep, voffB); PG8_STAGE(PG8_SA(1, 0), cA + kstep, voffA); PG8_STAGE(PG8_SB(1, 1), cB + hstepB + kstep, voffB);
    PG8_WAIT_V(6); PG8_BAR;
    for (;;) {
        const bool has_next = S.next(ui + 1, nxt);
        const char* nA = has_next ? (const char*)g.A + (size_t)nxt.pm * tstepA : cA; const char* nB = has_next ? (const char*)g.Bt + (size_t)nxt.pn * tstepB : cB;
        for (int t = 0; t < nt; t += 2) {
            const bool last = (t == nt - 2);
            const char* a1 = cA + (size_t)(t + 1) * kstep;
            const char* a2 = last ? nA : cA + (size_t)(t + 2) * kstep; const char* b2 = last ? nB : cB + (size_t)(t + 2) * kstep;
            const char* a3 = a2 + kstep; const char* b3 = b2 + kstep;
            PG8_LDB(B0, 0, 0); PG8_SCHED; PG8_LDA(At, 0, 0); PG8_STAGE(PG8_SA(1, 1), a1 + hstepA, voffA);
            PG8_WAIT_L(8); PG8_BAR; PG8_WAIT_L(0); PG8_MMA(0, 0, At, B0); PG8_BAR; PG8_SCHED;
            PG8_LDB(B1, 0, 1); PG8_STAGE(PG8_SB(0, 0), b2, voffB);
            PG8_BAR; PG8_WAIT_L(0); PG8_MMA(0, 1, At, B1); PG8_BAR;
            PG8_LDA(At, 0, 1); PG8_STAGE(PG8_SA(0, 0), a2, voffA);
            PG8_BAR; PG8_WAIT_L(0); PG8_MMA(1, 0, At, B0); PG8_BAR; PG8_SCHED;
            PG8_STAGE(PG8_SB(0, 1), b2 + hstepB, voffB);
            PG8_WAIT_V(6); PG8_BAR; PG8_MMA(1, 1, At, B1); PG8_BAR;
            PG8_LDB(B0, 1, 0); PG8_SCHED; PG8_LDA(At, 1, 0); PG8_STAGE(PG8_SA(0, 1), a2 + hstepA, voffA);
            PG8_WAIT_L(8); PG8_BAR; PG8_WAIT_L(0); PG8_MMA(0, 0, At, B0); PG8_BAR; PG8_SCHED;
            PG8_LDB(B1, 1, 1); PG8_STAGE(PG8_SB(1, 0), b3, voffB);
            PG8_BAR; PG8_WAIT_L(0); PG8_MMA(0, 1, At, B1); PG8_BAR;
            PG8_LDA(At, 1, 1); PG8_STAGE(PG8_SA(1, 0), a3, voffA);
            PG8_BAR; PG8_WAIT_L(0); PG8_MMA(1, 0, At, B0); PG8_BAR; PG8_SCHED;
            PG8_STAGE(PG8_SB(1, 1), b3 + hstepB, voffB);
            PG8_WAIT_V(6); PG8_BAR; PG8_MMA(1, 1, At, B1); PG8_BAR;
        }
        E(acc, cur, wr, wc, fr, fq);
        if (!has_next) break;
#pragma unroll
        for (int a = 0; a < 2; ++a)
#pragma unroll
            for (int b = 0; b < 2; ++b)
#pragma unroll
                for (int m = 0; m < 4; ++m)
#pragma unroll
                    for (int n = 0; n < 2; ++n) acc[a][b][m][n] = (f32x4){0.f, 0.f, 0.f, 0.f};
        cur = nxt; cA = nA; cB = nB; ++ui;
    }
    PG8_WAIT_V(0);
    if (wr == 0) PG8_BAR;
    PG8_BAR;
#undef PG8_SA
#undef PG8_SB
#undef PG8_STAGE
#undef PG8_LDA
#undef PG8_LDB
#undef PG8_MMA
#undef PG8_WAIT_V
#undef PG8_WAIT_L
#undef PG8_BAR
#undef PG8_SCHED
}
}

__device__ __forceinline__ void transpose_item(const float* W, int Nsrc, int ksrc0, int nsrc0, bf16_t* WT, int K, int k0, int n0, LAS float* scr, int lane) {
#pragma unroll 8
    for (int i = 0; i < 32; ++i) { const int kk = 2 * i + (lane >> 5);
        scr[kk * 33 + (lane & 31)] = nsrc0 >= 0 ? W[(size_t)(ksrc0 + kk) * Nsrc + nsrc0 + (lane & 31)] : 0.f; }
    asm volatile("s_waitcnt lgkmcnt(0)" ::: "memory");
    const int c = lane & 7;
#pragma unroll
    for (int j = 0; j < 4; ++j) { const int n = (lane >> 3) + 8 * j; const LAS float* s = scr + (8 * c) * 33 + n;
        u32x4 o; o.x = pk2(s[0 * 33], s[1 * 33]); o.y = pk2(s[2 * 33], s[3 * 33]); o.z = pk2(s[4 * 33], s[5 * 33]); o.w = pk2(s[6 * 33], s[7 * 33]);
        *(u32x4*)(WT + (size_t)(n0 + n) * K + k0 + 8 * c) = o; }
    asm volatile("s_waitcnt lgkmcnt(0)" ::: "memory");
}
__device__ __forceinline__ int win_colmap(int n0) {
    if (n0 < 384) return n0;
    if (n0 < 768) return 1152 + (n0 - 384);
    if (n0 < 1152) return 384 + (n0 - 768);
    if (n0 < 1536) return 768 + (n0 - 1152);
    if (n0 < NIN) return n0;
    return -1;
}
__device__ __forceinline__ void convert_weights(const Params& p, int l, LAS unsigned char* lds, int widx, int nw) {
    const int tid_ = opaque_tid(); const int wave = tid_ >> 6, lane = tid_ & 63;
    LAS float* scr = (LAS float*)(lds + wave * 8448);
    bf16_t* win_t = (bf16_t*)(p.ws + OFF_WIN); bf16_t* wout_t = (bf16_t*)(p.ws + OFF_WOUT); bf16_t* wup_t = (bf16_t*)(p.ws + OFF_WUP); bf16_t* wdn_t = (bf16_t*)(p.ws + OFF_WDN);
    const float* w_in = p.in[5] + (size_t)l * D * NIN; const float* w_out = p.in[22] + (size_t)l * D * D;
    const float* w_up = p.in[25] + (size_t)l * D * FFN; const float* w_dn = p.in[26] + (size_t)l * FFN * D;
    constexpr int I_IN = (D / 64) * (NINP / 32), I_OUT = (D / 64) * (D / 32), I_UP = (D / 64) * (FFN / 32), I_DN = (FFN / 64) * (D / 32);
    for (int it = widx; it < I_IN + I_OUT + I_UP + I_DN; it += nw) {
        int r = it;
        if (r < I_IN) { const int nb = NINP / 32, kb = r / nb, n0 = (r % nb) * 32; transpose_item(w_in, NIN, kb * 64, win_colmap(n0), win_t, D, kb * 64, n0, scr, lane); continue; } r -= I_IN;
        if (r < I_OUT) { const int nb = D / 32, kb = r / nb, n0 = (r % nb) * 32, k0 = kb * 64; const int ks = k0 < 256 ? 768 + k0 : k0 - 256;
            transpose_item(w_out, D, ks, n0, wout_t, D, k0, n0, scr, lane); continue; } r -= I_OUT;
        if (r < I_UP) { const int nb = FFN / 32, kb = r / nb, n0 = (r % nb) * 32; transpose_item(w_up, FFN, kb * 64, n0, wup_t, D, kb * 64, n0, scr, lane); continue; } r -= I_UP;
        { const int nb = D / 32, kb = r / nb, n0 = (r % nb) * 32; transpose_item(w_dn, D, kb * 64, n0, wdn_t, FFN, kb * 64, n0, scr, lane); }
    }
}

__device__ __forceinline__ void ln_row(const float* src, float* dst32, bf16_t* dstb, const float* g, const float* b, int lane_) {
    int lane = lane_; asm volatile("" : "+v"(lane));
    const f32x4* xr = (const f32x4*)src + lane;
    f32x4 v[4]; float s = 0.f;
#pragma unroll
    for (int j = 0; j < 4; ++j) { v[j] = xr[64 * j]; s += (v[j].x + v[j].y) + (v[j].z + v[j].w); }
    const float mean = wave_sum(s) * (1.f / D); float s2 = 0.f;
#pragma unroll
    for (int j = 0; j < 4; ++j) { v[j] = v[j] - mean; s2 += (v[j].x * v[j].x + v[j].y * v[j].y) + (v[j].z * v[j].z + v[j].w * v[j].w); }
    const float rstd = rsqrtf(wave_sum(s2) * (1.f / D) + LN_EPS);
#pragma unroll
    for (int j = 0; j < 4; ++j) {
        const f32x4 gg = ((const f32x4*)g)[lane + 64 * j], bb = ((const f32x4*)b)[lane + 64 * j];
        f32x4 o = v[j] * rstd * gg + bb;
        ((f32x4*)dst32)[lane + 64 * j] = o;
        u32x2 w; w.x = pk2(o.x, o.y); w.y = pk2(o.z, o.w);
        ((u32x2*)dstb)[lane + 64 * j] = w;
    }
}

constexpr int TC = 32;
__device__ __forceinline__ void rwkv_scan_wg(const Params& p, int l, int pairIdx, LAS unsigned char* lds) {
    const int tid = opaque_tid(), wave = tid >> 6, lane = tid & 63;
    const int b = pairIdx / 6, h = pairIdx % 6;
    LAS float* ring = (LAS float*)lds;
    const int dir = wave >> 2;
    const int c = h * 64 + lane;
    const bf16_t* proj = (const bf16_t*)(p.ws + OFF_PROJ);
    bf16_t* o_r = (bf16_t*)(p.ws + OFF_T);
    float wup[32], aup[32];
    { const float* wu = p.in[9] + (size_t)((l * 2 + dir) * 32) * RW + c; const float* au = p.in[11] + (size_t)((l * 2 + dir) * 32) * RW + c;
#pragma unroll
      for (int r = 0; r < 32; ++r) { wup[r] = wu[(size_t)r * RW]; aup[r] = au[(size_t)r * RW]; } }
    const float w0c = p.in[8][(l * 2 + dir) * RW + c], a0c = p.in[10][(l * 2 + dir) * RW + c];
    const float kkc = p.in[13][l * RW + c], kac = p.in[14][l * RW + c];
    const float* mu0 = p.in[7] + (size_t)(l * 2 + 0) * NRW; const float* mu1 = mu0 + NRW;
    const float mr0 = mu0[c], mr1 = mu1[c], mk0 = mu0[384 + c], mk1 = mu1[384 + c], mv0 = mu0[768 + c], mv1 = mu1[768 + c];
    const int lcol = lane < 32 ? 1152 + dir * 32 + lane : 1216 + dir * 32 + (lane - 32);
    const float ml0 = mu0[lcol], ml1 = mu1[lcol];
    const bool is_cons = (wave == 0) || (wave == 5);
    float S[64];
#pragma unroll
    for (int k = 0; k < 64; ++k) S[k] = 0.f;
    for (int chunk = 0; chunk < SEQL / TC; ++chunk) {
#pragma unroll 2
        for (int i = 0; i < TC / 4; ++i) {
            const int sl = (wave & 3) + 4 * i, s = chunk * TC + sl, t = dir ? SEQL - 1 - s : s;
            const bf16_t* pr = proj + ((size_t)b * SEQL + t) * PS;
            const bool hp = t > 0, hn = t < SEQL - 1;
            const bf16_t* pp = hp ? pr - PS : pr; const bf16_t* pn = hn ? pr + PS : pr;
            const float fp = hp ? 1.f : 0.f, fn = hn ? 1.f : 0.f;
            const float rc = bf2f(pr[P_R + c]), rp = fp * bf2f(pp[P_R + c]), rn = fn * bf2f(pn[P_R + c]);
            const float kc = bf2f(pr[P_K + c]), kp = fp * bf2f(pp[P_K + c]), kn = fn * bf2f(pn[P_K + c]);
            const float vc = bf2f(pr[P_V + c]), vp = fp * bf2f(pp[P_V + c]), vn = fn * bf2f(pn[P_V + c]);
            const float lc = bf2f(pr[P_RW + lcol]), lp = fp * bf2f(pp[P_RW + lcol]), ln = fn * bf2f(pn[P_RW + lcol]);
            const float rs = rc + mr0 * (rp - rc) + mr1 * (rn - rc);
            const float ks = kc + mk0 * (kp - kc) + mk1 * (kn - kc);
            const float vs = vc + mv0 * (vp - vc) + mv1 * (vn - vc);
            const float lo = lc + ml0 * (lp - lc) + ml1 * (ln - lc);
            const float e2 = __expf(2.f * lo); const float th = 1.f - 2.f / (e2 + 1.f);
            const float x = lane < 32 ? th : lo;
            float wacc0 = w0c, wacc1 = 0.f, aacc0 = a0c, aacc1 = 0.f;
#pragma unroll
            for (int r = 0; r < 32; r += 2) {
                wacc0 += rdlane(x, r) * wup[r]; wacc1 += rdlane(x, r + 1) * wup[r + 1];
                aacc0 += rdlane(x, 32 + r) * aup[r]; aacc1 += rdlane(x, 33 + r) * aup[r + 1]; }
            const float wpre = wacc0 + wacc1, apre = aacc0 + aacc1;
            const float w = -__logf(1.f + __expf(-wpre)) - 0.5f;
            const float dec = __expf(-__expf(w));
            const float a = sigmoidf_(apre);
            float kk = ks * kkc; const float n2 = wave_sum(kk * kk); kk = kk / fmaxf(sqrtf(n2), 1e-12f);
            const float kd = ks * (1.f + (a - 1.f) * kac);
            LAS float* o = ring + (size_t)((dir * TC + sl) * 6) * 64;
            o[0 * 64 + lane] = kk; o[1 * 64 + lane] = dec; o[2 * 64 + lane] = kk * a; o[3 * 64 + lane] = kd; o[4 * 64 + lane] = rs; o[5 * 64 + lane] = vs;
        }
        __syncthreads();
        if (is_cons) {
            for (int sl = 0; sl < TC; ++sl) {
                const LAS float* o = ring + (size_t)((dir * TC + sl) * 6) * 64;
                float s0 = 0.f, s1 = 0.f, s2 = 0.f, s3 = 0.f;
#pragma unroll
                for (int k4 = 0; k4 < 16; ++k4) { const f32x4 q = *(const LAS f32x4*)(o + k4 * 4);
                    s0 += S[4 * k4] * q.x; s1 += S[4 * k4 + 1] * q.y; s2 += S[4 * k4 + 2] * q.z; s3 += S[4 * k4 + 3] * q.w; }
                const float sa = -((s0 + s1) + (s2 + s3));
                const float vv = o[5 * 64 + lane];
                float o0 = 0.f, o1 = 0.f, o2 = 0.f, o3 = 0.f;
#pragma unroll
                for (int k4 = 0; k4 < 16; ++k4) {
                    const f32x4 dq = *(const LAS f32x4*)(o + 64 + k4 * 4), bq = *(const LAS f32x4*)(o + 128 + k4 * 4), kq = *(const LAS f32x4*)(o + 192 + k4 * 4), rq = *(const LAS f32x4*)(o + 256 + k4 * 4);
                    S[4 * k4] = S[4 * k4] * dq.x + (sa * bq.x + vv * kq.x); o0 += S[4 * k4] * rq.x;
                    S[4 * k4 + 1] = S[4 * k4 + 1] * dq.y + (sa * bq.y + vv * kq.y); o1 += S[4 * k4 + 1] * rq.y;
                    S[4 * k4 + 2] = S[4 * k4 + 2] * dq.z + (sa * bq.z + vv * kq.z); o2 += S[4 * k4 + 2] * rq.z;
                    S[4 * k4 + 3] = S[4 * k4 + 3] * dq.w + (sa * bq.w + vv * kq.w); o3 += S[4 * k4 + 3] * rq.w; }
                const float outv = (o0 + o1) + (o2 + o3);
                const int s = chunk * TC + sl, t = dir ? SEQL - 1 - s : s;
                o_r[((size_t)dir * MROWS + (size_t)b * SEQL + t) * RW + c] = (bf16_t)f2bf(outv);
            }
        }
        __syncthreads();
    }
}

__device__ __forceinline__ void hgrn_scan_wg(const Params& p, int l, int grp, LAS unsigned char* lds) {
    const int tid = opaque_tid(), wave = tid >> 6, lane = tid & 63;
    LAS float* ring = (LAS float*)lds;
    LAS float* lbt = (LAS float*)(lds + 3 * TC * 4 * 64 * 4);
    bf16_t* proj = (bf16_t*)(p.ws + OFF_PROJ);
    for (int i = tid; i < 2 * RW; i += 512) { const int dr = i / RW, cc = i % RW; const float* lg = p.in[4] + (size_t)dr * 5 * RW + cc;
        float e[5], mx = -1e30f; for (int j = 0; j < 5; ++j) { e[j] = lg[j * RW]; mx = fmaxf(mx, e[j]); }
        float sum = 0.f, cum = 0.f; for (int j = 0; j < 5; ++j) { e[j] = __expf(e[j] - mx); sum += e[j]; if (j <= l) cum += e[j]; }
        lbt[i] = cum / sum; }
    __syncthreads();
    const int cch = grp * 3 + (wave < 3 ? wave : 0);
    const int cdir = cch & 1, cb = (cch >> 1) / 6, chh = (cch >> 1) % 6;
    const int ocol = (cdir ? P_FB : P_FF) + chh * 64 + lane;
    float S[64];
#pragma unroll
    for (int k = 0; k < 64; ++k) S[k] = 0.f;
    for (int chunk = 0; chunk < SEQL / TC; ++chunk) {
#pragma unroll 4
        for (int i = 0; i < 3 * TC / 8; ++i) {
            const int it = wave + 8 * i, j = it / TC, sl = it % TC;
            const int ch = grp * 3 + j, dir = ch & 1, b = (ch >> 1) / 6, h = (ch >> 1) % 6;
            const int s = chunk * TC + sl, t = dir ? SEQL - 1 - s : s;
            const bf16_t* pr = proj + ((size_t)b * SEQL + t) * PS;
            const float q = bf2f(pr[P_Q + h * 64 + lane]), fr = bf2f(pr[(dir ? P_FB : P_FF) + h * 64 + lane]), iv = bf2f(pr[P_I + h * 64 + lane]);
            const float lb = lbt[dir * RW + h * 64 + lane];
            const float f = lb + (1.f - lb) * sigmoidf_(fr);
            LAS float* o = ring + (size_t)((j * TC + sl) * 4) * 64;
            o[lane] = f; o[64 + lane] = 1.f - f; o[128 + lane] = q; o[192 + lane] = iv;
        }
        __syncthreads();
        if (wave < 3) {
            for (int sl = 0; sl < TC; ++sl) {
                const LAS float* o = ring + (size_t)((wave * TC + sl) * 4) * 64;
                const float iv = o[192 + lane];
                float o0 = 0.f, o1 = 0.f, o2 = 0.f, o3 = 0.f;
#pragma unroll
                for (int k4 = 0; k4 < 16; ++k4) {
                    const f32x4 fq = *(const LAS f32x4*)(o + k4 * 4), gq = *(const LAS f32x4*)(o + 64 + k4 * 4), qq = *(const LAS f32x4*)(o + 128 + k4 * 4);
                    S[4 * k4] = S[4 * k4] * fq.x + gq.x * iv; o0 += S[4 * k4] * qq.x;
                    S[4 * k4 + 1] = S[4 * k4 + 1] * fq.y + gq.y * iv; o1 += S[4 * k4 + 1] * qq.y;
                    S[4 * k4 + 2] = S[4 * k4 + 2] * fq.z + gq.z * iv; o2 += S[4 * k4 + 2] * qq.z;
                    S[4 * k4 + 3] = S[4 * k4 + 3] * fq.w + gq.w * iv; o3 += S[4 * k4 + 3] * qq.w; }
                const float outv = (o0 + o1) + (o2 + o3);
                const int s = chunk * TC + sl, t = cdir ? SEQL - 1 - s : s;
                proj[((size_t)cb * SEQL + t) * PS + ocol] = (bf16_t)f2bf(outv);
            }
        }
        __syncthreads();
    }
}

__device__ __forceinline__ void conv_wg(const Params& p, int l, int first, int stride, LAS unsigned char* lds) {
    const int tid = opaque_tid(), wave = tid >> 6, lane = tid & 63;
    LAS float* z = (LAS float*)lds;
    LAS float* ot = (LAS float*)(lds + 62 * 256 * 4);
    bf16_t* proj = (bf16_t*)(p.ws + OFF_PROJ);
    const int ch = tid & 255, half = tid >> 8;
    float w[31];
#pragma unroll
    for (int j = 0; j < 31; ++j) w[j] = p.in[18][(size_t)(l * 31 + j) * 256 + ch];
    const float cb = p.in[19][l * 256 + ch];
    const f32x4 lg = ((const f32x4*)(p.in[20] + l * 256))[lane], lbv = ((const f32x4*)(p.in[21] + l * 256))[lane];
    for (int tile = first; tile < MROWS / 32; tile += stride) {
        const int row0 = tile * 32, b = row0 / SEQL, t0 = row0 % SEQL;
        for (int r = half; r < 62; r += 2) { const int t = t0 - 15 + r; float zz = 0.f;
            if (t >= 0 && t < SEQL) { const bf16_t* pr = proj + ((size_t)b * SEQL + t) * PS; zz = bf2f(pr[P_CV + ch]) * sigmoidf_(bf2f(pr[P_CG + ch])); }
            z[r * 256 + ch] = zz; }
        __syncthreads();
#pragma unroll 4
        for (int tt = 0; tt < 16; ++tt) { const int tok = half * 16 + tt; float acc = cb;
#pragma unroll
            for (int j = 0; j < 31; ++j) acc += w[j] * z[(tok + j) * 256 + ch];
            ot[tok * 256 + ch] = acc; }
        __syncthreads();
#pragma unroll
        for (int q = 0; q < 4; ++q) { const int tok = wave * 4 + q;
            f32x4 v = *(const LAS f32x4*)(ot + tok * 256 + lane * 4);
            const float mean = wave_sum((v.x + v.y) + (v.z + v.w)) * (1.f / 256.f);
            v = v - mean;
            const float var = wave_sum((v.x * v.x + v.y * v.y) + (v.z * v.z + v.w * v.w)) * (1.f / 256.f);
            const float rstd = rsqrtf(var + LN_EPS);
            f32x4 y = v * rstd * lg + lbv;
            y.x = y.x * sigmoidf_(y.x); y.y = y.y * sigmoidf_(y.y); y.z = y.z * sigmoidf_(y.z); y.w = y.w * sigmoidf_(y.w);
            u32x2 wv; wv.x = pk2(y.x, y.y); wv.y = pk2(y.z, y.w);
            *(u32x2*)(proj + (size_t)(row0 + tok) * PS + P_YC + lane * 4) = wv; }
        __syncthreads();
    }
}

__device__ __forceinline__ void combine_phase(const Params& p, int l, int widx, int nw) {
    const int lane = opaque_tid() & 63;
    bf16_t* proj = (bf16_t*)(p.ws + OFF_PROJ);
    const bf16_t* o_r = (const bf16_t*)(p.ws + OFF_T);
    const float* mu0 = p.in[7] + (size_t)(l * 2 + 0) * NRW; const float* mu1 = mu0 + NRW;
    const float mad0 = mu0[1216 + lane], mad1 = mu1[1216 + lane], mgd0 = mu0[1280 + lane], mgd1 = mu1[1280 + lane];
    const float* aup0 = p.in[11] + (size_t)((l * 2 + 0) * 32) * RW; const float* aup1 = p.in[11] + (size_t)((l * 2 + 1) * 32) * RW;
    const float* gup = p.in[12] + (size_t)(l * 64) * RW;
    for (int g4 = widx; g4 < MROWS / 2; g4 += nw) {
        const int row0 = g4 * 2;
        float adv[2], sgv[2];
#pragma unroll
        for (int tt = 0; tt < 2; ++tt) { const int row = row0 + tt, t = row % SEQL; const bf16_t* pr = proj + (size_t)row * PS;
            const bool hp = t > 0, hn = t < SEQL - 1; const bf16_t* pp = hp ? pr - PS : pr; const bf16_t* pn = hn ? pr + PS : pr; const float fp = hp ? 1.f : 0.f, fn = hn ? 1.f : 0.f;
            const float ac = bf2f(pr[P_AD + lane]), ap = fp * bf2f(pp[P_AD + lane]), an = fn * bf2f(pn[P_AD + lane]);
            const float gc = bf2f(pr[P_GD + lane]), gp = fp * bf2f(pp[P_GD + lane]), gn = fn * bf2f(pn[P_GD + lane]);
            adv[tt] = ac + mad0 * (ap - ac) + mad1 * (an - ac);
            sgv[tt] = sigmoidf_(gc + mgd0 * (gp - gc) + mgd1 * (gn - gc)); }
        float A0[2][6], A1[2][6], G[2][6];
#pragma unroll
        for (int tt = 0; tt < 2; ++tt)
#pragma unroll
            for (int h = 0; h < 6; ++h) { A0[tt][h] = 0.f; A1[tt][h] = 0.f; G[tt][h] = 0.f; }
#pragma unroll 2
        for (int r = 0; r < 32; ++r) {
            float w0[6], w1[6];
#pragma unroll
            for (int h = 0; h < 6; ++h) { w0[h] = aup0[(size_t)r * RW + h * 64 + lane]; w1[h] = aup1[(size_t)r * RW + h * 64 + lane]; }
#pragma unroll
            for (int tt = 0; tt < 2; ++tt) { const float s0 = rdlane(adv[tt], r), s1 = rdlane(adv[tt], 32 + r);
#pragma unroll
                for (int h = 0; h < 6; ++h) { A0[tt][h] += s0 * w0[h]; A1[tt][h] += s1 * w1[h]; } }
        }
#pragma unroll 2
        for (int r = 0; r < 64; ++r) {
            float wg[6];
#pragma unroll
            for (int h = 0; h < 6; ++h) wg[h] = gup[(size_t)r * RW + h * 64 + lane];
#pragma unroll
            for (int tt = 0; tt < 2; ++tt) { const float s = rdlane(sgv[tt], r);
#pragma unroll
                for (int h = 0; h < 6; ++h) G[tt][h] += s * wg[h]; }
        }
#pragma unroll
        for (int h = 0; h < 6; ++h) {
            const int c = h * 64 + lane;
            const float a00 = p.in[10][(l * 2 + 0) * RW + c], a01 = p.in[10][(l * 2 + 1) * RW + c], kac = p.in[14][l * RW + c];
            const float rk = p.in[15][(l * 6 + h) * 64 + lane], gng = p.in[16][l * RW + c], gnb = p.in[17][l * RW + c], ng = p.in[6][l * RW + c];
            const float mr0 = mu0[c], mr1 = mu1[c], mk0 = mu0[384 + c], mk1 = mu1[384 + c], mv0 = mu0[768 + c], mv1 = mu1[768 + c];
#pragma unroll
            for (int tt = 0; tt < 2; ++tt) { const int row = row0 + tt, t = row % SEQL; bf16_t* pr = proj + (size_t)row * PS;
                const bool hp = t > 0, hn = t < SEQL - 1; const bf16_t* pp = hp ? pr - PS : pr; const bf16_t* pn = hn ? pr + PS : pr; const float fp = hp ? 1.f : 0.f, fn = hn ? 1.f : 0.f;
                const float rc = bf2f(pr[P_R + c]), rp = fp * bf2f(pp[P_R + c]), rn = fn * bf2f(pn[P_R + c]);
                const float kc = bf2f(pr[P_K + c]), kp = fp * bf2f(pp[P_K + c]), kn = fn * bf2f(pn[P_K + c]);
                const float vc = bf2f(pr[P_V + c]), vp = fp * bf2f(pp[P_V + c]), vn = fn * bf2f(pn[P_V + c]);
                const float rs = rc + mr0 * (rp - rc) + mr1 * (rn - rc);
                const float ks = kc + mk0 * (kp - kc) + mk1 * (kn - kc);
                const float vs = vc + mv0 * (vp - vc) + mv1 * (vn - vc);
                const float a0 = sigmoidf_(a00 + A0[tt][h]), a1 = sigmoidf_(a01 + A1[tt][h]);
                const float kh = ks * (1.f + (0.5f * (a0 + a1) - 1.f) * kac);
                const float bsum = wave_sum(rs * kh * rk);
                const float o = bf2f(o_r[(size_t)row * RW + c]) + bf2f(o_r[((size_t)MROWS + row) * RW + c]);
                const float mean = wave_sum(o) * (1.f / 64.f); const float dlt = o - mean;
                const float var = wave_sum(dlt * dlt) * (1.f / 64.f);
                const float on = dlt * rsqrtf(var + GN_EPS) * gng + gnb;
                const float yr = (on + bsum * vs) * G[tt][h];
                const float oh = bf2f(pr[P_FF + c]) + bf2f(pr[P_FB + c]);
                const float ms = wave_sum(oh * oh) * (1.f / 64.f);
                const float gh = bf2f(pr[P_G + c]);
                const float yh = oh * rsqrtf(ms + RMS_EPS) * ng * (gh * sigmoidf_(gh));
                pr[P_I + c] = (bf16_t)f2bf(yr);
                pr[P_Q + c] = (bf16_t)f2bf(yh);
            }
        }
    }
}

__global__ void __launch_bounds__(512, 2) fwd_mega(Params p) {
    extern __shared__ __attribute__((aligned(16))) unsigned char smem_raw[];
    LAS unsigned char* lds = (LAS unsigned char*)smem_raw;
    cg::grid_group grid = cg::this_grid();
    const int tid = threadIdx.x, wave = tid >> 6, lane = tid & 63;
    const int G = gridDim.x, bid = blockIdx.x;
    const int widx = bid * 8 + wave, nw = G * 8;
    bf16_t* win_t = (bf16_t*)(p.ws + OFF_WIN); bf16_t* wout_t = (bf16_t*)(p.ws + OFF_WOUT); bf16_t* wup_t = (bf16_t*)(p.ws + OFF_WUP); bf16_t* wdn_t = (bf16_t*)(p.ws + OFF_WDN);
    bf16_t* proj = (bf16_t*)(p.ws + OFF_PROJ); bf16_t* xb = (bf16_t*)(p.ws + OFF_T); bf16_t* hid = proj;
    float* x = p.out;

    convert_weights(p, 0, lds, widx, nw);
    for (int row = widx; row < MROWS; row += nw) {
        const float* src = row < 16 * SEQL ? p.in[0] + (size_t)row * D : p.in[1] + (size_t)(row - 16 * SEQL) * D;
        ln_row(src, x + (size_t)row * D, xb + (size_t)row * D, p.in[2], p.in[3], lane);
    }
    grid.sync();
    for (int l = 0; l < DEPTH; ++l) {
        {
            pg8::Gemm g{xb, win_t, MROWS, NINP, D, D}; pg8::StaticOrder S; S.init(MROWS, NINP, G, bid);
            pg8::EpiBf16<0> E{proj + 256, PS};
            pg8::gemm_phase(lds, g, S, E);
        }
        grid.sync();
        if (bid < 144) rwkv_scan_wg(p, l, bid, lds);
        else if (bid < 240) hgrn_scan_wg(p, l, bid - 144, lds);
        else conv_wg(p, l, bid - 240, G - 240, lds);
        grid.sync();
        combine_phase(p, l, widx, nw);
        grid.sync();
        {
            pg8::Gemm g{proj, wout_t, MROWS, D, D, PS}; pg8::StaticOrder S; S.init(MROWS, D, G, bid);
            pg8::EpiResid E{x, D, DN_ALPHA};
            pg8::gemm_phase(lds, g, S, E);
        }
        grid.sync();
        for (int row = widx; row < MROWS; row += nw)
            ln_row(x + (size_t)row * D, x + (size_t)row * D, xb + (size_t)row * D, p.in[23] + l * D, p.in[24] + l * D, lane);
        grid.sync();
        for (int third = 0; third < 3; ++third) {
            constexpr int MT = MROWS / 3;
            {   pg8::Gemm g{xb + (size_t)third * MT * D, wup_t, MT, FFN, D, D}; pg8::StaticOrder S; S.init(MT, FFN, G, bid);
                pg8::EpiBf16<1> E{hid, FFN};
                pg8::gemm_phase(lds, g, S, E); }
            grid.sync();
            {   pg8::Gemm g{hid, wdn_t, MT, D, FFN, FFN}; pg8::StaticOrder S; S.init(MT, D, G, bid);
                pg8::EpiResid E{x + (size_t)third * MT * D, D, DN_ALPHA};
                pg8::gemm_phase(lds, g, S, E); }
            grid.sync();
        }
        if (l + 1 < DEPTH) convert_weights(p, l + 1, lds, widx, nw);
        for (int row = widx; row < MROWS; row += nw)
            ln_row(x + (size_t)row * D, x + (size_t)row * D, xb + (size_t)row * D, p.in[27] + l * D, p.in[28] + l * D, lane);
        grid.sync();
    }
}

extern "C" void kernel_launch(void* const* d_in, const int* in_sizes, int n_in, void* d_out, int out_size, void* d_ws, size_t ws_size, hipStream_t stream) {
    static int grid = 0;
    if (grid == 0) {
        if (n_in != 29 || out_size != MROWS * D || ws_size < WS_END) { fprintf(stderr, "kernel_launch: unexpected shapes (n_in %d out %d ws %zu need %zu)\n", n_in, out_size, ws_size, (size_t)WS_END); grid = -1; return; }
        int dev = 0, cus = 0, per_cu = 0;
        hipGetDevice(&dev);
        hipDeviceGetAttribute(&cus, hipDeviceAttributeMultiprocessorCount, dev);
        if (hipFuncSetAttribute((const void*)fwd_mega, hipFuncAttributeMaxDynamicSharedMemorySize, LDS_BYTES) != hipSuccess) { fprintf(stderr, "kernel_launch: hipFuncSetAttribute failed\n"); grid = -1; return; }
        hipOccupancyMaxActiveBlocksPerMultiprocessor(&per_cu, (const void*)fwd_mega, 512, LDS_BYTES);
        (void)hipGetLastError();
        if (per_cu < 1) per_cu = 1;
        grid = cus;
        if (grid != 256) fprintf(stderr, "kernel_launch: note: %d CUs\n", grid);
    }
    if (grid < 0) return;
    Params p{};
    for (int i = 0; i < 29; ++i) p.in[i] = (const float*)d_in[i];
    p.out = (float*)d_out; p.ws = (unsigned char*)d_ws;
    void* args[] = {&p};
    hipError_t e = hipLaunchCooperativeKernel((const void*)fwd_mega, dim3(grid), dim3(512), args, LDS_BYTES, stream);
    if (e != hipSuccess) fprintf(stderr, "cooperative launch failed: %s (grid %d)\n", hipGetErrorString(e), grid);
}
```

```cpp
#include <hip/hip_runtime.h>
#include <hip/hip_cooperative_groups.h>
#include <cstdio>
#include <cstdint>
namespace cg = cooperative_groups;

#define LAS __attribute__((address_space(3)))
typedef unsigned short bf16_t;
typedef short bf16x8 __attribute__((ext_vector_type(8)));
typedef float f32x4 __attribute__((ext_vector_type(4)));
typedef unsigned u32x4 __attribute__((ext_vector_type(4)));
typedef unsigned u32x2 __attribute__((ext_vector_type(2)));

constexpr int D = 1024, SEQL = 2048, NSEQ = 24, MROWS = NSEQ * SEQL, DEPTH = 4, FFN = 4096;
constexpr int NIN = 3776, NINP = 3840, PS = 4096;
constexpr int RW = 384, NRW = 1344;
constexpr int P_YC = 0, P_Q = 256, P_I = 640, P_FF = 1024, P_FB = 1408, P_G = 1792;
constexpr int P_RW = 2176, P_R = P_RW, P_K = P_RW + 384, P_V = P_RW + 768, P_WD = P_RW + 1152, P_AD = P_RW + 1216, P_GD = P_RW + 1280;
constexpr int P_CV = 3520, P_CG = 3776;
constexpr float LN_EPS = 1e-5f, RMS_EPS = 1e-6f, GN_EPS = 64e-5f;
constexpr float DN_ALPHA = 1.681792830507429f;

constexpr size_t OFF_WIN = 0, SZ_WIN = (size_t)NINP * D * 2;
constexpr size_t OFF_WOUT = OFF_WIN + SZ_WIN, SZ_WOUT = (size_t)D * D * 2;
constexpr size_t OFF_WUP = OFF_WOUT + SZ_WOUT, SZ_WUP = (size_t)FFN * D * 2;
constexpr size_t OFF_WDN = OFF_WUP + SZ_WUP, SZ_WDN = (size_t)FFN * D * 2;
constexpr size_t OFF_PROJ = OFF_WDN + SZ_WDN, SZ_PROJ = (size_t)MROWS * PS * 2;
constexpr size_t OFF_T = OFF_PROJ + SZ_PROJ, SZ_T = (size_t)MROWS * D * 2;
constexpr size_t WS_END = OFF_T + SZ_T;
constexpr int LDS_BYTES = 131072;

struct Params {
    const float* in[29];
    float* out;
    unsigned char* ws;
};

__device__ __forceinline__ float bf2f(bf16_t b) { return __uint_as_float(((unsigned)b) << 16); }
__device__ __forceinline__ unsigned f2bf(float f) { unsigned u = __float_as_uint(f); u += 0x7FFFu + ((u >> 16) & 1u); return u >> 16; }
__device__ __forceinline__ unsigned pk2(float lo, float hi) { return f2bf(lo) | (f2bf(hi) << 16); }
__device__ __forceinline__ float wave_sum(float v) {
#pragma unroll
    for (int o = 1; o < 64; o <<= 1) v += __shfl_xor(v, o);
    return v;
}
__device__ __forceinline__ int opaque_tid() { int t = threadIdx.x; asm volatile("" : "+v"(t)); return t; }
__device__ __forceinline__ float sigmoidf_(float x) { return 1.0f / (1.0f + __expf(-x)); }
__device__ __forceinline__ float rdlane(float v, int l) { return __int_as_float(__builtin_amdgcn_readlane(__float_as_int(v), l)); }

namespace pg8 {
constexpr int BM = 256, BK = 64, HALF = 128, HTB = HALF * BK * 2, STAGE_BYTES = 8 * HTB, NXCD = 8, WGM = 8;
__device__ __forceinline__ int lds_byte(int r, int c) { const int st = (r >> 4) * 2 + (c >> 5), rr = r & 15, cc = c & 31, ob = rr * 64 + cc * 2; return st * 1024 + (ob ^ (((ob >> 9) & 1) << 5)); }
__device__ __forceinline__ void stage_rc(int b, int& R, int& C) { const int st = b / 1024, sb = b % 1024, swz = sb ^ (((sb >> 9) & 1) << 5); R = (st >> 1) * 16 + swz / 64; C = (st & 1) * 32 + (swz % 64) / 2; }
__device__ __forceinline__ int perm32(int rho) { const int n = rho >> 4, i = rho & 15; return 8 * (i >> 2) + 4 * n + (i & 3); }
struct Unit { int pm, pn; };
struct Gemm { const bf16_t* A; const bf16_t* Bt; int M, N, K, lda; };
struct StaticOrder {
    int nM, nN, nwg, G, c;
    __device__ void init(int M, int N, int G_, int c_) { nM = M / BM; nN = N / BM; nwg = nM * nN; G = G_; c = c_; }
    __device__ bool next(int i, Unit& u) const {
        const long L = (long)i * G + c; if (L >= nwg) return false;
        int wgid = (int)L; { const int q = nwg / NXCD, r = nwg % NXCD, xcd = wgid % NXCD, off = wgid / NXCD; wgid = (xcd < r ? xcd * (q + 1) : r * (q + 1) + (xcd - r) * q) + off; }
        const int nig = WGM * nN, gid = wgid / nig, fm = gid * WGM, gsz = (nM - fm) < WGM ? (nM - fm) : WGM;
        u.pm = fm + ((wgid % nig) % gsz); u.pn = (wgid % nig) / gsz; return true;
    }
};
__device__ __forceinline__ unsigned cvt_pk_bf16(float lo, float hi) { unsigned r; asm volatile("v_cvt_pk_bf16_f32 %0, %1, %2" : "=v"(r) : "v"(lo), "v"(hi)); return r; }

template <int ACT  > struct EpiBf16 {
    static constexpr bool PERM = true;
    bf16_t* O; int ldc;
    __device__ __forceinline__ void operator()(const f32x4 (&acc)[2][2][4][2], const Unit& u, int wr, int wc, int fr, int fq) const {
        const int row0 = u.pm * BM + wr * 64 + fr; const int col0 = u.pn * BM + wc * 32 + 8 * fq;
#pragma unroll
        for (int ai = 0; ai < 2; ++ai)
#pragma unroll
            for (int m = 0; m < 4; ++m) { bf16_t* rowp = O + (size_t)(row0 + ai * HALF + m * 16) * ldc + col0;
#pragma unroll
                for (int bj = 0; bj < 2; ++bj) { f32x4 v0 = acc[ai][bj][m][0], v1 = acc[ai][bj][m][1];
                    if (ACT == 1) {
#pragma unroll
                        for (int j = 0; j < 4; ++j) { float a = fmaxf(v0[j], 0.f), b = fmaxf(v1[j], 0.f); v0[j] = a * a; v1[j] = b * b; } }
                    u32x4 w; w.x = cvt_pk_bf16(v0[0], v0[1]); w.y = cvt_pk_bf16(v0[2], v0[3]); w.z = cvt_pk_bf16(v1[0], v1[1]); w.w = cvt_pk_bf16(v1[2], v1[3]);
                    *(u32x4*)(rowp + bj * HALF) = w; } }
    }
};
struct EpiResid {
    static constexpr bool PERM = false;
    float* C; int ldc; float alpha;
    __device__ __forceinline__ void operator()(const f32x4 (&acc)[2][2][4][2], const Unit& u, int wr, int wc, int fr, int fq) const {
        const int row0 = u.pm * BM + wr * 64 + fr, col0 = u.pn * BM + wc * 32 + 4 * fq;
#pragma unroll
        for (int ai = 0; ai < 2; ++ai)
#pragma unroll
            for (int m = 0; m < 4; ++m) { float* rowp = C + (size_t)(row0 + ai * HALF + m * 16) * ldc + col0;
                f32x4 old[2][2];
#pragma unroll
                for (int bj = 0; bj < 2; ++bj)
#pragma unroll
                    for (int n = 0; n < 2; ++n) old[bj][n] = *(const f32x4*)(rowp + bj * HALF + n * 16);
#pragma unroll
                for (int bj = 0; bj < 2; ++bj)
#pragma unroll
                    for (int n = 0; n < 2; ++n) *(f32x4*)(rowp + bj * HALF + n * 16) = old[bj][n] * alpha + acc[ai][bj][m][n]; }
    }
};

template <class Epi, class Sched>
__device__ __forceinline__ void gemm_phase(LAS unsigned char* lds, const Gemm g, const Sched& S, const Epi& E) {
    const int tid = opaque_tid(), wid = __builtin_amdgcn_readfirstlane(tid >> 6), lane = tid & 63, wr = wid >> 2, wc = wid & 3, fr = lane & 15, fq = lane >> 4;
    const int K = g.K, nt = K / BK, lda = g.lda;
    unsigned voffA[2], voffB[2];
#pragma unroll
    for (int i = 0; i < 2; ++i) { int R, C; stage_rc(tid * 16 + i * 8192, R, C); const int Rb = Epi::PERM ? ((R & ~31) + perm32(R & 31)) : R;
        voffA[i] = (unsigned)(R * lda + C) * 2u; voffB[i] = (unsigned)(Rb * K + C) * 2u; }
    const size_t kstep = (size_t)(BK * 2);
    const size_t hstepA = (size_t)HALF * lda * 2, hstepB = (size_t)HALF * K * 2;
    const size_t tstepA = 2 * hstepA, tstepB = 2 * hstepB;
    const unsigned ldsw = (unsigned)wid * 1024u;
    const int aoff = lds_byte(wr * 64 + fr, fq * 8), boff = lds_byte(wc * 32 + fr, fq * 8);
#define PG8_SA(b, h) (((b) * 2 + (h)) * HTB)
#define PG8_SB(b, h) ((4 + (b) * 2 + (h)) * HTB)
#define PG8_STAGE(bufoff, gbase, voff) do { _Pragma("unroll") for (int _i = 0; _i < 2; ++_i) \
        __builtin_amdgcn_global_load_lds((const unsigned*)((const char*)(gbase) + (voff)[_i]), (LAS unsigned*)(lds + (bufoff) + ldsw + _i * 8192), 16, 0, 0); } while (0)
#define PG8_LDA(dst, b, h) do { _Pragma("unroll") for (int m = 0; m < 4; ++m) _Pragma("unroll") for (int k = 0; k < 2; ++k) dst[m][k] = *(const LAS bf16x8*)(lds + PG8_SA(b, h) + aoff + m * 2048 + k * 1024); } while (0)
#define PG8_LDB(dst, b, h) do { _Pragma("unroll") for (int n = 0; n < 2; ++n) _Pragma("unroll") for (int k = 0; k < 2; ++k) dst[n][k] = *(const LAS bf16x8*)(lds + PG8_SB(b, h) + boff + n * 2048 + k * 1024); } while (0)
#define PG8_MMA(ai, bj, At, Bt) do { __builtin_amdgcn_s_setprio(1); _Pragma("unroll") for (int m = 0; m < 4; ++m) _Pragma("unroll") for (int n = 0; n < 2; ++n) _Pragma("unroll") for (int k = 0; k < 2; ++k) \
        acc[ai][bj][m][n] = __builtin_amdgcn_mfma_f32_16x16x32_bf16(Bt[n][k], At[m][k], acc[ai][bj][m][n], 0, 0, 0); __builtin_amdgcn_s_setprio(0); } while (0)
#define PG8_WAIT_V(n) asm volatile("s_waitcnt vmcnt(" #n ")" ::: "memory")
#define PG8_WAIT_L(n) asm volatile("s_waitcnt lgkmcnt(" #n ")" ::: "memory")
#define PG8_BAR __builtin_amdgcn_s_barrier()
#define PG8_SCHED __builtin_amdgcn_sched_barrier(0)
    Unit cur, nxt; int ui = 0;
    if (!S.next(0, cur)) return;
    f32x4 acc[2][2][4][2];
#pragma unroll
    for (int a = 0; a < 2; ++a)
#pragma unroll
        for (int b = 0; b < 2; ++b)
#pragma unroll
            for (int m = 0; m < 4; ++m)
#pragma unroll
                for (int n = 0; n < 2; ++n) acc[a][b][m][n] = (f32x4){0.f, 0.f, 0.f, 0.f};
    bf16x8 At[4][2], B0[2][2], B1[2][2];
    const char* cA = (const char*)g.A + (size_t)cur.pm * tstepA; const char* cB = (const char*)g.Bt + (size_t)cur.pn * tstepB;
    PG8_STAGE(PG8_SB(0, 0), cB, voffB); PG8_STAGE(PG8_SA(0, 0), cA, voffA); PG8_STAGE(PG8_SB(0, 1), cB + hstepB, voffB); PG8_STAGE(PG8_SA(0, 1), cA + hstepA, voffA);
    if (wr == 1) PG8_BAR;
    PG8_WAIT_V(4); PG8_BAR;
    PG8_STAGE(PG8_SB(1, 0), cB + kstep, voffB); PG8_STAGE(PG8_SA(1, 0), cA + kstep, voffA); PG8_STAGE(PG8_SB(1, 1), cB + hstepB + kstep, voffB);
    PG8_WAIT_V(6); PG8_BAR;
    for (;;) {
        const bool has_next = S.next(ui + 1, nxt);
        const char* nA = has_next ? (const char*)g.A + (size_t)nxt.pm * tstepA : cA; const char* nB = has_next ? (const char*)g.Bt + (size_t)nxt.pn * tstepB : cB;
        for (int t = 0; t < nt; t += 2) {
            const bool last = (t == nt - 2);
            const char* a1 = cA + (size_t)(t + 1) * kstep;
            const char* a2 = last ? nA : cA + (size_t)(t + 2) * kstep; const char* b2 = last ? nB : cB + (size_t)(t + 2) * kstep;
            const char* a3 = a2 + kstep; const char* b3 = b2 + kstep;
            PG8_LDB(B0, 0, 0); PG8_SCHED; PG8_LDA(At, 0, 0); PG8_STAGE(PG8_SA(1, 1), a1 + hstepA, voffA);
            PG8_WAIT_L(8); PG8_BAR; PG8_WAIT_L(0); PG8_MMA(0, 0, At, B0); PG8_BAR; PG8_SCHED;
            PG8_LDB(B1, 0, 1); PG8_STAGE(PG8_SB(0, 0), b2, voffB);
            PG8_BAR; PG8_WAIT_L(0); PG8_MMA(0, 1, At, B1); PG8_BAR;
            PG8_LDA(At, 0, 1); PG8_STAGE(PG8_SA(0, 0), a2, voffA);
            PG8_BAR; PG8_WAIT_L(0); PG8_MMA(1, 0, At, B0); PG8_BAR; PG8_SCHED;
            PG8_STAGE(PG8_SB(0, 1), b2 + hstepB, voffB);
            PG8_WAIT_V(6); PG8_BAR; PG8_MMA(1, 1, At, B1); PG8_BAR;
            PG8_LDB(B0, 1, 0); PG8_SCHED; PG8_LDA(At, 1, 0); PG8_STAGE(PG8_SA(0, 1), a2 + hstepA, voffA);
            PG8_WAIT_L(8); PG8_BAR; PG8_WAIT_L(0); PG8_MMA(0, 0, At, B0); PG8_BAR; PG8_SCHED;
            PG8_LDB(B1, 1, 1); PG8_STAGE(PG8_SB(1, 0), b3, voffB);
            PG8_BAR; PG8_WAIT_L(0); PG8_MMA(0, 1, At, B1); PG8_BAR;
            PG8_LDA(At, 1, 1); PG8_STAGE(PG8_SA(1, 0), a3, voffA);
            PG8_BAR; PG8_WAIT_L(0); PG8_MMA(1, 0, At, B0); PG8_BAR; PG8_SCHED;
            PG8_STAGE(PG8_SB(1, 1), b3 + hstepB, voffB);
            PG8_WAIT_V(6); PG8_BAR; PG8_MMA(1, 1, At, B1); PG8_BAR;
        }
        E(acc, cur, wr, wc, fr, fq);
        if (!has_next) break;
#pragma unroll
        for (int a = 0; a < 2; ++a)
#pragma unroll
            for (int b = 0; b < 2; ++b)
#pragma unroll
                for (int m = 0; m < 4; ++m)
#pragma unroll
                    for (int n = 0; n < 2; ++n) acc[a][b][m][n] = (f32x4){0.f, 0.f, 0.f, 0.f};
        cur = nxt; cA = nA; cB = nB; ++ui;
    }
    PG8_WAIT_V(0);
    if (wr == 0) PG8_BAR;
    PG8_BAR;
#undef PG8_SA
#undef PG8_SB
#undef PG8_STAGE
#undef PG8_LDA
#undef PG8_LDB
#undef PG8_MMA
#undef PG8_WAIT_V
#undef PG8_WAIT_L
#undef PG8_BAR
#undef PG8_SCHED
}
}

__device__ __forceinline__ void transpose_item(const float* W, int Nsrc, int ksrc0, int nsrc0, bf16_t* WT, int K, int k0, int n0, LAS float* scr, int lane) {
#pragma unroll 8
    for (int i = 0; i < 32; ++i) { const int kk = 2 * i + (lane >> 5);
        scr[kk * 33 + (lane & 31)] = nsrc0 >= 0 ? W[(size_t)(ksrc0 + kk) * Nsrc + nsrc0 + (lane & 31)] : 0.f; }
    asm volatile("s_waitcnt lgkmcnt(0)" ::: "memory");
    const int c = lane & 7;
#pragma unroll
    for (int j = 0; j < 4; ++j) { const int n = (lane >> 3) + 8 * j; const LAS float* s = scr + (8 * c) * 33 + n;
        u32x4 o; o.x = pk2(s[0 * 33], s[1 * 33]); o.y = pk2(s[2 * 33], s[3 * 33]); o.z = pk2(s[4 * 33], s[5 * 33]); o.w = pk2(s[6 * 33], s[7 * 33]);
        *(u32x4*)(WT + (size_t)(n0 + n) * K + k0 + 8 * c) = o; }
    asm volatile("s_waitcnt lgkmcnt(0)" ::: "memory");
}
__device__ __forceinline__ int win_colmap(int n0) {
    if (n0 < 384) return n0;
    if (n0 < 768) return 1152 + (n0 - 384);
    if (n0 < 1152) return 384 + (n0 - 768);
    if (n0 < 1536) return 768 + (n0 - 1152);
    if (n0 < NIN) return n0;
    return -1;
}
__device__ __forceinline__ void convert_weights(const Params& p, int l, LAS unsigned char* lds, int widx, int nw) {
    const int tid_ = opaque_tid(); const int wave = tid_ >> 6, lane = tid_ & 63;
    LAS float* scr = (LAS float*)(lds + wave * 8448);
    bf16_t* win_t = (bf16_t*)(p.ws + OFF_WIN); bf16_t* wout_t = (bf16_t*)(p.ws + OFF_WOUT); bf16_t* wup_t = (bf16_t*)(p.ws + OFF_WUP); bf16_t* wdn_t = (bf16_t*)(p.ws + OFF_WDN);
    const float* w_in = p.in[5] + (size_t)l * D * NIN; const float* w_out = p.in[22] + (size_t)l * D * D;
    const float* w_up = p.in[25] + (size_t)l * D * FFN; const float* w_dn = p.in[26] + (size_t)l * FFN * D;
    constexpr int I_IN = (D / 64) * (NINP / 32), I_OUT = (D / 64) * (D / 32), I_UP = (D / 64) * (FFN / 32), I_DN = (FFN / 64) * (D / 32);
    for (int it = widx; it < I_IN + I_OUT + I_UP + I_DN; it += nw) {
        int r = it;
        if (r < I_IN) { const int nb = NINP / 32, kb = r / nb, n0 = (r % nb) * 32; transpose_item(w_in, NIN, kb * 64, win_colmap(n0), win_t, D, kb * 64, n0, scr, lane); continue; } r -= I_IN;
        if (r < I_OUT) { const int nb = D / 32, kb = r / nb, n0 = (r % nb) * 32, k0 = kb * 64; const int ks = k0 < 256 ? 768 + k0 : k0 - 256;
            transpose_item(w_out, D, ks, n0, wout_t, D, k0, n0, scr, lane); continue; } r -= I_OUT;
        if (r < I_UP) { const int nb = FFN / 32, kb = r / nb, n0 = (r % nb) * 32; transpose_item(w_up, FFN, kb * 64, n0, wup_t, D, kb * 64, n0, scr, lane); continue; } r -= I_UP;
        { const int nb = D / 32, kb = r / nb, n0 = (r % nb) * 32; transpose_item(w_dn, D, kb * 64, n0, wdn_t, FFN, kb * 64, n0, scr, lane); }
    }
}

__device__ __forceinline__ void ln_row(const float* src, float* dst32, bf16_t* dstb, const float* g, const float* b, int lane_) {
    int lane = lane_; asm volatile("" : "+v"(lane));
    const f32x4* xr = (const f32x4*)src + lane;
    f32x4 v[4]; float s = 0.f;
#pragma unroll
    for (int j = 0; j < 4; ++j) { v[j] = xr[64 * j]; s += (v[j].x + v[j].y) + (v[j].z + v[j].w); }
    const float mean = wave_sum(s) * (1.f / D); float s2 = 0.f;
#pragma unroll
    for (int j = 0; j < 4; ++j) { v[j] = v[j] - mean; s2 += (v[j].x * v[j].x + v[j].y * v[j].y) + (v[j].z * v[j].z + v[j].w * v[j].w); }
    const float rstd = rsqrtf(wave_sum(s2) * (1.f / D) + LN_EPS);
#pragma unroll
    for (int j = 0; j < 4; ++j) {
        const f32x4 gg = ((const f32x4*)g)[lane + 64 * j], bb = ((const f32x4*)b)[lane + 64 * j];
        f32x4 o = v[j] * rstd * gg + bb;
        ((f32x4*)dst32)[lane + 64 * j] = o;
        u32x2 w; w.x = pk2(o.x, o.y); w.y = pk2(o.z, o.w);
        ((u32x2*)dstb)[lane + 64 * j] = w;
    }
}

constexpr int TC = 16;
#define DSR128(dst, addr, off) asm volatile("ds_read_b128 %0, %1 offset:%2" : "=v"(dst) : "v"(addr), "n"(off))
#define DSR32(dst, addr, off) asm volatile("ds_read_b32 %0, %1 offset:%2" : "=v"(dst) : "v"(addr), "n"(off))
#define WAIT16(b) asm volatile("s_waitcnt lgkmcnt(0)" ::: "memory"); __builtin_amdgcn_sched_barrier(0)
#define WAIT16V(b, x) asm volatile("s_waitcnt lgkmcnt(0)" ::: "memory"); __builtin_amdgcn_sched_barrier(0)
#define WAIT12(b) asm volatile("s_waitcnt lgkmcnt(0)" ::: "memory"); __builtin_amdgcn_sched_barrier(0)
#define WAIT12V(b, x) asm volatile("s_waitcnt lgkmcnt(0)" ::: "memory"); __builtin_amdgcn_sched_barrier(0)
#define SCHEDB __builtin_amdgcn_sched_barrier(0)
#define RW_ISSUE_KK(BUF, base, basel, vvn) do { \
    DSR128(BUF[0], base, 0); DSR128(BUF[1], base, 16); DSR128(BUF[2], base, 32); DSR128(BUF[3], base, 48); DSR128(BUF[4], base, 64); DSR128(BUF[5], base, 80); DSR128(BUF[6], base, 96); DSR128(BUF[7], base, 112); \
    DSR128(BUF[8], base, 128); DSR128(BUF[9], base, 144); DSR128(BUF[10], base, 160); DSR128(BUF[11], base, 176); DSR128(BUF[12], base, 192); DSR128(BUF[13], base, 208); DSR128(BUF[14], base, 224); DSR128(BUF[15], base, 240); \
    DSR32(vvn, basel, 1280); } while (0)
#define RW_ISSUE_Q(BUF, base, Q) do { \
    DSR128(BUF[0], base, 256 + Q); DSR128(BUF[1], base, 256 + Q + 16); DSR128(BUF[2], base, 256 + Q + 32); DSR128(BUF[3], base, 256 + Q + 48); \
    DSR128(BUF[4], base, 512 + Q); DSR128(BUF[5], base, 512 + Q + 16); DSR128(BUF[6], base, 512 + Q + 32); DSR128(BUF[7], base, 512 + Q + 48); \
    DSR128(BUF[8], base, 768 + Q); DSR128(BUF[9], base, 768 + Q + 16); DSR128(BUF[10], base, 768 + Q + 32); DSR128(BUF[11], base, 768 + Q + 48); \
    DSR128(BUF[12], base, 1024 + Q); DSR128(BUF[13], base, 1024 + Q + 16); DSR128(BUF[14], base, 1024 + Q + 32); DSR128(BUF[15], base, 1024 + Q + 48); } while (0)
#define RW_QUARTER(BUF, J) do { _Pragma("unroll") for (int i_ = 0; i_ < 4; ++i_) { const f32x4 dq = BUF[i_], bq = BUF[4 + i_], kq = BUF[8 + i_], rq = BUF[12 + i_]; \
    f32x4 sv = S4[4 * (J) + i_]; sv = sv * dq + (sa * bq + vv * kq); S4[4 * (J) + i_] = sv; oacc += sv * rq; } } while (0)
#define RW_STEP(KB, QB, base, basel, PF, nbase, nbasel) do { \
    WAIT16V(KB, vvn); vv = vvn; RW_ISSUE_Q(QB, base, 0); SCHEDB; \
    f32x4 sacc = (f32x4){0.f, 0.f, 0.f, 0.f}; \
    _Pragma("unroll") for (int i_ = 0; i_ < 16; ++i_) sacc += S4[i_] * KB[i_]; \
    sa = -((sacc.x + sacc.y) + (sacc.z + sacc.w)); oacc = (f32x4){0.f, 0.f, 0.f, 0.f}; SCHEDB; \
    WAIT16(QB); RW_ISSUE_Q(KB, base, 64); SCHEDB; RW_QUARTER(QB, 0); SCHEDB; \
    WAIT16(KB); RW_ISSUE_Q(QB, base, 128); SCHEDB; RW_QUARTER(KB, 1); SCHEDB; \
    WAIT16(QB); RW_ISSUE_Q(KB, base, 192); SCHEDB; RW_QUARTER(QB, 2); SCHEDB; \
    WAIT16(KB); RW_ISSUE_KK(QB, nbase, nbasel, vvn); SCHEDB; RW_QUARTER(KB, 3); SCHEDB; } while (0)

__device__ __forceinline__ void rwkv_scan_wg(const Params& p, int l, int pairIdx, LAS unsigned char* lds) {
    const int tid = opaque_tid(), wave = tid >> 6, lane = tid & 63;
    const int b = pairIdx / 6, h = pairIdx % 6;
    LAS float* ring = (LAS float*)lds;
    const int dir = wave >> 2;
    const int c = h * 64 + lane;
    const bf16_t* proj = (const bf16_t*)(p.ws + OFF_PROJ);
    bf16_t* o_r = (bf16_t*)(p.ws + OFF_T);
    const bool is_cons = (wave == 0) || (wave == 5);
    constexpr int NCH = SEQL / TC;
    if (is_cons) {
        f32x4 S4[16];
#pragma unroll
        for (int k = 0; k < 16; ++k) S4[k] = (f32x4){0.f, 0.f, 0.f, 0.f};
        f32x4 A[16], B[16], oacc = (f32x4){0.f, 0.f, 0.f, 0.f}; float vv = 0.f, vvn = 0.f, sa = 0.f;
        const unsigned ring_addr = (unsigned)(unsigned long long)ring;
        bf16_t* orow = o_r + ((size_t)dir * MROWS + (size_t)b * SEQL) * RW + c;
        __syncthreads();
        for (int chunk = 0; chunk < NCH; ++chunk) {
            const unsigned cb = ring_addr + (unsigned)((((chunk & 1) * 2 + dir) * TC) * 1536);
            { const unsigned b0 = cb, bl0 = cb + lane * 4; RW_ISSUE_KK(A, b0, bl0, vvn); }
            for (int sl = 0; sl < TC; sl += 2) {
                const unsigned base0 = cb + sl * 1536, base1 = base0 + 1536, base2 = base1 + 1536;
                const unsigned bl0 = base0 + lane * 4, bl1 = base1 + lane * 4, bl2 = base2 + lane * 4;
                const int s = chunk * TC + sl;
                RW_STEP(A, B, base0, bl0, true, base1, bl1);
                { const int t = dir ? SEQL - 1 - s : s; orow[(size_t)t * RW] = (bf16_t)f2bf((oacc.x + oacc.y) + (oacc.z + oacc.w)); }
                const bool pf = sl + 2 < TC;
                RW_STEP(B, A, base1, bl1, pf, base2, bl2);
                { const int t = dir ? SEQL - 2 - s : s + 1; orow[(size_t)t * RW] = (bf16_t)f2bf((oacc.x + oacc.y) + (oacc.z + oacc.w)); }
            }
            __syncthreads();
        }
    } else {
        const int pw = dir == 0 ? wave - 1 : (wave == 4 ? 0 : wave - 5);
        float wup[32], aup[32];
        { const float* wu = p.in[9] + (size_t)((l * 2 + dir) * 32) * RW + c; const float* au = p.in[11] + (size_t)((l * 2 + dir) * 32) * RW + c;
#pragma unroll
          for (int r = 0; r < 32; ++r) { wup[r] = wu[(size_t)r * RW]; aup[r] = au[(size_t)r * RW]; } }
        const float w0c = p.in[8][(l * 2 + dir) * RW + c], a0c = p.in[10][(l * 2 + dir) * RW + c];
        const float kkc = p.in[13][l * RW + c], kac = p.in[14][l * RW + c];
        const float* mu0 = p.in[7] + (size_t)(l * 2 + 0) * NRW; const float* mu1 = mu0 + NRW;
        const float mr0 = mu0[c], mr1 = mu1[c], mk0 = mu0[384 + c], mk1 = mu1[384 + c], mv0 = mu0[768 + c], mv1 = mu1[768 + c];
        const int lcol = lane < 32 ? 1152 + dir * 32 + lane : 1216 + dir * 32 + (lane - 32);
        const float ml0 = mu0[lcol], ml1 = mu1[lcol];
        for (int chunk = 0; chunk <= NCH; ++chunk) {
            if (chunk < NCH) {
                float rs[6], ks[6], vs[6], lo[6];
#pragma unroll
                for (int i = 0; i < 6; ++i) {
                    const int sl = min(pw + 3 * i, TC - 1), s = chunk * TC + sl, t = dir ? SEQL - 1 - s : s;
                    const bf16_t* pr = proj + ((size_t)b * SEQL + t) * PS;
                    const bool hp = t > 0, hn = t < SEQL - 1;
                    const bf16_t* pp = hp ? pr - PS : pr; const bf16_t* pn = hn ? pr + PS : pr;
                    const float fp = hp ? 1.f : 0.f, fn = hn ? 1.f : 0.f;
                    const float rc = bf2f(pr[P_R + c]), rp = fp * bf2f(pp[P_R + c]), rn = fn * bf2f(pn[P_R + c]);
                    const float kc = bf2f(pr[P_K + c]), kp = fp * bf2f(pp[P_K + c]), kn = fn * bf2f(pn[P_K + c]);
                    const float vc = bf2f(pr[P_V + c]), vp = fp * bf2f(pp[P_V + c]), vn = fn * bf2f(pn[P_V + c]);
                    const float lc = bf2f(pr[P_RW + lcol]), lp = fp * bf2f(pp[P_RW + lcol]), ln = fn * bf2f(pn[P_RW + lcol]);
                    rs[i] = rc + mr0 * (rp - rc) + mr1 * (rn - rc);
                    ks[i] = kc + mk0 * (kp - kc) + mk1 * (kn - kc);
                    vs[i] = vc + mv0 * (vp - vc) + mv1 * (vn - vc);
                    lo[i] = lc + ml0 * (lp - lc) + ml1 * (ln - lc);
                }
#pragma unroll
                for (int i = 0; i < 6; ++i) {
                    const int sl = min(pw + 3 * i, TC - 1);
                    const float e2 = __expf(2.f * lo[i]); const float th = 1.f - 2.f / (e2 + 1.f);
                    const float x = lane < 32 ? th : lo[i];
                    float wacc0 = w0c, wacc1 = 0.f, aacc0 = a0c, aacc1 = 0.f;
#pragma unroll
                    for (int r = 0; r < 32; r += 2) {
                        wacc0 += rdlane(x, r) * wup[r]; wacc1 += rdlane(x, r + 1) * wup[r + 1];
                        aacc0 += rdlane(x, 32 + r) * aup[r]; aacc1 += rdlane(x, 33 + r) * aup[r + 1]; }
                    const float wpre = wacc0 + wacc1, apre = aacc0 + aacc1;
                    const float w = -__logf(1.f + __expf(-wpre)) - 0.5f;
                    const float dec = __expf(-__expf(w));
                    const float a = sigmoidf_(apre);
                    float kk = ks[i] * kkc; const float n2 = wave_sum(kk * kk); kk = kk / fmaxf(sqrtf(n2), 1e-12f);
                    const float kd = ks[i] * (1.f + (a - 1.f) * kac);
                    LAS float* o = ring + (size_t)((((chunk & 1) * 2 + dir) * TC + sl) * 6) * 64;
                    o[0 * 64 + lane] = kk; o[1 * 64 + lane] = dec; o[2 * 64 + lane] = kk * a; o[3 * 64 + lane] = kd; o[4 * 64 + lane] = rs[i]; o[5 * 64 + lane] = vs[i];
                }
            }
            __syncthreads();
        }
    }
}

#define HG_ISSUE_Q(BUF, base, Q) do { \
    DSR128(BUF[0], base, Q); DSR128(BUF[1], base, Q + 16); DSR128(BUF[2], base, Q + 32); DSR128(BUF[3], base, Q + 48); \
    DSR128(BUF[4], base, 256 + Q); DSR128(BUF[5], base, 256 + Q + 16); DSR128(BUF[6], base, 256 + Q + 32); DSR128(BUF[7], base, 256 + Q + 48); \
    DSR128(BUF[8], base, 512 + Q); DSR128(BUF[9], base, 512 + Q + 16); DSR128(BUF[10], base, 512 + Q + 32); DSR128(BUF[11], base, 512 + Q + 48); } while (0)
#define HG_QUARTER(BUF, J) do { _Pragma("unroll") for (int i_ = 0; i_ < 4; ++i_) { const f32x4 fq = BUF[i_], gq = BUF[4 + i_], qq = BUF[8 + i_]; \
    f32x4 sv = S4[4 * (J) + i_]; sv = sv * fq + gq * iv; S4[4 * (J) + i_] = sv; oacc += sv * qq; } } while (0)

__device__ __forceinline__ void hgrn_scan_wg(const Params& p, int l, int grp, LAS unsigned char* lds) {
    const int tid = opaque_tid(), wave = tid >> 6, lane = tid & 63;
    LAS float* ring = (LAS float*)lds;
    LAS float* lbt = (LAS float*)(lds + 2 * 3 * TC * 4 * 64 * 4);
    bf16_t* proj = (bf16_t*)(p.ws + OFF_PROJ);
    constexpr int NCH = SEQL / TC;
    for (int i = tid; i < 2 * RW; i += 512) { const int dr = i / RW, cc = i % RW; const float* lg = p.in[4] + (size_t)dr * 5 * RW + cc;
        float e[5], mx = -1e30f;
#pragma unroll
        for (int j = 0; j < 5; ++j) { e[j] = lg[j * RW]; mx = fmaxf(mx, e[j]); }
        float sum = 0.f, cum = 0.f;
#pragma unroll
        for (int j = 0; j < 5; ++j) { e[j] = __expf(e[j] - mx); sum += e[j]; if (j <= l) cum += e[j]; }
        lbt[i] = cum / sum; }
    __syncthreads();
    if (wave < 3) {
        const int cch = grp * 3 + wave;
        const int cdir = cch & 1, cb = (cch >> 1) / 6, chh = (cch >> 1) % 6;
        bf16_t* orow = proj + (size_t)cb * SEQL * PS + (cdir ? P_FB : P_FF) + chh * 64 + lane;
        f32x4 S4[16];
#pragma unroll
        for (int k = 0; k < 16; ++k) S4[k] = (f32x4){0.f, 0.f, 0.f, 0.f};
        f32x4 A[12], B[12], oacc = (f32x4){0.f, 0.f, 0.f, 0.f}; float iv = 0.f, ivn = 0.f;
        const unsigned ring_addr = (unsigned)(unsigned long long)ring;
        __syncthreads();
        for (int chunk = 0; chunk < NCH; ++chunk) {
            const unsigned cbase = ring_addr + (unsigned)((((chunk & 1) * 3 + wave) * TC) * 1024);
            { const unsigned bl0 = cbase + lane * 4; HG_ISSUE_Q(A, cbase, 0); DSR32(ivn, bl0, 768); }
            for (int sl = 0; sl < TC; ++sl) {
                const unsigned base = cbase + sl * 1024, nbase = base + 1024, nbl = nbase + lane * 4;
                WAIT12V(A, ivn); iv = ivn; HG_ISSUE_Q(B, base, 64); SCHEDB; oacc = (f32x4){0.f, 0.f, 0.f, 0.f}; HG_QUARTER(A, 0); SCHEDB;
                WAIT12(B); HG_ISSUE_Q(A, base, 128); SCHEDB; HG_QUARTER(B, 1); SCHEDB;
                WAIT12(A); HG_ISSUE_Q(B, base, 192); SCHEDB; HG_QUARTER(A, 2); SCHEDB;
                WAIT12(B); HG_ISSUE_Q(A, nbase, 0); DSR32(ivn, nbl, 768); SCHEDB; HG_QUARTER(B, 3); SCHEDB;
                const int s = chunk * TC + sl, t = cdir ? SEQL - 1 - s : s;
                orow[(size_t)t * PS] = (bf16_t)f2bf((oacc.x + oacc.y) + (oacc.z + oacc.w));
            }
            __syncthreads();
        }
    } else {
        const int pwi = wave - 3;
        for (int chunk = 0; chunk <= NCH; ++chunk) {
            if (chunk < NCH) {
#pragma unroll 5
                for (int i = 0; i < 10; ++i) {
                    const int it = min(pwi + 5 * i, 3 * TC - 1), j = it / TC, sl = it % TC;
                    const int ch = grp * 3 + j, dir = ch & 1, b = (ch >> 1) / 6, h = (ch >> 1) % 6;
                    const int s = chunk * TC + sl, t = dir ? SEQL - 1 - s : s;
                    const bf16_t* pr = proj + ((size_t)b * SEQL + t) * PS;
                    const float q = bf2f(pr[P_Q + h * 64 + lane]), fr = bf2f(pr[(dir ? P_FB : P_FF) + h * 64 + lane]), ivv = bf2f(pr[P_I + h * 64 + lane]);
                    const float lb = lbt[dir * RW + h * 64 + lane];
                    const float f = lb + (1.f - lb) * sigmoidf_(fr);
                    LAS float* o = ring + (size_t)((((chunk & 1) * 3 + j) * TC + sl) * 4) * 64;
                    o[lane] = f; o[64 + lane] = 1.f - f; o[128 + lane] = q; o[192 + lane] = ivv;
                }
            }
            __syncthreads();
        }
    }
}

__device__ __forceinline__ void conv_wg(const Params& p, int l, int first, int stride, LAS unsigned char* lds) {
    const int tid = opaque_tid(), wave = tid >> 6, lane = tid & 63;
    LAS float* z = (LAS float*)lds;
    LAS float* ot = (LAS float*)(lds + 62 * 256 * 4);
    bf16_t* proj = (bf16_t*)(p.ws + OFF_PROJ);
    const int ch = tid & 255, half = tid >> 8;
    float w[31];
#pragma unroll
    for (int j = 0; j < 31; ++j) w[j] = p.in[18][(size_t)(l * 31 + j) * 256 + ch];
    const float cb = p.in[19][l * 256 + ch];
    const f32x4 lg = ((const f32x4*)(p.in[20] + l * 256))[lane], lbv = ((const f32x4*)(p.in[21] + l * 256))[lane];
    for (int tile = first; tile < MROWS / 32; tile += stride) {
        const int row0 = tile * 32, b = row0 / SEQL, t0 = row0 % SEQL;
        for (int r = half; r < 62; r += 2) { const int t = t0 - 15 + r; float zz = 0.f;
            if (t >= 0 && t < SEQL) { const bf16_t* pr = proj + ((size_t)b * SEQL + t) * PS; zz = bf2f(pr[P_CV + ch]) * sigmoidf_(bf2f(pr[P_CG + ch])); }
            z[r * 256 + ch] = zz; }
        __syncthreads();
#pragma unroll 4
        for (int tt = 0; tt < 16; ++tt) { const int tok = half * 16 + tt; float acc = cb;
#pragma unroll
            for (int j = 0; j < 31; ++j) acc += w[j] * z[(tok + j) * 256 + ch];
            ot[tok * 256 + ch] = acc; }
        __syncthreads();
#pragma unroll
        for (int q = 0; q < 4; ++q) { const int tok = wave * 4 + q;
            f32x4 v = *(const LAS f32x4*)(ot + tok * 256 + lane * 4);
            const float mean = wave_sum((v.x + v.y) + (v.z + v.w)) * (1.f / 256.f);
            v = v - mean;
            const float var = wave_sum((v.x * v.x + v.y * v.y) + (v.z * v.z + v.w * v.w)) * (1.f / 256.f);
            const float rstd = rsqrtf(var + LN_EPS);
            f32x4 y = v * rstd * lg + lbv;
            y.x = y.x * sigmoidf_(y.x); y.y = y.y * sigmoidf_(y.y); y.z = y.z * sigmoidf_(y.z); y.w = y.w * sigmoidf_(y.w);
            u32x2 wv; wv.x = pk2(y.x, y.y); wv.y = pk2(y.z, y.w);
            *(u32x2*)(proj + (size_t)(row0 + tok) * PS + P_YC + lane * 4) = wv; }
        __syncthreads();
    }
}

__device__ __forceinline__ void combine_phase(const Params& p, int l, int widx, int nw) {
    const int lane = opaque_tid() & 63;
    bf16_t* proj = (bf16_t*)(p.ws + OFF_PROJ);
    const bf16_t* o_r = (const bf16_t*)(p.ws + OFF_T);
    const float* mu0 = p.in[7] + (size_t)(l * 2 + 0) * NRW; const float* mu1 = mu0 + NRW;
    const float mad0 = mu0[1216 + lane], mad1 = mu1[1216 + lane], mgd0 = mu0[1280 + lane], mgd1 = mu1[1280 + lane];
    const float* aup0 = p.in[11] + (size_t)((l * 2 + 0) * 32) * RW; const float* aup1 = p.in[11] + (size_t)((l * 2 + 1) * 32) * RW;
    const float* gup = p.in[12] + (size_t)(l * 64) * RW;
    for (int g4 = widx; g4 < MROWS / 2; g4 += nw) {
        const int row0 = g4 * 2;
        float adv[2], sgv[2];
#pragma unroll
        for (int tt = 0; tt < 2; ++tt) { const int row = row0 + tt, t = row % SEQL; const bf16_t* pr = proj + (size_t)row * PS;
            const bool hp = t > 0, hn = t < SEQL - 1; const bf16_t* pp = hp ? pr - PS : pr; const bf16_t* pn = hn ? pr + PS : pr; const float fp = hp ? 1.f : 0.f, fn = hn ? 1.f : 0.f;
            const float ac = bf2f(pr[P_AD + lane]), ap = fp * bf2f(pp[P_AD + lane]), an = fn * bf2f(pn[P_AD + lane]);
            const float gc = bf2f(pr[P_GD + lane]), gp = fp * bf2f(pp[P_GD + lane]), gn = fn * bf2f(pn[P_GD + lane]);
            adv[tt] = ac + mad0 * (ap - ac) + mad1 * (an - ac);
            sgv[tt] = sigmoidf_(gc + mgd0 * (gp - gc) + mgd1 * (gn - gc)); }
        float A0[2][6], A1[2][6], G[2][6];
#pragma unroll
        for (int tt = 0; tt < 2; ++tt)
#pragma unroll
            for (int h = 0; h < 6; ++h) { A0[tt][h] = 0.f; A1[tt][h] = 0.f; G[tt][h] = 0.f; }
#pragma unroll 2
        for (int r = 0; r < 32; ++r) {
            float w0[6], w1[6];
#pragma unroll
            for (int h = 0; h < 6; ++h) { w0[h] = aup0[(size_t)r * RW + h * 64 + lane]; w1[h] = aup1[(size_t)r * RW + h * 64 + lane]; }
#pragma unroll
            for (int tt = 0; tt < 2; ++tt) { const float s0 = rdlane(adv[tt], r), s1 = rdlane(adv[tt], 32 + r);
#pragma unroll
                for (int h = 0; h < 6; ++h) { A0[tt][h] += s0 * w0[h]; A1[tt][h] += s1 * w1[h]; } }
        }
#pragma unroll 2
        for (int r = 0; r < 64; ++r) {
            float wg[6];
#pragma unroll
            for (int h = 0; h < 6; ++h) wg[h] = gup[(size_t)r * RW + h * 64 + lane];
#pragma unroll
            for (int tt = 0; tt < 2; ++tt) { const float s = rdlane(sgv[tt], r);
#pragma unroll
                for (int h = 0; h < 6; ++h) G[tt][h] += s * wg[h]; }
        }
#pragma unroll
        for (int h = 0; h < 6; ++h) {
            const int c = h * 64 + lane;
            const float a00 = p.in[10][(l * 2 + 0) * RW + c], a01 = p.in[10][(l * 2 + 1) * RW + c], kac = p.in[14][l * RW + c];
            const float rk = p.in[15][(l * 6 + h) * 64 + lane], gng = p.in[16][l * RW + c], gnb = p.in[17][l * RW + c], ng = p.in[6][l * RW + c];
            const float mr0 = mu0[c], mr1 = mu1[c], mk0 = mu0[384 + c], mk1 = mu1[384 + c], mv0 = mu0[768 + c], mv1 = mu1[768 + c];
#pragma unroll
            for (int tt = 0; tt < 2; ++tt) { const int row = row0 + tt, t = row % SEQL; bf16_t* pr = proj + (size_t)row * PS;
                const bool hp = t > 0, hn = t < SEQL - 1; const bf16_t* pp = hp ? pr - PS : pr; const bf16_t* pn = hn ? pr + PS : pr; const float fp = hp ? 1.f : 0.f, fn = hn ? 1.f : 0.f;
                const float rc = bf2f(pr[P_R + c]), rp = fp * bf2f(pp[P_R + c]), rn = fn * bf2f(pn[P_R + c]);
                const float kc = bf2f(pr[P_K + c]), kp = fp * bf2f(pp[P_K + c]), kn = fn * bf2f(pn[P_K + c]);
                const float vc = bf2f(pr[P_V + c]), vp = fp * bf2f(pp[P_V + c]), vn = fn * bf2f(pn[P_V + c]);
                const float rs = rc + mr0 * (rp - rc) + mr1 * (rn - rc);
                const float ks = kc + mk0 * (kp - kc) + mk1 * (kn - kc);
                const float vs = vc + mv0 * (vp - vc) + mv1 * (vn - vc);
                const float a0 = sigmoidf_(a00 + A0[tt][h]), a1 = sigmoidf_(a01 + A1[tt][h]);
                const float kh = ks * (1.f + (0.5f * (a0 + a1) - 1.f) * kac);
                const float bsum = wave_sum(rs * kh * rk);
                const float o = bf2f(o_r[(size_t)row * RW + c]) + bf2f(o_r[((size_t)MROWS + row) * RW + c]);
                const float mean = wave_sum(o) * (1.f / 64.f); const float dlt = o - mean;
                const float var = wave_sum(dlt * dlt) * (1.f / 64.f);
                const float on = dlt * rsqrtf(var + GN_EPS) * gng + gnb;
                const float yr = (on + bsum * vs) * G[tt][h];
                const float oh = bf2f(pr[P_FF + c]) + bf2f(pr[P_FB + c]);
                const float ms = wave_sum(oh * oh) * (1.f / 64.f);
                const float gh = bf2f(pr[P_G + c]);
                const float yh = oh * rsqrtf(ms + RMS_EPS) * ng * (gh * sigmoidf_(gh));
                pr[P_I + c] = (bf16_t)f2bf(yr);
                pr[P_Q + c] = (bf16_t)f2bf(yh);
            }
        }
    }
}

__global__ void __launch_bounds__(512, 2) fwd_mega(Params p) {
    extern __shared__ __attribute__((aligned(16))) unsigned char smem_raw[];
    LAS unsigned char* lds = (LAS unsigned char*)smem_raw;
    cg::grid_group grid = cg::this_grid();
    const int tid = threadIdx.x, wave = tid >> 6, lane = tid & 63;
    const int G = gridDim.x, bid = blockIdx.x;
    const int widx = bid * 8 + wave, nw = G * 8;
    bf16_t* win_t = (bf16_t*)(p.ws + OFF_WIN); bf16_t* wout_t = (bf16_t*)(p.ws + OFF_WOUT); bf16_t* wup_t = (bf16_t*)(p.ws + OFF_WUP); bf16_t* wdn_t = (bf16_t*)(p.ws + OFF_WDN);
    bf16_t* proj = (bf16_t*)(p.ws + OFF_PROJ); bf16_t* xb = (bf16_t*)(p.ws + OFF_T); bf16_t* hid = proj;
    float* x = p.out;

    convert_weights(p, 0, lds, widx, nw);
    for (int row = widx; row < MROWS; row += nw) {
        const float* src = row < 16 * SEQL ? p.in[0] + (size_t)row * D : p.in[1] + (size_t)(row - 16 * SEQL) * D;
        ln_row(src, x + (size_t)row * D, xb + (size_t)row * D, p.in[2], p.in[3], lane);
    }
    grid.sync();
    for (int l = 0; l < DEPTH; ++l) {
        {
            pg8::Gemm g{xb, win_t, MROWS, NINP, D, D}; pg8::StaticOrder S; S.init(MROWS, NINP, G, bid);
            pg8::EpiBf16<0> E{proj + 256, PS};
            pg8::gemm_phase(lds, g, S, E);
        }
        grid.sync();
        if (bid < 144) rwkv_scan_wg(p, l, bid, lds);
        else if (bid < 240) hgrn_scan_wg(p, l, bid - 144, lds);
        else conv_wg(p, l, bid - 240, G - 240, lds);
        grid.sync();
        combine_phase(p, l, widx, nw);
        grid.sync();
        {
            pg8::Gemm g{proj, wout_t, MROWS, D, D, PS}; pg8::StaticOrder S; S.init(MROWS, D, G, bid);
            pg8::EpiResid E{x, D, DN_ALPHA};
            pg8::gemm_phase(lds, g, S, E);
        }
        grid.sync();
        for (int row = widx; row < MROWS; row += nw)
            ln_row(x + (size_t)row * D, x + (size_t)row * D, xb + (size_t)row * D, p.in[23] + l * D, p.in[24] + l * D, lane);
        grid.sync();
        for (int third = 0; third < 3; ++third) {
            constexpr int MT = MROWS / 3;
            {   pg8::Gemm g{xb + (size_t)third * MT * D, wup_t, MT, FFN, D, D}; pg8::StaticOrder S; S.init(MT, FFN, G, bid);
                pg8::EpiBf16<1> E{hid, FFN};
                pg8::gemm_phase(lds, g, S, E); }
            grid.sync();
            {   pg8::Gemm g{hid, wdn_t, MT, D, FFN, FFN}; pg8::StaticOrder S; S.init(MT, D, G, bid);
                pg8::EpiResid E{x + (size_t)third * MT * D, D, DN_ALPHA};
                pg8::gemm_phase(lds, g, S, E); }
            grid.sync();
        }
        if (l + 1 < DEPTH) convert_weights(p, l + 1, lds, widx, nw);
        for (int row = widx; row < MROWS; row += nw)
            ln_row(x + (size_t)row * D, x + (size_t)row * D, xb + (size_t)row * D, p.in[27] + l * D, p.in[28] + l * D, lane);
        grid.sync();
    }
}

extern "C" void kernel_launch(void* const* d_in, const int* in_sizes, int n_in, void* d_out, int out_size, void* d_ws, size_t ws_size, hipStream_t stream) {
    static int grid = 0;
    if (grid == 0) {
        if (n_in != 29 || out_size != MROWS * D || ws_size < WS_END) { fprintf(stderr, "kernel_launch: unexpected shapes (n_in %d out %d ws %zu need %zu)\n", n_in, out_size, ws_size, (size_t)WS_END); grid = -1; return; }
        int dev = 0, cus = 0, per_cu = 0;
        hipGetDevice(&dev);
        hipDeviceGetAttribute(&cus, hipDeviceAttributeMultiprocessorCount, dev);
        if (hipFuncSetAttribute((const void*)fwd_mega, hipFuncAttributeMaxDynamicSharedMemorySize, LDS_BYTES) != hipSuccess) { fprintf(stderr, "kernel_launch: hipFuncSetAttribute failed\n"); grid = -1; return; }
        hipOccupancyMaxActiveBlocksPerMultiprocessor(&per_cu, (const void*)fwd_mega, 512, LDS_BYTES);
        (void)hipGetLastError();
        if (per_cu < 1) per_cu = 1;
        grid = cus;
        if (grid != 256) fprintf(stderr, "kernel_launch: note: %d CUs\n", grid);
    }
    if (grid < 0) return;
    Params p{};
    for (int i = 0; i < 29; ++i) p.in[i] = (const float*)d_in[i];
    p.out = (float*)d_out; p.ws = (unsigned char*)d_ws;
    void* args[] = {&p};
    hipError_t e = hipLaunchCooperativeKernel((const void*)fwd_mega, dim3(grid), dim3(512), args, LDS_BYTES, stream);
    if (e != hipSuccess) fprintf(stderr, "cooperative launch failed: %s (grid %d)\n", hipGetErrorString(e), grid);
}
```

```cpp
#include <hip/hip_runtime.h>
#include <hip/hip_cooperative_groups.h>
#include <cstdio>
#include <cstdint>
namespace cg = cooperative_groups;

#define LAS __attribute__((address_space(3)))
typedef unsigned short bf16_t;
typedef short bf16x8 __attribute__((ext_vector_type(8)));
typedef float f32x4 __attribute__((ext_vector_type(4)));
typedef unsigned u32x4 __attribute__((ext_vector_type(4)));
typedef unsigned u32x2 __attribute__((ext_vector_type(2)));

constexpr int D = 1024, SEQL = 2048, NSEQ = 24, MROWS = NSEQ * SEQL, DEPTH = 4, FFN = 4096;
constexpr int NIN = 3776, NINP = 3840, PS = 4096;
constexpr int RW = 384, NRW = 1344;
constexpr int P_YC = 0, P_Q = 256, P_I = 640, P_FF = 1024, P_FB = 1408, P_G = 1792;
constexpr int P_RW = 2176, P_R = P_RW, P_K = P_RW + 384, P_V = P_RW + 768, P_WD = P_RW + 1152, P_AD = P_RW + 1216, P_GD = P_RW + 1280;
constexpr int P_CV = 3520, P_CG = 3776;
constexpr float LN_EPS = 1e-5f, RMS_EPS = 1e-6f, GN_EPS = 64e-5f;
constexpr float DN_ALPHA = 1.681792830507429f;

constexpr size_t OFF_WIN = 0, SZ_WIN = (size_t)NINP * D * 2;
constexpr size_t OFF_WOUT = OFF_WIN + SZ_WIN, SZ_WOUT = (size_t)D * D * 2;
constexpr size_t OFF_WUP = OFF_WOUT + SZ_WOUT, SZ_WUP = (size_t)FFN * D * 2;
constexpr size_t OFF_WDN = OFF_WUP + SZ_WUP, SZ_WDN = (size_t)FFN * D * 2;
constexpr size_t OFF_PROJ = OFF_WDN + SZ_WDN, SZ_PROJ = (size_t)MROWS * PS * 2;
constexpr size_t OFF_T = OFF_PROJ + SZ_PROJ, SZ_T = (size_t)MROWS * D * 2;
constexpr size_t WS_END = OFF_T + SZ_T;
constexpr int LDS_BYTES = 131072;
#define REP_SCAN 1
#define REP_COMB 1
#define REP_GIN 1
#define REP_UP 1
#define REP_SYNC 1
#define GSYNC() do { for (int r_ = 0; r_ < REP_SYNC; ++r_) grid.sync(); } while (0)

struct Params {
    const float* in[29];
    float* out;
    unsigned char* ws;
};

__device__ __forceinline__ float bf2f(bf16_t b) { return __uint_as_float(((unsigned)b) << 16); }
__device__ __forceinline__ unsigned f2bf(float f) { unsigned u = __float_as_uint(f); u += 0x7FFFu + ((u >> 16) & 1u); return u >> 16; }
__device__ __forceinline__ unsigned pk2(float lo, float hi) { return f2bf(lo) | (f2bf(hi) << 16); }
__device__ __forceinline__ float dpp_add(float v, const int ctrl_sel) {
    int r;
    switch (ctrl_sel) {
        case 0: r = __builtin_amdgcn_update_dpp(0, __float_as_int(v), 0xB1, 0xF, 0xF, true); break;
        case 1: r = __builtin_amdgcn_update_dpp(0, __float_as_int(v), 0x4E, 0xF, 0xF, true); break;
        case 2: r = __builtin_amdgcn_update_dpp(0, __float_as_int(v), 0x141, 0xF, 0xF, true); break;
        default: r = __builtin_amdgcn_update_dpp(0, __float_as_int(v), 0x140, 0xF, 0xF, true); break;
    }
    return v + __int_as_float(r);
}
__device__ __forceinline__ float wave_sum(float v) {
    v = dpp_add(v, 0); v = dpp_add(v, 1); v = dpp_add(v, 2); v = dpp_add(v, 3);
    { auto r = __builtin_amdgcn_permlane16_swap(__float_as_uint(v), __float_as_uint(v), false, false); v = __uint_as_float(r[0]) + __uint_as_float(r[1]); }
    { auto r = __builtin_amdgcn_permlane32_swap(__float_as_uint(v), __float_as_uint(v), false, false); v = __uint_as_float(r[0]) + __uint_as_float(r[1]); }
    return v;
}
__device__ __forceinline__ int opaque_tid() { int t = threadIdx.x; asm volatile("" : "+v"(t)); return t; }
__device__ __forceinline__ float sigmoidf_(float x) { return 1.0f / (1.0f + __expf(-x)); }
__device__ __forceinline__ float rdlane(float v, int l) { return __int_as_float(__builtin_amdgcn_readlane(__float_as_int(v), l)); }

namespace pg8 {
constexpr int BM = 256, BK = 64, HALF = 128, HTB = HALF * BK * 2, STAGE_BYTES = 8 * HTB, NXCD = 8, WGM = 8;
__device__ __forceinline__ int lds_byte(int r, int c) { const int st = (r >> 4) * 2 + (c >> 5), rr = r & 15, cc = c & 31, ob = rr * 64 + cc * 2; return st * 1024 + (ob ^ (((ob >> 9) & 1) << 5)); }
__device__ __forceinline__ void stage_rc(int b, int& R, int& C) { const int st = b / 1024, sb = b % 1024, swz = sb ^ (((sb >> 9) & 1) << 5); R = (st >> 1) * 16 + swz / 64; C = (st & 1) * 32 + (swz % 64) / 2; }
__device__ __forceinline__ int perm32(int rho) { const int n = rho >> 4, i = rho & 15; return 8 * (i >> 2) + 4 * n + (i & 3); }
struct Unit { int pm, pn; };
struct Gemm { const bf16_t* A; const bf16_t* Bt; int M, N, K, lda; };
struct StaticOrder {
    int nM, nN, nwg, G, c;
    __device__ void init(int M, int N, int G_, int c_) { nM = M / BM; nN = N / BM; nwg = nM * nN; G = G_; c = c_; }
    __device__ bool next(int i, Unit& u) const {
        const long L = (long)i * G + c; if (L >= nwg) return false;
        int wgid = (int)L; { const int q = nwg / NXCD, r = nwg % NXCD, xcd = wgid % NXCD, off = wgid / NXCD; wgid = (xcd < r ? xcd * (q + 1) : r * (q + 1) + (xcd - r) * q) + off; }
        const int nig = WGM * nN, gid = wgid / nig, fm = gid * WGM, gsz = (nM - fm) < WGM ? (nM - fm) : WGM;
        u.pm = fm + ((wgid % nig) % gsz); u.pn = (wgid % nig) / gsz; return true;
    }
};
__device__ __forceinline__ unsigned cvt_pk_bf16(float lo, float hi) { unsigned r; asm volatile("v_cvt_pk_bf16_f32 %0, %1, %2" : "=v"(r) : "v"(lo), "v"(hi)); return r; }

template <int ACT  > struct EpiBf16 {
    static constexpr bool PERM = true;
    bf16_t* O; int ldc;
    __device__ __forceinline__ void operator()(const f32x4 (&acc)[2][2][4][2], const Unit& u, int wr, int wc, int fr, int fq) const {
        const int row0 = u.pm * BM + wr * 64 + fr; const int col0 = u.pn * BM + wc * 32 + 8 * fq;
#pragma unroll
        for (int ai = 0; ai < 2; ++ai)
#pragma unroll
            for (int m = 0; m < 4; ++m) { bf16_t* rowp = O + (size_t)(row0 + ai * HALF + m * 16) * ldc + col0;
#pragma unroll
                for (int bj = 0; bj < 2; ++bj) { f32x4 v0 = acc[ai][bj][m][0], v1 = acc[ai][bj][m][1];
                    if (ACT == 1) {
#pragma unroll
                        for (int j = 0; j < 4; ++j) { float a = fmaxf(v0[j], 0.f), b = fmaxf(v1[j], 0.f); v0[j] = a * a; v1[j] = b * b; } }
                    u32x4 w; w.x = cvt_pk_bf16(v0[0], v0[1]); w.y = cvt_pk_bf16(v0[2], v0[3]); w.z = cvt_pk_bf16(v1[0], v1[1]); w.w = cvt_pk_bf16(v1[2], v1[3]);
                    *(u32x4*)(rowp + bj * HALF) = w; } }
    }
};
struct EpiResid {
    static constexpr bool PERM = false;
    float* C; int ldc; float alpha;
    __device__ __forceinline__ void operator()(const f32x4 (&acc)[2][2][4][2], const Unit& u, int wr, int wc, int fr, int fq) const {
        const int row0 = u.pm * BM + wr * 64 + fr, col0 = u.pn * BM + wc * 32 + 4 * fq;
#pragma unroll
        for (int ai = 0; ai < 2; ++ai)
#pragma unroll
            for (int m = 0; m < 4; ++m) { float* rowp = C + (size_t)(row0 + ai * HALF + m * 16) * ldc + col0;
                f32x4 old[2][2];
#pragma unroll
                for (int bj = 0; bj < 2; ++bj)
#pragma unroll
                    for (int n = 0; n < 2; ++n) old[bj][n] = *(const f32x4*)(rowp + bj * HALF + n * 16);
#pragma unroll
                for (int bj = 0; bj < 2; ++bj)
#pragma unroll
                    for (int n = 0; n < 2; ++n) *(f32x4*)(rowp + bj * HALF + n * 16) = old[bj][n] * alpha + acc[ai][bj][m][n]; }
    }
};

template <class Epi, class Sched>
__device__ __forceinline__ void gemm_phase(LAS unsigned char* lds, const Gemm g, const Sched& S, const Epi& E) {
    const int tid = opaque_tid(), wid = __builtin_amdgcn_readfirstlane(tid >> 6), lane = tid & 63, wr = wid >> 2, wc = wid & 3, fr = lane & 15, fq = lane >> 4;
    const int K = g.K, nt = K / BK, lda = g.lda;
    unsigned voffA[2], voffB[2];
#pragma unroll
    for (int i = 0; i < 2; ++i) { int R, C; stage_rc(tid * 16 + i * 8192, R, C); const int Rb = Epi::PERM ? ((R & ~31) + perm32(R & 31)) : R;
        voffA[i] = (unsigned)(R * lda + C) * 2u; voffB[i] = (unsigned)(Rb * K + C) * 2u; }
    const size_t kstep = (size_t)(BK * 2);
    const size_t hstepA = (size_t)HALF * lda * 2, hstepB = (size_t)HALF * K * 2;
    const size_t tstepA = 2 * hstepA, tstepB = 2 * hstepB;
    const unsigned ldsw = (unsigned)wid * 1024u;
    const int aoff = lds_byte(wr * 64 + fr, fq * 8), boff = lds_byte(wc * 32 + fr, fq * 8);
#define PG8_SA(b, h) (((b) * 2 + (h)) * HTB)
#define PG8_SB(b, h) ((4 + (b) * 2 + (h)) * HTB)
#define PG8_STAGE(bufoff, gbase, voff) do { _Pragma("unroll") for (int _i = 0; _i < 2; ++_i) \
        __builtin_amdgcn_global_load_lds((const unsigned*)((const char*)(gbase) + (voff)[_i]), (LAS unsigned*)(lds + (bufoff) + ldsw + _i * 8192), 16, 0, 0); } while (0)
#define PG8_LDA(dst, b, h) do { _Pragma("unroll") for (int m = 0; m < 4; ++m) _Pragma("unroll") for (int k = 0; k < 2; ++k) dst[m][k] = *(const LAS bf16x8*)(lds + PG8_SA(b, h) + aoff + m * 2048 + k * 1024); } while (0)
#define PG8_LDB(dst, b, h) do { _Pragma("unroll") for (int n = 0; n < 2; ++n) _Pragma("unroll") for (int k = 0; k < 2; ++k) dst[n][k] = *(const LAS bf16x8*)(lds + PG8_SB(b, h) + boff + n * 2048 + k * 1024); } while (0)
#define PG8_MMA(ai, bj, At, Bt) do { __builtin_amdgcn_s_setprio(1); _Pragma("unroll") for (int m = 0; m < 4; ++m) _Pragma("unroll") for (int n = 0; n < 2; ++n) _Pragma("unroll") for (int k = 0; k < 2; ++k) \
        acc[ai][bj][m][n] = __builtin_amdgcn_mfma_f32_16x16x32_bf16(Bt[n][k], At[m][k], acc[ai][bj][m][n], 0, 0, 0); __builtin_amdgcn_s_setprio(0); } while (0)
#define PG8_WAIT_V(n) asm volatile("s_waitcnt vmcnt(" #n ")" ::: "memory")
#define PG8_WAIT_L(n) asm volatile("s_waitcnt lgkmcnt(" #n ")" ::: "memory")
#define PG8_BAR __builtin_amdgcn_s_barrier()
#define PG8_SCHED __builtin_amdgcn_sched_barrier(0)
    Unit cur, nxt; int ui = 0;
    if (!S.next(0, cur)) return;
    f32x4 acc[2][2][4][2];
#pragma unroll
    for (int a = 0; a < 2; ++a)
#pragma unroll
        for (int b = 0; b < 2; ++b)
#pragma unroll
            for (int m = 0; m < 4; ++m)
#pragma unroll
                for (int n = 0; n < 2; ++n) acc[a][b][m][n] = (f32x4){0.f, 0.f, 0.f, 0.f};
    bf16x8 At[4][2], B0[2][2], B1[2][2];
    const char* cA = (const char*)g.A + (size_t)cur.pm * tstepA; const char* cB = (const char*)g.Bt + (size_t)cur.pn * tstepB;
    PG8_STAGE(PG8_SB(0, 0), cB, voffB); PG8_STAGE(PG8_SA(0, 0), cA, voffA); PG8_STAGE(PG8_SB(0, 1), cB + hstepB, voffB); PG8_STAGE(PG8_SA(0, 1), cA + hstepA, voffA);
    if (wr == 1) PG8_BAR;
    PG8_WAIT_V(4); PG8_BAR;
    PG8_STAGE(PG8_SB(1, 0), cB + kstep, voffB); PG8_STAGE(PG8_SA(1, 0), cA + kstep, voffA); PG8_STAGE(PG8_SB(1, 1), cB + hstepB + kstep, voffB);
    PG8_WAIT_V(6); PG8_BAR;
    for (;;) {
        const bool has_next = S.next(ui + 1, nxt);
        const char* nA = has_next ? (const char*)g.A + (size_t)nxt.pm * tstepA : cA; const char* nB = has_next ? (const char*)g.Bt + (size_t)nxt.pn * tstepB : cB;
        for (int t = 0; t < nt; t += 2) {
            const bool last = (t == nt - 2);
            const char* a1 = cA + (size_t)(t + 1) * kstep;
            const char* a2 = last ? nA : cA + (size_t)(t + 2) * kstep; const char* b2 = last ? nB : cB + (size_t)(t + 2) * kstep;
            const char* a3 = a2 + kstep; const char* b3 = b2 + kstep;
            PG8_LDB(B0, 0, 0); PG8_SCHED; PG8_LDA(At, 0, 0); PG8_STAGE(PG8_SA(1, 1), a1 + hstepA, voffA);
            PG8_WAIT_L(8); PG8_BAR; PG8_WAIT_L(0); PG8_MMA(0, 0, At, B0); PG8_BAR; PG8_SCHED;
            PG8_LDB(B1, 0, 1); PG8_STAGE(PG8_SB(0, 0), b2, voffB);
            PG8_BAR; PG8_WAIT_L(0); PG8_MMA(0, 1, At, B1); PG8_BAR;
            PG8_LDA(At, 0, 1); PG8_STAGE(PG8_SA(0, 0), a2, voffA);
            PG8_BAR; PG8_WAIT_L(0); PG8_MMA(1, 0, At, B0); PG8_BAR; PG8_SCHED;
            PG8_STAGE(PG8_SB(0, 1), b2 + hstepB, voffB);
            PG8_WAIT_V(6); PG8_BAR; PG8_MMA(1, 1, At, B1); PG8_BAR;
            PG8_LDB(B0, 1, 0); PG8_SCHED; PG8_LDA(At, 1, 0); PG8_STAGE(PG8_SA(0, 1), a2 + hstepA, voffA);
            PG8_WAIT_L(8); PG8_BAR; PG8_WAIT_L(0); PG8_MMA(0, 0, At, B0); PG8_BAR; PG8_SCHED;
            PG8_LDB(B1, 1, 1); PG8_STAGE(PG8_SB(1, 0), b3, voffB);
            PG8_BAR; PG8_WAIT_L(0); PG8_MMA(0, 1, At, B1); PG8_BAR;
            PG8_LDA(At, 1, 1); PG8_STAGE(PG8_SA(1, 0), a3, voffA);
            PG8_BAR; PG8_WAIT_L(0); PG8_MMA(1, 0, At, B0); PG8_BAR; PG8_SCHED;
            PG8_STAGE(PG8_SB(1, 1), b3 + hstepB, voffB);
            PG8_WAIT_V(6); PG8_BAR; PG8_MMA(1, 1, At, B1); PG8_BAR;
        }
        E(acc, cur, wr, wc, fr, fq);
        if (!has_next) break;
#pragma unroll
        for (int a = 0; a < 2; ++a)
#pragma unroll
            for (int b = 0; b < 2; ++b)
#pragma unroll
                for (int m = 0; m < 4; ++m)
#pragma unroll
                    for (int n = 0; n < 2; ++n) acc[a][b][m][n] = (f32x4){0.f, 0.f, 0.f, 0.f};
        cur = nxt; cA = nA; cB = nB; ++ui;
    }
    PG8_WAIT_V(0);
    if (wr == 0) PG8_BAR;
    PG8_BAR;
#undef PG8_SA
#undef PG8_SB
#undef PG8_STAGE
#undef PG8_LDA
#undef PG8_LDB
#undef PG8_MMA
#undef PG8_WAIT_V
#undef PG8_WAIT_L
#undef PG8_BAR
#undef PG8_SCHED
}
}

__device__ __forceinline__ void transpose_item(const float* W, int Nsrc, int ksrc0, int nsrc0, bf16_t* WT, int K, int k0, int n0, LAS float* scr, int lane) {
#pragma unroll 8
    for (int i = 0; i < 32; ++i) { const int kk = 2 * i + (lane >> 5);
        scr[kk * 33 + (lane & 31)] = nsrc0 >= 0 ? W[(size_t)(ksrc0 + kk) * Nsrc + nsrc0 + (lane & 31)] : 0.f; }
    asm volatile("s_waitcnt lgkmcnt(0)" ::: "memory");
    const int c = lane & 7;
#pragma unroll
    for (int j = 0; j < 4; ++j) { const int n = (lane >> 3) + 8 * j; const LAS float* s = scr + (8 * c) * 33 + n;
        u32x4 o; o.x = pk2(s[0 * 33], s[1 * 33]); o.y = pk2(s[2 * 33], s[3 * 33]); o.z = pk2(s[4 * 33], s[5 * 33]); o.w = pk2(s[6 * 33], s[7 * 33]);
        *(u32x4*)(WT + (size_t)(n0 + n) * K + k0 + 8 * c) = o; }
    asm volatile("s_waitcnt lgkmcnt(0)" ::: "memory");
}
__device__ __forceinline__ int win_colmap(int n0) {
    if (n0 < 384) return n0;
    if (n0 < 768) return 1152 + (n0 - 384);
    if (n0 < 1152) return 384 + (n0 - 768);
    if (n0 < 1536) return 768 + (n0 - 1152);
    if (n0 < NIN) return n0;
    return -1;
}
__device__ __forceinline__ void convert_weights(const Params& p, int l, LAS unsigned char* lds, int widx, int nw) {
    const int tid_ = opaque_tid(); const int wave = tid_ >> 6, lane = tid_ & 63;
    LAS float* scr = (LAS float*)(lds + wave * 8448);
    bf16_t* win_t = (bf16_t*)(p.ws + OFF_WIN); bf16_t* wout_t = (bf16_t*)(p.ws + OFF_WOUT); bf16_t* wup_t = (bf16_t*)(p.ws + OFF_WUP); bf16_t* wdn_t = (bf16_t*)(p.ws + OFF_WDN);
    const float* w_in = p.in[5] + (size_t)l * D * NIN; const float* w_out = p.in[22] + (size_t)l * D * D;
    const float* w_up = p.in[25] + (size_t)l * D * FFN; const float* w_dn = p.in[26] + (size_t)l * FFN * D;
    constexpr int I_IN = (D / 64) * (NINP / 32), I_OUT = (D / 64) * (D / 32), I_UP = (D / 64) * (FFN / 32), I_DN = (FFN / 64) * (D / 32);
    for (int it = widx; it < I_IN + I_OUT + I_UP + I_DN; it += nw) {
        int r = it;
        if (r < I_IN) { const int nb = NINP / 32, kb = r / nb, n0 = (r % nb) * 32; transpose_item(w_in, NIN, kb * 64, win_colmap(n0), win_t, D, kb * 64, n0, scr, lane); continue; } r -= I_IN;
        if (r < I_OUT) { const int nb = D / 32, kb = r / nb, n0 = (r % nb) * 32, k0 = kb * 64; const int ks = k0 < 256 ? 768 + k0 : k0 - 256;
            transpose_item(w_out, D, ks, n0, wout_t, D, k0, n0, scr, lane); continue; } r -= I_OUT;
        if (r < I_UP) { const int nb = FFN / 32, kb = r / nb, n0 = (r % nb) * 32; transpose_item(w_up, FFN, kb * 64, n0, wup_t, D, kb * 64, n0, scr, lane); continue; } r -= I_UP;
        { const int nb = D / 32, kb = r / nb, n0 = (r % nb) * 32; transpose_item(w_dn, D, kb * 64, n0, wdn_t, FFN, kb * 64, n0, scr, lane); }
    }
}

__device__ __forceinline__ void ln_row(const float* src, float* dst32, bf16_t* dstb, const float* g, const float* b, int lane_) {
    int lane = lane_; asm volatile("" : "+v"(lane));
    const f32x4* xr = (const f32x4*)src + lane;
    f32x4 v[4]; float s = 0.f;
#pragma unroll
    for (int j = 0; j < 4; ++j) { v[j] = xr[64 * j]; s += (v[j].x + v[j].y) + (v[j].z + v[j].w); }
    const float mean = wave_sum(s) * (1.f / D); float s2 = 0.f;
#pragma unroll
    for (int j = 0; j < 4; ++j) { v[j] = v[j] - mean; s2 += (v[j].x * v[j].x + v[j].y * v[j].y) + (v[j].z * v[j].z + v[j].w * v[j].w); }
    const float rstd = rsqrtf(wave_sum(s2) * (1.f / D) + LN_EPS);
#pragma unroll
    for (int j = 0; j < 4; ++j) {
        const f32x4 gg = ((const f32x4*)g)[lane + 64 * j], bb = ((const f32x4*)b)[lane + 64 * j];
        f32x4 o = v[j] * rstd * gg + bb;
        ((f32x4*)dst32)[lane + 64 * j] = o;
        u32x2 w; w.x = pk2(o.x, o.y); w.y = pk2(o.z, o.w);
        ((u32x2*)dstb)[lane + 64 * j] = w;
    }
}

#define DSR128(dst, addr, off) asm volatile("ds_read_b128 %0, %1 offset:%2" : "=v"(dst) : "v"(addr), "n"(off))
#define DSR32(dst, addr, off) asm volatile("ds_read_b32 %0, %1 offset:%2" : "=v"(dst) : "v"(addr), "n"(off))
#define LGKM0() do { asm volatile("s_waitcnt lgkmcnt(0)" ::: "memory"); __builtin_amdgcn_sched_barrier(0); } while (0)
#define SCHEDB __builtin_amdgcn_sched_barrier(0)
__device__ __forceinline__ float xsum32(float x) { auto r = __builtin_amdgcn_permlane32_swap(__float_as_uint(x), __float_as_uint(x), false, false); return __uint_as_float(r[0]) + __uint_as_float(r[1]); }
__device__ __forceinline__ float xsum16(float x) { auto r = __builtin_amdgcn_permlane16_swap(__float_as_uint(x), __float_as_uint(x), false, false); return __uint_as_float(r[0]) + __uint_as_float(r[1]); }

constexpr int RTC = 32;
#define RW_ISSUE(BUF, bk, bv, vvn) do { \
    DSR128(BUF[0], bk, 0); DSR128(BUF[1], bk, 16); DSR128(BUF[2], bk, 32); DSR128(BUF[3], bk, 48); \
    DSR128(BUF[4], bk, 256); DSR128(BUF[5], bk, 272); DSR128(BUF[6], bk, 288); DSR128(BUF[7], bk, 304); \
    DSR128(BUF[8], bk, 512); DSR128(BUF[9], bk, 528); DSR128(BUF[10], bk, 544); DSR128(BUF[11], bk, 560); \
    DSR128(BUF[12], bk, 768); DSR128(BUF[13], bk, 784); DSR128(BUF[14], bk, 800); DSR128(BUF[15], bk, 816); \
    DSR128(BUF[16], bk, 1024); DSR128(BUF[17], bk, 1040); DSR128(BUF[18], bk, 1056); DSR128(BUF[19], bk, 1072); \
    DSR32(vvn, bv, 1280); } while (0)
#define RW_COMPUTE(BUF) do { \
    f32x4 sacc = S4[0] * BUF[0] + S4[1] * BUF[1]; sacc += S4[2] * BUF[2] + S4[3] * BUF[3]; \
    const float sa = -xsum16(xsum32((sacc.x + sacc.y) + (sacc.z + sacc.w))); \
    f32x4 oacc = (f32x4){0.f, 0.f, 0.f, 0.f}; \
    _Pragma("unroll") for (int i_ = 0; i_ < 4; ++i_) { f32x4 sv = S4[i_] * BUF[4 + i_] + (sa * BUF[8 + i_] + vv * BUF[12 + i_]); S4[i_] = sv; oacc += sv * BUF[16 + i_]; } \
    oval = xsum16(xsum32((oacc.x + oacc.y) + (oacc.z + oacc.w))); } while (0)

__device__ __forceinline__ void rwkv_scan_wg(const Params& p, int l, int pairIdx, LAS unsigned char* lds) {
    const int tid = opaque_tid(), wave = tid >> 6, lane = tid & 63;
    const int b = pairIdx / 6, h = pairIdx % 6;
    LAS float* ring = (LAS float*)lds;
    const int dir = wave >> 2, rq = wave & 3;
    const int c = h * 64 + lane;
    const bf16_t* proj = (const bf16_t*)(p.ws + OFF_PROJ);
    bf16_t* o_r = (bf16_t*)(p.ws + OFF_T);
    constexpr int NCH = SEQL / RTC;
    const int kp = lane >> 4, row = lane & 15, v0 = rq * 16 + row;
    f32x4 S4[4];
#pragma unroll
    for (int k = 0; k < 4; ++k) S4[k] = (f32x4){0.f, 0.f, 0.f, 0.f};
    f32x4 A[20], B[20]; float vv = 0.f, vvn = 0.f, oval = 0.f;
    const unsigned ring_addr = (unsigned)(unsigned long long)ring + (unsigned)(dir * RTC * 1536);
    const unsigned offk = ring_addr + kp * 64, offv = ring_addr + v0 * 4;
    bf16_t* orow = o_r + ((size_t)dir * MROWS + (size_t)b * SEQL) * RW + h * 64 + v0;
    const float w0c = p.in[8][(l * 2 + dir) * RW + c], a0c = p.in[10][(l * 2 + dir) * RW + c];
    const float kkc = p.in[13][l * RW + c], kac = p.in[14][l * RW + c];
    const float* mu0 = p.in[7] + (size_t)(l * 2 + 0) * NRW; const float* mu1 = mu0 + NRW;
    const float mr0 = mu0[c], mr1 = mu1[c], mk0 = mu0[384 + c], mk1 = mu1[384 + c], mv0 = mu0[768 + c], mv1 = mu1[768 + c];
    const int lcol = lane < 32 ? 1152 + dir * 32 + lane : 1216 + dir * 32 + (lane - 32);
    const float ml0 = mu0[lcol], ml1 = mu1[lcol];
    for (int chunk = 0; chunk < NCH; ++chunk) {
        {
            const int s0 = chunk * RTC + rq * 8;
            const int tlo = dir ? SEQL - 8 - s0 : s0;
            float rr[10], rk_[10], rv[10], rl[10];
#pragma unroll
            for (int q = 0; q < 10; ++q) {
                const int tr = tlo - 1 + q; const bool ok = (tr >= 0) && (tr < SEQL);
                const bf16_t* pr = proj + ((size_t)b * SEQL + (ok ? tr : 0)) * PS; const float m = ok ? 1.f : 0.f;
                rr[q] = m * bf2f(pr[P_R + c]); rk_[q] = m * bf2f(pr[P_K + c]); rv[q] = m * bf2f(pr[P_V + c]); rl[q] = m * bf2f(pr[P_RW + lcol]);
            }
            float rs[8], ks[8], vs[8], lo[8];
#pragma unroll
            for (int i = 0; i < 8; ++i) {
                const float rc = dir ? rr[8 - i] : rr[i + 1], rp = dir ? rr[7 - i] : rr[i], rn = dir ? rr[9 - i] : rr[i + 2];
                const float kc = dir ? rk_[8 - i] : rk_[i + 1], kp_ = dir ? rk_[7 - i] : rk_[i], kn = dir ? rk_[9 - i] : rk_[i + 2];
                const float vc = dir ? rv[8 - i] : rv[i + 1], vp = dir ? rv[7 - i] : rv[i], vn = dir ? rv[9 - i] : rv[i + 2];
                const float lc = dir ? rl[8 - i] : rl[i + 1], lp = dir ? rl[7 - i] : rl[i], ln = dir ? rl[9 - i] : rl[i + 2];
                rs[i] = rc + mr0 * (rp - rc) + mr1 * (rn - rc);
                ks[i] = kc + mk0 * (kp_ - kc) + mk1 * (kn - kc);
                vs[i] = vc + mv0 * (vp - vc) + mv1 * (vn - vc);
                lo[i] = lc + ml0 * (lp - lc) + ml1 * (ln - lc);
            }
            int zoff = 0; asm volatile("" : "+s"(zoff));
            float wup[32], aup[32];
            { const float* wu = p.in[9] + (size_t)((l * 2 + dir) * 32) * RW + c + zoff; const float* au = p.in[11] + (size_t)((l * 2 + dir) * 32) * RW + c + zoff;
#pragma unroll
              for (int r = 0; r < 32; ++r) { wup[r] = wu[(size_t)r * RW]; aup[r] = au[(size_t)r * RW]; } }
#pragma unroll
            for (int i = 0; i < 8; ++i) {
                const int sl = rq * 8 + i;
                const float e2 = __expf(2.f * lo[i]); const float th = 1.f - 2.f / (e2 + 1.f);
                const float x = lane < 32 ? th : lo[i];
                float wacc0 = w0c, wacc1 = 0.f, aacc0 = a0c, aacc1 = 0.f;
#pragma unroll
                for (int r = 0; r < 32; r += 2) {
                    wacc0 += rdlane(x, r) * wup[r]; wacc1 += rdlane(x, r + 1) * wup[r + 1];
                    aacc0 += rdlane(x, 32 + r) * aup[r]; aacc1 += rdlane(x, 33 + r) * aup[r + 1]; }
                const float wpre = wacc0 + wacc1, apre = aacc0 + aacc1;
                const float w = -__logf(1.f + __expf(-wpre)) - 0.5f;
                const float dec = __expf(-__expf(w));
                const float a = sigmoidf_(apre);
                float kk = ks[i] * kkc; const float n2 = wave_sum(kk * kk); kk = kk / fmaxf(sqrtf(n2), 1e-12f);
                const float kd = ks[i] * (1.f + (a - 1.f) * kac);
                LAS float* o = ring + (size_t)((dir * RTC + sl) * 6) * 64;
                o[0 * 64 + lane] = kk; o[1 * 64 + lane] = dec; o[2 * 64 + lane] = kk * a; o[3 * 64 + lane] = kd; o[4 * 64 + lane] = rs[i]; o[5 * 64 + lane] = vs[i];
            }
        }
        __syncthreads();
        {
            RW_ISSUE(A, offk, offv, vvn);
#pragma unroll 1
            for (int sl = 0; sl < RTC; sl += 2) {
                const unsigned bk1 = offk + (sl + 1) * 1536, bv1 = offv + (sl + 1) * 1536, bk2 = bk1 + 1536, bv2 = bv1 + 1536;
                const int s = chunk * RTC + sl;
                LGKM0(); vv = vvn; RW_ISSUE(B, bk1, bv1, vvn); SCHEDB; RW_COMPUTE(A); SCHEDB;
                if (kp == 0) { const int t = dir ? SEQL - 1 - s : s; orow[(size_t)t * RW] = (bf16_t)f2bf(oval); }
                LGKM0(); vv = vvn; RW_ISSUE(A, bk2, bv2, vvn); SCHEDB; RW_COMPUTE(B); SCHEDB;
                if (kp == 0) { const int t = dir ? SEQL - 2 - s : s + 1; orow[(size_t)t * RW] = (bf16_t)f2bf(oval); }
            }
            LGKM0();
        }
        __syncthreads();
    }
}

constexpr int TC = 16;
#define HG_ISSUE(BUF, bk, Q) do { \
    DSR128(BUF[0], bk, Q); DSR128(BUF[1], bk, Q + 16); DSR128(BUF[2], bk, Q + 32); DSR128(BUF[3], bk, Q + 48); \
    DSR128(BUF[4], bk, 256 + Q); DSR128(BUF[5], bk, 256 + Q + 16); DSR128(BUF[6], bk, 256 + Q + 32); DSR128(BUF[7], bk, 256 + Q + 48); \
    DSR128(BUF[8], bk, 512 + Q); DSR128(BUF[9], bk, 512 + Q + 16); DSR128(BUF[10], bk, 512 + Q + 32); DSR128(BUF[11], bk, 512 + Q + 48); } while (0)
#define HG_HALF(BUF, J) do { _Pragma("unroll") for (int i_ = 0; i_ < 4; ++i_) { \
    f32x4 sv = S4[4 * (J) + i_] * BUF[i_] + BUF[4 + i_] * iv; S4[4 * (J) + i_] = sv; oacc += sv * BUF[8 + i_]; } } while (0)

__device__ __forceinline__ void hgrn_scan_wg(const Params& p, int l, int grp, LAS unsigned char* lds) {
    const int tid = opaque_tid(), wave = tid >> 6, lane = tid & 63;
    constexpr int HTC = 16, NCH = SEQL / HTC;
    LAS float* ring = (LAS float*)lds;
    LAS float* lbt = (LAS float*)(lds + 4 * HTC * 4 * 64 * 4);
    bf16_t* proj = (bf16_t*)(p.ws + OFF_PROJ);
    for (int i = tid; i < 2 * RW; i += 512) { const int dr = i / RW, cc = i % RW; const float* lg = p.in[4] + (size_t)dr * 5 * RW + cc;
        float e[5], mx = -1e30f;
#pragma unroll
        for (int j = 0; j < 5; ++j) { e[j] = lg[j * RW]; mx = fmaxf(mx, e[j]); }
        float sum = 0.f, cum = 0.f;
#pragma unroll
        for (int j = 0; j < 5; ++j) { e[j] = __expf(e[j] - mx); sum += e[j]; if (j <= l) cum += e[j]; }
        lbt[i] = cum / sum; }
    __syncthreads();
    const int j = wave >> 1, half = wave & 1, kp = lane >> 5, col = half * 32 + (lane & 31);
    const int cch = grp * 4 + j;
    const int cdir = cch & 1, cb = (cch >> 1) / 6, chh = (cch >> 1) % 6;
    bf16_t* orow = proj + (size_t)cb * SEQL * PS + (cdir ? P_FB : P_FF) + chh * 64 + col;
    const bf16_t* prow = proj + (size_t)cb * SEQL * PS + chh * 64 + lane;
    const float lb = lbt[cdir * RW + chh * 64 + lane];
    f32x4 S4[8];
#pragma unroll
    for (int k = 0; k < 8; ++k) S4[k] = (f32x4){0.f, 0.f, 0.f, 0.f};
    f32x4 A[12], B[12], oacc = (f32x4){0.f, 0.f, 0.f, 0.f}; float iv = 0.f, ivn = 0.f;
    const unsigned ring_addr = (unsigned)(unsigned long long)ring;
    const unsigned cbase = ring_addr + (unsigned)((j * HTC) * 1024);
    const unsigned offk = cbase + kp * 128, offv = cbase + col * 4;
    for (int chunk = 0; chunk < NCH; ++chunk) {
        {
            float qv[8], fv[8], ivv[8];
#pragma unroll
            for (int i = 0; i < 8; ++i) {
                const int sl = half * 8 + i, s = chunk * HTC + sl, t = cdir ? SEQL - 1 - s : s;
                const bf16_t* pr = prow + (size_t)t * PS;
                qv[i] = bf2f(pr[P_Q]); fv[i] = bf2f(pr[cdir ? P_FB : P_FF]); ivv[i] = bf2f(pr[P_I]);
            }
#pragma unroll
            for (int i = 0; i < 8; ++i) {
                const int sl = half * 8 + i;
                const float f = lb + (1.f - lb) * sigmoidf_(fv[i]);
                LAS float* o = ring + (size_t)((j * HTC + sl) * 4) * 64;
                o[lane] = f; o[64 + lane] = 1.f - f; o[128 + lane] = qv[i]; o[192 + lane] = ivv[i];
            }
        }
        __syncthreads();
        {
            HG_ISSUE(A, offk, 0); DSR32(ivn, offv, 768);
#pragma unroll 1
            for (int sl = 0; sl < HTC; ++sl) {
                const unsigned bk = offk + sl * 1024, nbk = bk + 1024, nbv = offv + (sl + 1) * 1024;
                LGKM0(); iv = ivn; HG_ISSUE(B, bk, 64); SCHEDB; oacc = (f32x4){0.f, 0.f, 0.f, 0.f}; HG_HALF(A, 0); SCHEDB;
                LGKM0(); HG_ISSUE(A, nbk, 0); DSR32(ivn, nbv, 768); SCHEDB; HG_HALF(B, 1); SCHEDB;
                const float oval = xsum32((oacc.x + oacc.y) + (oacc.z + oacc.w));
                const int s = chunk * HTC + sl, t = cdir ? SEQL - 1 - s : s;
                if (kp == 0) orow[(size_t)t * PS] = (bf16_t)f2bf(oval);
            }
            LGKM0();
        }
        __syncthreads();
    }
}

__device__ __forceinline__ void conv_wg(const Params& p, int l, int first, int stride, LAS unsigned char* lds) {
    const int tid = opaque_tid(), wave = tid >> 6, lane = tid & 63;
    LAS float* z = (LAS float*)lds;
    LAS float* ot = (LAS float*)(lds + 62 * 256 * 4);
    bf16_t* proj = (bf16_t*)(p.ws + OFF_PROJ);
    const int ch = tid & 255, half = tid >> 8;
    float w[31];
#pragma unroll
    for (int j = 0; j < 31; ++j) w[j] = p.in[18][(size_t)(l * 31 + j) * 256 + ch];
    const float cb = p.in[19][l * 256 + ch];
    const f32x4 lg = ((const f32x4*)(p.in[20] + l * 256))[lane], lbv = ((const f32x4*)(p.in[21] + l * 256))[lane];
    for (int tile = first; tile < MROWS / 32; tile += stride) {
        const int row0 = tile * 32, b = row0 / SEQL, t0 = row0 % SEQL;
        for (int r = half; r < 62; r += 2) { const int t = t0 - 15 + r; float zz = 0.f;
            if (t >= 0 && t < SEQL) { const bf16_t* pr = proj + ((size_t)b * SEQL + t) * PS; zz = bf2f(pr[P_CV + ch]) * sigmoidf_(bf2f(pr[P_CG + ch])); }
            z[r * 256 + ch] = zz; }
        __syncthreads();
#pragma unroll 4
        for (int tt = 0; tt < 16; ++tt) { const int tok = half * 16 + tt; float acc = cb;
#pragma unroll
            for (int j = 0; j < 31; ++j) acc += w[j] * z[(tok + j) * 256 + ch];
            ot[tok * 256 + ch] = acc; }
        __syncthreads();
#pragma unroll
        for (int q = 0; q < 4; ++q) { const int tok = wave * 4 + q;
            f32x4 v = *(const LAS f32x4*)(ot + tok * 256 + lane * 4);
            const float mean = wave_sum((v.x + v.y) + (v.z + v.w)) * (1.f / 256.f);
            v = v - mean;
            const float var = wave_sum((v.x * v.x + v.y * v.y) + (v.z * v.z + v.w * v.w)) * (1.f / 256.f);
            const float rstd = rsqrtf(var + LN_EPS);
            f32x4 y = v * rstd * lg + lbv;
            y.x = y.x * sigmoidf_(y.x); y.y = y.y * sigmoidf_(y.y); y.z = y.z * sigmoidf_(y.z); y.w = y.w * sigmoidf_(y.w);
            u32x2 wv; wv.x = pk2(y.x, y.y); wv.y = pk2(y.z, y.w);
            *(u32x2*)(proj + (size_t)(row0 + tok) * PS + P_YC + lane * 4) = wv; }
        __syncthreads();
    }
}

__device__ __forceinline__ void combine_phase(const Params& p, int l, int widx, int nw, LAS unsigned char* lds) {
    const int tid = opaque_tid(), lane = tid & 63;
    bf16_t* proj = (bf16_t*)(p.ws + OFF_PROJ);
    const bf16_t* o_r = (const bf16_t*)(p.ws + OFF_T);
    LAS unsigned* WA = (LAS unsigned*)lds;
    LAS unsigned* WG = (LAS unsigned*)(lds + 49152);
    {
        const float* aup = p.in[11] + (size_t)(l * 2 * 32) * RW; const float* gup = p.in[12] + (size_t)(l * 64) * RW;
        for (int i = tid; i < 2 * 32 * 3 * 64; i += 512) { const int ln = i & 63, hp = (i >> 6) % 3, dr = i / 192; const float* s = aup + (size_t)dr * RW + (2 * hp) * 64 + ln; WA[i] = pk2(s[0], s[64]); }
        for (int i = tid; i < 64 * 3 * 64; i += 512) { const int ln = i & 63, hp = (i >> 6) % 3, r = i / 192; const float* s = gup + (size_t)r * RW + (2 * hp) * 64 + ln; WG[i] = pk2(s[0], s[64]); }
    }
    __syncthreads();
    const float* mu0 = p.in[7] + (size_t)(l * 2 + 0) * NRW; const float* mu1 = mu0 + NRW;
    const float mad0 = mu0[1216 + lane], mad1 = mu1[1216 + lane], mgd0 = mu0[1280 + lane], mgd1 = mu1[1280 + lane];
    for (int g4 = widx; g4 < MROWS / 2; g4 += nw) {
        const int row0 = g4 * 2;
        float adv[2], sgv[2];
#pragma unroll
        for (int tt = 0; tt < 2; ++tt) { const int row = row0 + tt, t = row % SEQL; const bf16_t* pr = proj + (size_t)row * PS;
            const bool hp = t > 0, hn = t < SEQL - 1; const bf16_t* pp = hp ? pr - PS : pr; const bf16_t* pn = hn ? pr + PS : pr; const float fp = hp ? 1.f : 0.f, fn = hn ? 1.f : 0.f;
            const float ac = bf2f(pr[P_AD + lane]), ap = fp * bf2f(pp[P_AD + lane]), an = fn * bf2f(pn[P_AD + lane]);
            const float gc = bf2f(pr[P_GD + lane]), gp = fp * bf2f(pp[P_GD + lane]), gn = fn * bf2f(pn[P_GD + lane]);
            adv[tt] = ac + mad0 * (ap - ac) + mad1 * (an - ac);
            sgv[tt] = sigmoidf_(gc + mgd0 * (gp - gc) + mgd1 * (gn - gc)); }
        float A0[2][6], A1[2][6], G[2][6];
#pragma unroll
        for (int tt = 0; tt < 2; ++tt)
#pragma unroll
            for (int h = 0; h < 6; ++h) { A0[tt][h] = 0.f; A1[tt][h] = 0.f; G[tt][h] = 0.f; }
#pragma unroll 4
        for (int r = 0; r < 32; ++r) {
            float w0[6], w1[6];
#pragma unroll
            for (int hp = 0; hp < 3; ++hp) { const unsigned u0 = WA[(r * 3 + hp) * 64 + lane], u1 = WA[((32 + r) * 3 + hp) * 64 + lane];
                w0[2 * hp] = __uint_as_float(u0 << 16); w0[2 * hp + 1] = __uint_as_float(u0 & 0xffff0000u); w1[2 * hp] = __uint_as_float(u1 << 16); w1[2 * hp + 1] = __uint_as_float(u1 & 0xffff0000u); }
#pragma unroll
            for (int tt = 0; tt < 2; ++tt) { const float s0 = rdlane(adv[tt], r), s1 = rdlane(adv[tt], 32 + r);
#pragma unroll
                for (int h = 0; h < 6; ++h) { A0[tt][h] += s0 * w0[h]; A1[tt][h] += s1 * w1[h]; } }
        }
#pragma unroll 4
        for (int r = 0; r < 64; ++r) {
            float wg[6];
#pragma unroll
            for (int hp = 0; hp < 3; ++hp) { const unsigned u = WG[(r * 3 + hp) * 64 + lane]; wg[2 * hp] = __uint_as_float(u << 16); wg[2 * hp + 1] = __uint_as_float(u & 0xffff0000u); }
#pragma unroll
            for (int tt = 0; tt < 2; ++tt) { const float s = rdlane(sgv[tt], r);
#pragma unroll
                for (int h = 0; h < 6; ++h) G[tt][h] += s * wg[h]; }
        }
#pragma unroll
        for (int h = 0; h < 6; ++h) {
            const int c = h * 64 + lane;
            const float a00 = p.in[10][(l * 2 + 0) * RW + c], a01 = p.in[10][(l * 2 + 1) * RW + c], kac = p.in[14][l * RW + c];
            const float rk = p.in[15][(l * 6 + h) * 64 + lane], gng = p.in[16][l * RW + c], gnb = p.in[17][l * RW + c], ng = p.in[6][l * RW + c];
            const float mr0 = mu0[c], mr1 = mu1[c], mk0 = mu0[384 + c], mk1 = mu1[384 + c], mv0 = mu0[768 + c], mv1 = mu1[768 + c];
#pragma unroll
            for (int tt = 0; tt < 2; ++tt) { const int row = row0 + tt, t = row % SEQL; bf16_t* pr = proj + (size_t)row * PS;
                const bool hp = t > 0, hn = t < SEQL - 1; const bf16_t* pp = hp ? pr - PS : pr; const bf16_t* pn = hn ? pr + PS : pr; const float fp = hp ? 1.f : 0.f, fn = hn ? 1.f : 0.f;
                const float rc = bf2f(pr[P_R + c]), rp = fp * bf2f(pp[P_R + c]), rn = fn * bf2f(pn[P_R + c]);
                const float kc = bf2f(pr[P_K + c]), kp = fp * bf2f(pp[P_K + c]), kn = fn * bf2f(pn[P_K + c]);
                const float vc = bf2f(pr[P_V + c]), vp = fp * bf2f(pp[P_V + c]), vn = fn * bf2f(pn[P_V + c]);
                const float rs = rc + mr0 * (rp - rc) + mr1 * (rn - rc);
                const float ks = kc + mk0 * (kp - kc) + mk1 * (kn - kc);
                const float vs = vc + mv0 * (vp - vc) + mv1 * (vn - vc);
                const float a0 = sigmoidf_(a00 + A0[tt][h]), a1 = sigmoidf_(a01 + A1[tt][h]);
                const float kh = ks * (1.f + (0.5f * (a0 + a1) - 1.f) * kac);
                const float bsum = wave_sum(rs * kh * rk);
                const float o = bf2f(o_r[(size_t)row * RW + c]) + bf2f(o_r[((size_t)MROWS + row) * RW + c]);
                const float mean = wave_sum(o) * (1.f / 64.f); const float dlt = o - mean;
                const float var = wave_sum(dlt * dlt) * (1.f / 64.f);
                const float on = dlt * rsqrtf(var + GN_EPS) * gng + gnb;
                const float yr = (on + bsum * vs) * G[tt][h];
                const float oh = bf2f(pr[P_FF + c]) + bf2f(pr[P_FB + c]);
                const float ms = wave_sum(oh * oh) * (1.f / 64.f);
                const float gh = bf2f(pr[P_G + c]);
                const float yh = oh * rsqrtf(ms + RMS_EPS) * ng * (gh * sigmoidf_(gh));
                pr[P_I + c] = (bf16_t)f2bf(yr);
                pr[P_Q + c] = (bf16_t)f2bf(yh);
            }
        }
    }
}

__global__ void __launch_bounds__(512, 2) fwd_mega(Params p) {
    extern __shared__ __attribute__((aligned(16))) unsigned char smem_raw[];
    LAS unsigned char* lds = (LAS unsigned char*)smem_raw;
    cg::grid_group grid = cg::this_grid();
    const int tid = threadIdx.x, wave = tid >> 6, lane = tid & 63;
    const int G = gridDim.x, bid = blockIdx.x;
    const int widx = bid * 8 + wave, nw = G * 8;
    bf16_t* win_t = (bf16_t*)(p.ws + OFF_WIN); bf16_t* wout_t = (bf16_t*)(p.ws + OFF_WOUT); bf16_t* wup_t = (bf16_t*)(p.ws + OFF_WUP); bf16_t* wdn_t = (bf16_t*)(p.ws + OFF_WDN);
    bf16_t* proj = (bf16_t*)(p.ws + OFF_PROJ); bf16_t* xb = (bf16_t*)(p.ws + OFF_T); bf16_t* hid = proj;
    float* x = p.out;

    convert_weights(p, 0, lds, widx, nw);
    for (int row = widx; row < MROWS; row += nw) {
        const float* src = row < 16 * SEQL ? p.in[0] + (size_t)row * D : p.in[1] + (size_t)(row - 16 * SEQL) * D;
        ln_row(src, x + (size_t)row * D, xb + (size_t)row * D, p.in[2], p.in[3], lane);
    }
    GSYNC();
    for (int l = 0; l < DEPTH; ++l) {
        {
            pg8::Gemm g{xb, win_t, MROWS, NINP, D, D}; pg8::StaticOrder S; S.init(MROWS, NINP, G, bid);
            pg8::EpiBf16<0> E{proj + 256, PS};
            for (int rep = 0; rep < REP_GIN; ++rep) pg8::gemm_phase(lds, g, S, E);
        }
        GSYNC();
        for (int rep = 0; rep < REP_SCAN; ++rep) {
            if (bid < 144) rwkv_scan_wg(p, l, bid, lds);
            else if (bid < 216) { if (rep == 0) hgrn_scan_wg(p, l, bid - 144, lds); }
            else { }
        }
        GSYNC();
        conv_wg(p, l, bid, G, lds);
        for (int rep = 0; rep < REP_COMB; ++rep) combine_phase(p, l, widx, nw, lds);
        GSYNC();
        {
            pg8::Gemm g{proj, wout_t, MROWS, D, D, PS}; pg8::StaticOrder S; S.init(MROWS, D, G, bid);
            pg8::EpiResid E{x, D, DN_ALPHA};
            pg8::gemm_phase(lds, g, S, E);
        }
        GSYNC();
        for (int row = widx; row < MROWS; row += nw)
            ln_row(x + (size_t)row * D, x + (size_t)row * D, xb + (size_t)row * D, p.in[23] + l * D, p.in[24] + l * D, lane);
        GSYNC();
        for (int third = 0; third < 3; ++third) {
            constexpr int MT = MROWS / 3;
            {   pg8::Gemm g{xb + (size_t)third * MT * D, wup_t, MT, FFN, D, D}; pg8::StaticOrder S; S.init(MT, FFN, G, bid);
                pg8::EpiBf16<1> E{hid, FFN};
                for (int rep = 0; rep < REP_UP; ++rep) pg8::gemm_phase(lds, g, S, E); }
            GSYNC();
            {   pg8::Gemm g{hid, wdn_t, MT, D, FFN, FFN}; pg8::StaticOrder S; S.init(MT, D, G, bid);
                pg8::EpiResid E{x + (size_t)third * MT * D, D, DN_ALPHA};
                pg8::gemm_phase(lds, g, S, E); }
            GSYNC();
        }
        if (l + 1 < DEPTH) convert_weights(p, l + 1, lds, widx, nw);
        for (int row = widx; row < MROWS; row += nw)
            ln_row(x + (size_t)row * D, x + (size_t)row * D, xb + (size_t)row * D, p.in[27] + l * D, p.in[28] + l * D, lane);
        GSYNC();
    }
}

extern "C" void kernel_launch(void* const* d_in, const int* in_sizes, int n_in, void* d_out, int out_size, void* d_ws, size_t ws_size, hipStream_t stream) {
    static int grid = 0;
    if (grid == 0) {
        if (n_in != 29 || out_size != MROWS * D || ws_size < WS_END) { fprintf(stderr, "kernel_launch: unexpected shapes (n_in %d out %d ws %zu need %zu)\n", n_in, out_size, ws_size, (size_t)WS_END); grid = -1; return; }
        int dev = 0, cus = 0, per_cu = 0;
        hipGetDevice(&dev);
        hipDeviceGetAttribute(&cus, hipDeviceAttributeMultiprocessorCount, dev);
        if (hipFuncSetAttribute((const void*)fwd_mega, hipFuncAttributeMaxDynamicSharedMemorySize, LDS_BYTES) != hipSuccess) { fprintf(stderr, "kernel_launch: hipFuncSetAttribute failed\n"); grid = -1; return; }
        hipOccupancyMaxActiveBlocksPerMultiprocessor(&per_cu, (const void*)fwd_mega, 512, LDS_BYTES);
        (void)hipGetLastError();
        if (per_cu < 1) per_cu = 1;
        grid = cus;
        if (grid != 256) fprintf(stderr, "kernel_launch: note: %d CUs\n", grid);
    }
    if (grid < 0) return;
    Params p{};
    for (int i = 0; i < 29; ++i) p.in[i] = (const float*)d_in[i];
    p.out = (float*)d_out; p.ws = (unsigned char*)d_ws;
    void* args[] = {&p};
    hipError_t e = hipLaunchCooperativeKernel((const void*)fwd_mega, dim3(grid), dim3(512), args, LDS_BYTES, stream);
    if (e != hipSuccess) fprintf(stderr, "cooperative launch failed: %s (grid %d)\n", hipGetErrorString(e), grid);
}
```

```cpp
#include <hip/hip_runtime.h>
#include <hip/hip_cooperative_groups.h>
#include <cstdio>
#include <cstdint>
namespace cg = cooperative_groups;

#define LAS __attribute__((address_space(3)))
typedef unsigned short bf16_t;
typedef short bf16x8 __attribute__((ext_vector_type(8)));
typedef float f32x4 __attribute__((ext_vector_type(4)));
typedef unsigned u32x4 __attribute__((ext_vector_type(4)));
typedef unsigned u32x2 __attribute__((ext_vector_type(2)));

constexpr int D = 1024, SEQL = 2048, NSEQ = 24, MROWS = NSEQ * SEQL, DEPTH = 4, FFN = 4096;
constexpr int NIN = 3776, NINP = 3840, PS = 4096;
constexpr int RW = 384, NRW = 1344;
constexpr int P_YC = 0, P_Q = 256, P_I = 640, P_FF = 1024, P_FB = 1408, P_G = 1792;
constexpr int P_RW = 2176, P_R = P_RW, P_K = P_RW + 384, P_V = P_RW + 768, P_WD = P_RW + 1152, P_AD = P_RW + 1216, P_GD = P_RW + 1280;
constexpr int P_CV = 3520, P_CG = 3776;
constexpr float LN_EPS = 1e-5f, RMS_EPS = 1e-6f, GN_EPS = 64e-5f;
constexpr float DN_ALPHA = 1.681792830507429f;

constexpr size_t OFF_WIN = 0, SZ_WIN = (size_t)NINP * D * 2;
constexpr size_t OFF_WOUT = OFF_WIN + SZ_WIN, SZ_WOUT = (size_t)D * D * 2;
constexpr size_t OFF_WUP = OFF_WOUT + SZ_WOUT, SZ_WUP = (size_t)FFN * D * 2;
constexpr size_t OFF_WDN = OFF_WUP + SZ_WUP, SZ_WDN = (size_t)FFN * D * 2;
constexpr size_t OFF_PROJ = OFF_WDN + SZ_WDN, SZ_PROJ = (size_t)MROWS * PS * 2;
constexpr size_t OFF_T = OFF_PROJ + SZ_PROJ, SZ_T = (size_t)MROWS * D * 2;
constexpr size_t OFF_BAR = OFF_T + SZ_T, SZ_BAR = 3456 * 4;
constexpr size_t WS_END = OFF_BAR + SZ_BAR;
constexpr int LDS_BYTES = 131072 + 16;
#define REP_SCAN 1
#define REP_COMB 1
#define REP_GIN 1
#define REP_UP 1
#define REP_SYNC 1
#define GSYNC() do { for (int r_ = 0; r_ < REP_SYNC; ++r_) xcd_barrier(xbar); } while (0)

struct Params {
    const float* in[29];
    float* out;
    unsigned char* ws;
};

__device__ __forceinline__ float bf2f(bf16_t b) { return __uint_as_float(((unsigned)b) << 16); }
__device__ __forceinline__ unsigned f2bf(float f) { unsigned u = __float_as_uint(f); u += 0x7FFFu + ((u >> 16) & 1u); return u >> 16; }
__device__ __forceinline__ unsigned pk2(float lo, float hi) { return f2bf(lo) | (f2bf(hi) << 16); }
__device__ __forceinline__ float dpp_add(float v, const int ctrl_sel) {
    int r;
    switch (ctrl_sel) {
        case 0: r = __builtin_amdgcn_update_dpp(0, __float_as_int(v), 0xB1, 0xF, 0xF, true); break;
        case 1: r = __builtin_amdgcn_update_dpp(0, __float_as_int(v), 0x4E, 0xF, 0xF, true); break;
        case 2: r = __builtin_amdgcn_update_dpp(0, __float_as_int(v), 0x141, 0xF, 0xF, true); break;
        default: r = __builtin_amdgcn_update_dpp(0, __float_as_int(v), 0x140, 0xF, 0xF, true); break;
    }
    return v + __int_as_float(r);
}
__device__ __forceinline__ float wave_sum(float v) {
    v = dpp_add(v, 0); v = dpp_add(v, 1); v = dpp_add(v, 2); v = dpp_add(v, 3);
    { auto r = __builtin_amdgcn_permlane16_swap(__float_as_uint(v), __float_as_uint(v), false, false); v = __uint_as_float(r[0]) + __uint_as_float(r[1]); }
    { auto r = __builtin_amdgcn_permlane32_swap(__float_as_uint(v), __float_as_uint(v), false, false); v = __uint_as_float(r[0]) + __uint_as_float(r[1]); }
    return v;
}
__device__ __forceinline__ int opaque_tid() { int t = threadIdx.x; asm volatile("" : "+v"(t)); return t; }
__device__ __forceinline__ float sigmoidf_(float x) { return 1.0f / (1.0f + __expf(-x)); }
__device__ __forceinline__ float rdlane(float v, int l) { return __int_as_float(__builtin_amdgcn_readlane(__float_as_int(v), l)); }

#define XB_TMO      128
#define XB_XCNT(j)  (256  + 64 * (j))
#define XB_XSUB(j)  (1280 + 64 * (j))
#define XB_XGEN(j)  (2304 + 64 * (j))
#define XB_TOP      3328
#define XB_TOPGEN   3392
#define XCD_BAR_WORDS 3456
#define XB_SPIN_CAP (1u << 22)
__device__ __forceinline__ unsigned xb_ld(unsigned* p)              { return __hip_atomic_load(p, __ATOMIC_RELAXED, __HIP_MEMORY_SCOPE_AGENT); }
__device__ __forceinline__ unsigned xb_add(unsigned* p, unsigned v) { return __hip_atomic_fetch_add(p, v, __ATOMIC_RELAXED, __HIP_MEMORY_SCOPE_AGENT); }
__device__ __forceinline__ unsigned xb_xcc_id() { return (unsigned)__builtin_amdgcn_s_getreg((3 << 11) | 20) & 0xFu; }
#define XB_SPIN(cond, bar) do { unsigned _sp = 0; while (cond) { __builtin_amdgcn_s_sleep(1); \
    if ((++_sp & 255u) == 0u) { if (xb_ld(&(bar)[XB_TMO])) break; if (_sp > XB_SPIN_CAP) { atomicAdd(&(bar)[XB_TMO], 1u); break; } } } } while (0)
struct XcdBarrier { unsigned* bar; unsigned x; volatile LAS unsigned* st; };
__device__ __forceinline__ XcdBarrier xcd_barrier_post(unsigned* bar, volatile LAS unsigned* st) {
    XcdBarrier b; b.bar = bar; b.x = xb_xcc_id(); b.st = st;
    if (threadIdx.x == 0) (void)xb_add(&bar[XB_XCNT(b.x)], 1u);
    return b;
}
__device__ __forceinline__ void xcd_barrier_complete(unsigned* bar, unsigned x, unsigned& nloc, unsigned& nx) {
    const unsigned G = gridDim.x * gridDim.y * gridDim.z;
    unsigned sum, cnt, mine, sp = 0u;
    for (;;) {
        sum = 0u; cnt = 0u; mine = 0u;
#pragma unroll
        for (unsigned j = 0; j < 16; ++j) { const unsigned c = xb_ld(&bar[XB_XCNT(j)]); sum += c; cnt += (c > 0u) ? 1u : 0u; mine = (j == x) ? c : mine; }
        if (sum == G) break;
        __builtin_amdgcn_s_sleep(1);
        if ((++sp & 255u) == 0u) { if (xb_ld(&bar[XB_TMO])) break; if (sp > XB_SPIN_CAP) { atomicAdd(&bar[XB_TMO], 1u); break; } }
    }
    nloc = mine > 0u ? mine : 1u; nx = cnt > 0u ? cnt : 1u;
}
__device__ __forceinline__ void xcd_barrier(const XcdBarrier& b) {
    asm volatile("s_waitcnt vmcnt(0)" ::: "memory");
    __syncthreads();
    if (threadIdx.x == 0) {
        unsigned* bar = b.bar;
        __builtin_amdgcn_s_waitcnt(0);
        unsigned nloc = b.st[0], nx = b.st[1];
        if (nloc == 0u) { xcd_barrier_complete(bar, b.x, nloc, nx); b.st[0] = nloc; b.st[1] = nx; }
        const unsigned old = xb_add(&bar[XB_XSUB(b.x)], 1u);
        const unsigned gen = old / nloc;
        if (old + 1u == (gen + 1u) * nloc) {
            __builtin_amdgcn_fence(__ATOMIC_RELEASE, "agent");
            asm volatile("s_waitcnt vmcnt(0)" ::: "memory");
            const unsigned og = xb_add(&bar[XB_TOP], 1u);
            const unsigned tg = og / nx;
            if (og + 1u == (tg + 1u) * nx) xb_add(&bar[XB_TOPGEN], 1u);
            else XB_SPIN(xb_ld(&bar[XB_TOPGEN]) == tg, bar);
            __builtin_amdgcn_fence(__ATOMIC_ACQUIRE, "agent");
            xb_add(&bar[XB_XGEN(b.x)], 1u);
            asm volatile("s_waitcnt vmcnt(0)" ::: "memory");
        } else {
            XB_SPIN(xb_ld(&bar[XB_XGEN(b.x)]) == gen, bar);
            __builtin_amdgcn_fence(__ATOMIC_ACQUIRE, "agent");
            asm volatile("s_waitcnt vmcnt(0)" ::: "memory");
        }
    }
    __syncthreads();
}

namespace pg8 {
constexpr int BM = 256, BK = 64, HALF = 128, HTB = HALF * BK * 2, STAGE_BYTES = 8 * HTB, NXCD = 8, WGM = 8;
__device__ __forceinline__ int lds_byte(int r, int c) { const int st = (r >> 4) * 2 + (c >> 5), rr = r & 15, cc = c & 31, ob = rr * 64 + cc * 2; return st * 1024 + (ob ^ (((ob >> 9) & 1) << 5)); }
__device__ __forceinline__ void stage_rc(int b, int& R, int& C) { const int st = b / 1024, sb = b % 1024, swz = sb ^ (((sb >> 9) & 1) << 5); R = (st >> 1) * 16 + swz / 64; C = (st & 1) * 32 + (swz % 64) / 2; }
__device__ __forceinline__ int perm32(int rho) { const int n = rho >> 4, i = rho & 15; return 8 * (i >> 2) + 4 * n + (i & 3); }
struct Unit { int pm, pn; };
struct Gemm { const bf16_t* A; const bf16_t* Bt; int M, N, K, lda; };
struct StaticOrder {
    int nM, nN, nwg, G, c;
    __device__ void init(int M, int N, int G_, int c_) { nM = M / BM; nN = N / BM; nwg = nM * nN; G = G_; c = c_; }
    __device__ bool next(int i, Unit& u) const {
        const long L = (long)i * G + c; if (L >= nwg) return false;
        int wgid = (int)L; { const int q = nwg / NXCD, r = nwg % NXCD, xcd = wgid % NXCD, off = wgid / NXCD; wgid = (xcd < r ? xcd * (q + 1) : r * (q + 1) + (xcd - r) * q) + off; }
        const int nig = WGM * nN, gid = wgid / nig, fm = gid * WGM, gsz = (nM - fm) < WGM ? (nM - fm) : WGM;
        u.pm = fm + ((wgid % nig) % gsz); u.pn = (wgid % nig) / gsz; return true;
    }
};
__device__ __forceinline__ unsigned cvt_pk_bf16(float lo, float hi) { unsigned r; asm volatile("v_cvt_pk_bf16_f32 %0, %1, %2" : "=v"(r) : "v"(lo), "v"(hi)); return r; }

template <int ACT  > struct EpiBf16 {
    static constexpr bool PERM = true;
    bf16_t* O; int ldc;
    __device__ __forceinline__ void operator()(const f32x4 (&acc)[2][2][4][2], const Unit& u, int wr, int wc, int fr, int fq) const {
        const int row0 = u.pm * BM + wr * 64 + fr; const int col0 = u.pn * BM + wc * 32 + 8 * fq;
#pragma unroll
        for (int ai = 0; ai < 2; ++ai)
#pragma unroll
            for (int m = 0; m < 4; ++m) { bf16_t* rowp = O + (size_t)(row0 + ai * HALF + m * 16) * ldc + col0;
#pragma unroll
                for (int bj = 0; bj < 2; ++bj) { f32x4 v0 = acc[ai][bj][m][0], v1 = acc[ai][bj][m][1];
                    if (ACT == 1) {
#pragma unroll
                        for (int j = 0; j < 4; ++j) { float a = fmaxf(v0[j], 0.f), b = fmaxf(v1[j], 0.f); v0[j] = a * a; v1[j] = b * b; } }
                    u32x4 w; w.x = cvt_pk_bf16(v0[0], v0[1]); w.y = cvt_pk_bf16(v0[2], v0[3]); w.z = cvt_pk_bf16(v1[0], v1[1]); w.w = cvt_pk_bf16(v1[2], v1[3]);
                    *(u32x4*)(rowp + bj * HALF) = w; } }
    }
};
struct EpiResid {
    static constexpr bool PERM = false;
    float* C; int ldc; float alpha;
    __device__ __forceinline__ void operator()(const f32x4 (&acc)[2][2][4][2], const Unit& u, int wr, int wc, int fr, int fq) const {
        const int row0 = u.pm * BM + wr * 64 + fr, col0 = u.pn * BM + wc * 32 + 4 * fq;
#pragma unroll
        for (int ai = 0; ai < 2; ++ai)
#pragma unroll
            for (int m = 0; m < 4; ++m) { float* rowp = C + (size_t)(row0 + ai * HALF + m * 16) * ldc + col0;
                f32x4 old[2][2];
#pragma unroll
                for (int bj = 0; bj < 2; ++bj)
#pragma unroll
                    for (int n = 0; n < 2; ++n) old[bj][n] = *(const f32x4*)(rowp + bj * HALF + n * 16);
#pragma unroll
                for (int bj = 0; bj < 2; ++bj)
#pragma unroll
                    for (int n = 0; n < 2; ++n) *(f32x4*)(rowp + bj * HALF + n * 16) = old[bj][n] * alpha + acc[ai][bj][m][n]; }
    }
};

template <class Epi, class Sched>
__device__ __forceinline__ void gemm_phase(LAS unsigned char* lds, const Gemm g, const Sched& S, const Epi& E) {
    const int tid = opaque_tid(), wid = __builtin_amdgcn_readfirstlane(tid >> 6), lane = tid & 63, wr = wid >> 2, wc = wid & 3, fr = lane & 15, fq = lane >> 4;
    const int K = g.K, nt = K / BK, lda = g.lda;
    unsigned voffA[2], voffB[2];
#pragma unroll
    for (int i = 0; i < 2; ++i) { int R, C; stage_rc(tid * 16 + i * 8192, R, C); const int Rb = Epi::PERM ? ((R & ~31) + perm32(R & 31)) : R;
        voffA[i] = (unsigned)(R * lda + C) * 2u; voffB[i] = (unsigned)(Rb * K + C) * 2u; }
    const size_t kstep = (size_t)(BK * 2);
    const size_t hstepA = (size_t)HALF * lda * 2, hstepB = (size_t)HALF * K * 2;
    const size_t tstepA = 2 * hstepA, tstepB = 2 * hstepB;
    const unsigned ldsw = (unsigned)wid * 1024u;
    const int aoff = lds_byte(wr * 64 + fr, fq * 8), boff = lds_byte(wc * 32 + fr, fq * 8);
#define PG8_SA(b, h) (((b) * 2 + (h)) * HTB)
#define PG8_SB(b, h) ((4 + (b) * 2 + (h)) * HTB)
#define PG8_STAGE(bufoff, gbase, voff) do { _Pragma("unroll") for (int _i = 0; _i < 2; ++_i) \
        __builtin_amdgcn_global_load_lds((const unsigned*)((const char*)(gbase) + (voff)[_i]), (LAS unsigned*)(lds + (bufoff) + ldsw + _i * 8192), 16, 0, 0); } while (0)
#define PG8_LDA(dst, b, h) do { _Pragma("unroll") for (int m = 0; m < 4; ++m) _Pragma("unroll") for (int k = 0; k < 2; ++k) dst[m][k] = *(const LAS bf16x8*)(lds + PG8_SA(b, h) + aoff + m * 2048 + k * 1024); } while (0)
#define PG8_LDB(dst, b, h) do { _Pragma("unroll") for (int n = 0; n < 2; ++n) _Pragma("unroll") for (int k = 0; k < 2; ++k) dst[n][k] = *(const LAS bf16x8*)(lds + PG8_SB(b, h) + boff + n * 2048 + k * 1024); } while (0)
#define PG8_MMA(ai, bj, At, Bt) do { __builtin_amdgcn_s_setprio(1); _Pragma("unroll") for (int m = 0; m < 4; ++m) _Pragma("unroll") for (int n = 0; n < 2; ++n) _Pragma("unroll") for (int k = 0; k < 2; ++k) \
        acc[ai][bj][m][n] = __builtin_amdgcn_mfma_f32_16x16x32_bf16(Bt[n][k], At[m][k], acc[ai][bj][m][n], 0, 0, 0); __builtin_amdgcn_s_setprio(0); } while (0)
#define PG8_WAIT_V(n) asm volatile("s_waitcnt vmcnt(" #n ")" ::: "memory")
#define PG8_WAIT_L(n) asm volatile("s_waitcnt lgkmcnt(" #n ")" ::: "memory")
#define PG8_BAR __builtin_amdgcn_s_barrier()
#define PG8_SCHED __builtin_amdgcn_sched_barrier(0)
    Unit cur, nxt; int ui = 0;
    if (!S.next(0, cur)) return;
    f32x4 acc[2][2][4][2];
#pragma unroll
    for (int a = 0; a < 2; ++a)
#pragma unroll
        for (int b = 0; b < 2; ++b)
#pragma unroll
            for (int m = 0; m < 4; ++m)
#pragma unroll
                for (int n = 0; n < 2; ++n) acc[a][b][m][n] = (f32x4){0.f, 0.f, 0.f, 0.f};
    bf16x8 At[4][2], B0[2][2], B1[2][2];
    const char* cA = (const char*)g.A + (size_t)cur.pm * tstepA; const char* cB = (const char*)g.Bt + (size_t)cur.pn * tstepB;
    PG8_STAGE(PG8_SB(0, 0), cB, voffB); PG8_STAGE(PG8_SA(0, 0), cA, voffA); PG8_STAGE(PG8_SB(0, 1), cB + hstepB, voffB); PG8_STAGE(PG8_SA(0, 1), cA + hstepA, voffA);
    if (wr == 1) PG8_BAR;
    PG8_WAIT_V(4); PG8_BAR;
    PG8_STAGE(PG8_SB(1, 0), cB + kstep, voffB); PG8_STAGE(PG8_SA(1, 0), cA + kstep, voffA); PG8_STAGE(PG8_SB(1, 1), cB + hstepB + kstep, voffB);
    PG8_WAIT_V(6); PG8_BAR;
    for (;;) {
        const bool has_next = S.next(ui + 1, nxt);
        const char* nA = has_next ? (const char*)g.A + (size_t)nxt.pm * tstepA : cA; const char* nB = has_next ? (const char*)g.Bt + (size_t)nxt.pn * tstepB : cB;
        for (int t = 0; t < nt; t += 2) {
            const bool last = (t == nt - 2);
            const char* a1 = cA + (size_t)(t + 1) * kstep;
            const char* a2 = last ? nA : cA + (size_t)(t + 2) * kstep; const char* b2 = last ? nB : cB + (size_t)(t + 2) * kstep;
            const char* a3 = a2 + kstep; const char* b3 = b2 + kstep;
            PG8_LDB(B0, 0, 0); PG8_SCHED; PG8_LDA(At, 0, 0); PG8_STAGE(PG8_SA(1, 1), a1 + hstepA, voffA);
            PG8_WAIT_L(8); PG8_BAR; PG8_WAIT_L(0); PG8_MMA(0, 0, At, B0); PG8_BAR; PG8_SCHED;
            PG8_LDB(B1, 0, 1); PG8_STAGE(PG8_SB(0, 0), b2, voffB);
            PG8_BAR; PG8_WAIT_L(0); PG8_MMA(0, 1, At, B1); PG8_BAR;
            PG8_LDA(At, 0, 1); PG8_STAGE(PG8_SA(0, 0), a2, voffA);
            PG8_BAR; PG8_WAIT_L(0); PG8_MMA(1, 0, At, B0); PG8_BAR; PG8_SCHED;
            PG8_STAGE(PG8_SB(0, 1), b2 + hstepB, voffB);
            PG8_WAIT_V(6); PG8_BAR; PG8_MMA(1, 1, At, B1); PG8_BAR;
            PG8_LDB(B0, 1, 0); PG8_SCHED; PG8_LDA(At, 1, 0); PG8_STAGE(PG8_SA(0, 1), a2 + hstepA, voffA);
            PG8_WAIT_L(8); PG8_BAR; PG8_WAIT_L(0); PG8_MMA(0, 0, At, B0); PG8_BAR; PG8_SCHED;
            PG8_LDB(B1, 1, 1); PG8_STAGE(PG8_SB(1, 0), b3, voffB);
            PG8_BAR; PG8_WAIT_L(0); PG8_MMA(0, 1, At, B1); PG8_BAR;
            PG8_LDA(At, 1, 1); PG8_STAGE(PG8_SA(1, 0), a3, voffA);
            PG8_BAR; PG8_WAIT_L(0); PG8_MMA(1, 0, At, B0); PG8_BAR; PG8_SCHED;
            PG8_STAGE(PG8_SB(1, 1), b3 + hstepB, voffB);
            PG8_WAIT_V(6); PG8_BAR; PG8_MMA(1, 1, At, B1); PG8_BAR;
        }
        E(acc, cur, wr, wc, fr, fq);
        if (!has_next) break;
#pragma unroll
        for (int a = 0; a < 2; ++a)
#pragma unroll
            for (int b = 0; b < 2; ++b)
#pragma unroll
                for (int m = 0; m < 4; ++m)
#pragma unroll
                    for (int n = 0; n < 2; ++n) acc[a][b][m][n] = (f32x4){0.f, 0.f, 0.f, 0.f};
        cur = nxt; cA = nA; cB = nB; ++ui;
    }
    PG8_WAIT_V(0);
    if (wr == 0) PG8_BAR;
    PG8_BAR;
#undef PG8_SA
#undef PG8_SB
#undef PG8_STAGE
#undef PG8_LDA
#undef PG8_LDB
#undef PG8_MMA
#undef PG8_WAIT_V
#undef PG8_WAIT_L
#undef PG8_BAR
#undef PG8_SCHED
}
}

__device__ __forceinline__ void transpose_item(const float* W, int Nsrc, int ksrc0, int nsrc0, bf16_t* WT, int K, int k0, int n0, LAS float* scr, int lane) {
#pragma unroll 8
    for (int i = 0; i < 32; ++i) { const int kk = 2 * i + (lane >> 5);
        scr[kk * 33 + (lane & 31)] = nsrc0 >= 0 ? W[(size_t)(ksrc0 + kk) * Nsrc + nsrc0 + (lane & 31)] : 0.f; }
    asm volatile("s_waitcnt lgkmcnt(0)" ::: "memory");
    const int c = lane & 7;
#pragma unroll
    for (int j = 0; j < 4; ++j) { const int n = (lane >> 3) + 8 * j; const LAS float* s = scr + (8 * c) * 33 + n;
        u32x4 o; o.x = pk2(s[0 * 33], s[1 * 33]); o.y = pk2(s[2 * 33], s[3 * 33]); o.z = pk2(s[4 * 33], s[5 * 33]); o.w = pk2(s[6 * 33], s[7 * 33]);
        *(u32x4*)(WT + (size_t)(n0 + n) * K + k0 + 8 * c) = o; }
    asm volatile("s_waitcnt lgkmcnt(0)" ::: "memory");
}
__device__ __forceinline__ int win_colmap(int n0) {
    if (n0 < 384) return n0;
    if (n0 < 768) return 1152 + (n0 - 384);
    if (n0 < 1152) return 384 + (n0 - 768);
    if (n0 < 1536) return 768 + (n0 - 1152);
    if (n0 < NIN) return n0;
    return -1;
}
__device__ __forceinline__ void convert_weights(const Params& p, int l, LAS unsigned char* lds, int widx, int nw) {
    const int tid_ = opaque_tid(); const int wave = tid_ >> 6, lane = tid_ & 63;
    LAS float* scr = (LAS float*)(lds + wave * 8448);
    bf16_t* win_t = (bf16_t*)(p.ws + OFF_WIN); bf16_t* wout_t = (bf16_t*)(p.ws + OFF_WOUT); bf16_t* wup_t = (bf16_t*)(p.ws + OFF_WUP); bf16_t* wdn_t = (bf16_t*)(p.ws + OFF_WDN);
    const float* w_in = p.in[5] + (size_t)l * D * NIN; const float* w_out = p.in[22] + (size_t)l * D * D;
    const float* w_up = p.in[25] + (size_t)l * D * FFN; const float* w_dn = p.in[26] + (size_t)l * FFN * D;
    constexpr int I_IN = (D / 64) * (NINP / 32), I_OUT = (D / 64) * (D / 32), I_UP = (D / 64) * (FFN / 32), I_DN = (FFN / 64) * (D / 32);
    for (int it = widx; it < I_IN + I_OUT + I_UP + I_DN; it += nw) {
        int r = it;
        if (r < I_IN) { const int nb = NINP / 32, kb = r / nb, n0 = (r % nb) * 32; transpose_item(w_in, NIN, kb * 64, win_colmap(n0), win_t, D, kb * 64, n0, scr, lane); continue; } r -= I_IN;
        if (r < I_OUT) { const int nb = D / 32, kb = r / nb, n0 = (r % nb) * 32, k0 = kb * 64; const int ks = k0 < 256 ? 768 + k0 : k0 - 256;
            transpose_item(w_out, D, ks, n0, wout_t, D, k0, n0, scr, lane); continue; } r -= I_OUT;
        if (r < I_UP) { const int nb = FFN / 32, kb = r / nb, n0 = (r % nb) * 32; transpose_item(w_up, FFN, kb * 64, n0, wup_t, D, kb * 64, n0, scr, lane); continue; } r -= I_UP;
        { const int nb = D / 32, kb = r / nb, n0 = (r % nb) * 32; transpose_item(w_dn, D, kb * 64, n0, wdn_t, FFN, kb * 64, n0, scr, lane); }
    }
}

__device__ __forceinline__ void ln_row(const float* src, float* dst32, bf16_t* dstb, const float* g, const float* b, int lane_) {
    int lane = lane_; asm volatile("" : "+v"(lane));
    const f32x4* xr = (const f32x4*)src + lane;
    f32x4 v[4]; float s = 0.f;
#pragma unroll
    for (int j = 0; j < 4; ++j) { v[j] = xr[64 * j]; s += (v[j].x + v[j].y) + (v[j].z + v[j].w); }
    const float mean = wave_sum(s) * (1.f / D); float s2 = 0.f;
#pragma unroll
    for (int j = 0; j < 4; ++j) { v[j] = v[j] - mean; s2 += (v[j].x * v[j].x + v[j].y * v[j].y) + (v[j].z * v[j].z + v[j].w * v[j].w); }
    const float rstd = rsqrtf(wave_sum(s2) * (1.f / D) + LN_EPS);
#pragma unroll
    for (int j = 0; j < 4; ++j) {
        const f32x4 gg = ((const f32x4*)g)[lane + 64 * j], bb = ((const f32x4*)b)[lane + 64 * j];
        f32x4 o = v[j] * rstd * gg + bb;
        ((f32x4*)dst32)[lane + 64 * j] = o;
        u32x2 w; w.x = pk2(o.x, o.y); w.y = pk2(o.z, o.w);
        ((u32x2*)dstb)[lane + 64 * j] = w;
    }
}

#define DSR128(dst, addr, off) asm volatile("ds_read_b128 %0, %1 offset:%2" : "=v"(dst) : "v"(addr), "n"(off))
#define DSR32(dst, addr, off) asm volatile("ds_read_b32 %0, %1 offset:%2" : "=v"(dst) : "v"(addr), "n"(off))
#define LGKM0() do { asm volatile("s_waitcnt lgkmcnt(0)" ::: "memory"); __builtin_amdgcn_sched_barrier(0); } while (0)
#define SCHEDB __builtin_amdgcn_sched_barrier(0)
__device__ __forceinline__ float xsum32(float x) { auto r = __builtin_amdgcn_permlane32_swap(__float_as_uint(x), __float_as_uint(x), false, false); return __uint_as_float(r[0]) + __uint_as_float(r[1]); }
__device__ __forceinline__ float xsum16(float x) { auto r = __builtin_amdgcn_permlane16_swap(__float_as_uint(x), __float_as_uint(x), false, false); return __uint_as_float(r[0]) + __uint_as_float(r[1]); }

constexpr int RTC = 32;
#define RW_ISSUE(BUF, bk, bv, vvn) do { \
    DSR128(BUF[0], bk, 0); DSR128(BUF[1], bk, 16); DSR128(BUF[2], bk, 32); DSR128(BUF[3], bk, 48); \
    DSR128(BUF[4], bk, 256); DSR128(BUF[5], bk, 272); DSR128(BUF[6], bk, 288); DSR128(BUF[7], bk, 304); \
    DSR128(BUF[8], bk, 512); DSR128(BUF[9], bk, 528); DSR128(BUF[10], bk, 544); DSR128(BUF[11], bk, 560); \
    DSR128(BUF[12], bk, 768); DSR128(BUF[13], bk, 784); DSR128(BUF[14], bk, 800); DSR128(BUF[15], bk, 816); \
    DSR128(BUF[16], bk, 1024); DSR128(BUF[17], bk, 1040); DSR128(BUF[18], bk, 1056); DSR128(BUF[19], bk, 1072); \
    DSR32(vvn, bv, 1280); } while (0)
#define RW_COMPUTE(BUF) do { \
    f32x4 sacc = S4[0] * BUF[0] + S4[1] * BUF[1]; sacc += S4[2] * BUF[2] + S4[3] * BUF[3]; \
    const float sa = -xsum16(xsum32((sacc.x + sacc.y) + (sacc.z + sacc.w))); \
    f32x4 oacc = (f32x4){0.f, 0.f, 0.f, 0.f}; \
    _Pragma("unroll") for (int i_ = 0; i_ < 4; ++i_) { f32x4 sv = S4[i_] * BUF[4 + i_] + (sa * BUF[8 + i_] + vv * BUF[12 + i_]); S4[i_] = sv; oacc += sv * BUF[16 + i_]; } \
    oval = xsum16(xsum32((oacc.x + oacc.y) + (oacc.z + oacc.w))); } while (0)

__device__ __forceinline__ void rwkv_scan_wg(const Params& p, int l, int pairIdx, LAS unsigned char* lds) {
    const int tid = opaque_tid(), wave = tid >> 6, lane = tid & 63;
    const int b = pairIdx / 6, h = pairIdx % 6;
    LAS float* ring = (LAS float*)lds;
    const int dir = wave >> 2, rq = wave & 3;
    const int c = h * 64 + lane;
    const bf16_t* proj = (const bf16_t*)(p.ws + OFF_PROJ);
    bf16_t* o_r = (bf16_t*)(p.ws + OFF_T);
    constexpr int NCH = SEQL / RTC;
    const int kp = lane >> 4, row = lane & 15, v0 = rq * 16 + row;
    f32x4 S4[4];
#pragma unroll
    for (int k = 0; k < 4; ++k) S4[k] = (f32x4){0.f, 0.f, 0.f, 0.f};
    f32x4 A[20], B[20]; float vv = 0.f, vvn = 0.f, oval = 0.f;
    const unsigned ring_addr = (unsigned)(unsigned long long)ring + (unsigned)(dir * RTC * 1536);
    const unsigned offk = ring_addr + kp * 64, offv = ring_addr + v0 * 4;
    bf16_t* orow = o_r + ((size_t)dir * MROWS + (size_t)b * SEQL) * RW + h * 64 + v0;
    const float w0c = p.in[8][(l * 2 + dir) * RW + c], a0c = p.in[10][(l * 2 + dir) * RW + c];
    const float kkc = p.in[13][l * RW + c], kac = p.in[14][l * RW + c];
    const float* mu0 = p.in[7] + (size_t)(l * 2 + 0) * NRW; const float* mu1 = mu0 + NRW;
    const float mr0 = mu0[c], mr1 = mu1[c], mk0 = mu0[384 + c], mk1 = mu1[384 + c], mv0 = mu0[768 + c], mv1 = mu1[768 + c];
    const int lcol = lane < 32 ? 1152 + dir * 32 + lane : 1216 + dir * 32 + (lane - 32);
    const float ml0 = mu0[lcol], ml1 = mu1[lcol];
    for (int chunk = 0; chunk < NCH; ++chunk) {
        {
            const int s0 = chunk * RTC + rq * 8;
            const int tlo = dir ? SEQL - 8 - s0 : s0;
            float rr[10], rk_[10], rv[10], rl[10];
#pragma unroll
            for (int q = 0; q < 10; ++q) {
                const int tr = tlo - 1 + q; const bool ok = (tr >= 0) && (tr < SEQL);
                const bf16_t* pr = proj + ((size_t)b * SEQL + (ok ? tr : 0)) * PS; const float m = ok ? 1.f : 0.f;
                rr[q] = m * bf2f(pr[P_R + c]); rk_[q] = m * bf2f(pr[P_K + c]); rv[q] = m * bf2f(pr[P_V + c]); rl[q] = m * bf2f(pr[P_RW + lcol]);
            }
            float rs[8], ks[8], vs[8], lo[8];
#pragma unroll
            for (int i = 0; i < 8; ++i) {
                const float rc = dir ? rr[8 - i] : rr[i + 1], rp = dir ? rr[7 - i] : rr[i], rn = dir ? rr[9 - i] : rr[i + 2];
                const float kc = dir ? rk_[8 - i] : rk_[i + 1], kp_ = dir ? rk_[7 - i] : rk_[i], kn = dir ? rk_[9 - i] : rk_[i + 2];
                const float vc = dir ? rv[8 - i] : rv[i + 1], vp = dir ? rv[7 - i] : rv[i], vn = dir ? rv[9 - i] : rv[i + 2];
                const float lc = dir ? rl[8 - i] : rl[i + 1], lp = dir ? rl[7 - i] : rl[i], ln = dir ? rl[9 - i] : rl[i + 2];
                rs[i] = rc + mr0 * (rp - rc) + mr1 * (rn - rc);
                ks[i] = kc + mk0 * (kp_ - kc) + mk1 * (kn - kc);
                vs[i] = vc + mv0 * (vp - vc) + mv1 * (vn - vc);
                lo[i] = lc + ml0 * (lp - lc) + ml1 * (ln - lc);
            }
            int zoff = 0; asm volatile("" : "+s"(zoff));
            float wup[32], aup[32];
            { const float* wu = p.in[9] + (size_t)((l * 2 + dir) * 32) * RW + c + zoff; const float* au = p.in[11] + (size_t)((l * 2 + dir) * 32) * RW + c + zoff;
#pragma unroll
              for (int r = 0; r < 32; ++r) { wup[r] = wu[(size_t)r * RW]; aup[r] = au[(size_t)r * RW]; } }
#pragma unroll
            for (int i = 0; i < 8; ++i) {
                const int sl = rq * 8 + i;
                const float e2 = __expf(2.f * lo[i]); const float th = 1.f - 2.f / (e2 + 1.f);
                const float x = lane < 32 ? th : lo[i];
                float wacc0 = w0c, wacc1 = 0.f, aacc0 = a0c, aacc1 = 0.f;
#pragma unroll
                for (int r = 0; r < 32; r += 2) {
                    wacc0 += rdlane(x, r) * wup[r]; wacc1 += rdlane(x, r + 1) * wup[r + 1];
                    aacc0 += rdlane(x, 32 + r) * aup[r]; aacc1 += rdlane(x, 33 + r) * aup[r + 1]; }
                const float wpre = wacc0 + wacc1, apre = aacc0 + aacc1;
                const float w = -__logf(1.f + __expf(-wpre)) - 0.5f;
                const float dec = __expf(-__expf(w));
                const float a = sigmoidf_(apre);
                float kk = ks[i] * kkc; const float n2 = wave_sum(kk * kk); kk = kk / fmaxf(sqrtf(n2), 1e-12f);
                const float kd = ks[i] * (1.f + (a - 1.f) * kac);
                LAS float* o = ring + (size_t)((dir * RTC + sl) * 6) * 64;
                o[0 * 64 + lane] = kk; o[1 * 64 + lane] = dec; o[2 * 64 + lane] = kk * a; o[3 * 64 + lane] = kd; o[4 * 64 + lane] = rs[i]; o[5 * 64 + lane] = vs[i];
            }
        }
        __syncthreads();
        {
            RW_ISSUE(A, offk, offv, vvn);
#pragma unroll 1
            for (int sl = 0; sl < RTC; sl += 2) {
                const unsigned bk1 = offk + (sl + 1) * 1536, bv1 = offv + (sl + 1) * 1536, bk2 = bk1 + 1536, bv2 = bv1 + 1536;
                const int s = chunk * RTC + sl;
                LGKM0(); vv = vvn; RW_ISSUE(B, bk1, bv1, vvn); SCHEDB; RW_COMPUTE(A); SCHEDB;
                if (kp == 0) { const int t = dir ? SEQL - 1 - s : s; orow[(size_t)t * RW] = (bf16_t)f2bf(oval); }
                LGKM0(); vv = vvn; RW_ISSUE(A, bk2, bv2, vvn); SCHEDB; RW_COMPUTE(B); SCHEDB;
                if (kp == 0) { const int t = dir ? SEQL - 2 - s : s + 1; orow[(size_t)t * RW] = (bf16_t)f2bf(oval); }
            }
            LGKM0();
        }
        __syncthreads();
    }
}

constexpr int TC = 16;
#define HG_ISSUE(BUF, bk, Q) do { \
    DSR128(BUF[0], bk, Q); DSR128(BUF[1], bk, Q + 16); DSR128(BUF[2], bk, Q + 32); DSR128(BUF[3], bk, Q + 48); \
    DSR128(BUF[4], bk, 256 + Q); DSR128(BUF[5], bk, 256 + Q + 16); DSR128(BUF[6], bk, 256 + Q + 32); DSR128(BUF[7], bk, 256 + Q + 48); \
    DSR128(BUF[8], bk, 512 + Q); DSR128(BUF[9], bk, 512 + Q + 16); DSR128(BUF[10], bk, 512 + Q + 32); DSR128(BUF[11], bk, 512 + Q + 48); } while (0)
#define HG_HALF(BUF, J) do { _Pragma("unroll") for (int i_ = 0; i_ < 4; ++i_) { \
    f32x4 sv = S4[4 * (J) + i_] * BUF[i_] + BUF[4 + i_] * iv; S4[4 * (J) + i_] = sv; oacc += sv * BUF[8 + i_]; } } while (0)

__device__ __forceinline__ void hgrn_scan_wg(const Params& p, int l, int grp, LAS unsigned char* lds) {
    const int tid = opaque_tid(), wave = tid >> 6, lane = tid & 63;
    constexpr int HTC = 16, NCH = SEQL / HTC;
    LAS float* ring = (LAS float*)lds;
    LAS float* lbt = (LAS float*)(lds + 4 * HTC * 4 * 64 * 4);
    bf16_t* proj = (bf16_t*)(p.ws + OFF_PROJ);
    for (int i = tid; i < 2 * RW; i += 512) { const int dr = i / RW, cc = i % RW; const float* lg = p.in[4] + (size_t)dr * 5 * RW + cc;
        float e[5], mx = -1e30f;
#pragma unroll
        for (int j = 0; j < 5; ++j) { e[j] = lg[j * RW]; mx = fmaxf(mx, e[j]); }
        float sum = 0.f, cum = 0.f;
#pragma unroll
        for (int j = 0; j < 5; ++j) { e[j] = __expf(e[j] - mx); sum += e[j]; if (j <= l) cum += e[j]; }
        lbt[i] = cum / sum; }
    __syncthreads();
    const int j = wave >> 1, half = wave & 1, kp = lane >> 5, col = half * 32 + (lane & 31);
    const int cch = grp * 4 + j;
    const int cdir = cch & 1, cb = (cch >> 1) / 6, chh = (cch >> 1) % 6;
    bf16_t* orow = proj + (size_t)cb * SEQL * PS + (cdir ? P_FB : P_FF) + chh * 64 + col;
    const bf16_t* prow = proj + (size_t)cb * SEQL * PS + chh * 64 + lane;
    const float lb = lbt[cdir * RW + chh * 64 + lane];
    f32x4 S4[8];
#pragma unroll
    for (int k = 0; k < 8; ++k) S4[k] = (f32x4){0.f, 0.f, 0.f, 0.f};
    f32x4 A[12], B[12], oacc = (f32x4){0.f, 0.f, 0.f, 0.f}; float iv = 0.f, ivn = 0.f;
    const unsigned ring_addr = (unsigned)(unsigned long long)ring;
    const unsigned cbase = ring_addr + (unsigned)((j * HTC) * 1024);
    const unsigned offk = cbase + kp * 128, offv = cbase + col * 4;
    for (int chunk = 0; chunk < NCH; ++chunk) {
        {
            float qv[8], fv[8], ivv[8];
#pragma unroll
            for (int i = 0; i < 8; ++i) {
                const int sl = half * 8 + i, s = chunk * HTC + sl, t = cdir ? SEQL - 1 - s : s;
                const bf16_t* pr = prow + (size_t)t * PS;
                qv[i] = bf2f(pr[P_Q]); fv[i] = bf2f(pr[cdir ? P_FB : P_FF]); ivv[i] = bf2f(pr[P_I]);
            }
#pragma unroll
            for (int i = 0; i < 8; ++i) {
                const int sl = half * 8 + i;
                const float f = lb + (1.f - lb) * sigmoidf_(fv[i]);
                LAS float* o = ring + (size_t)((j * HTC + sl) * 4) * 64;
                o[lane] = f; o[64 + lane] = 1.f - f; o[128 + lane] = qv[i]; o[192 + lane] = ivv[i];
            }
        }
        __syncthreads();
        {
            HG_ISSUE(A, offk, 0); DSR32(ivn, offv, 768);
#pragma unroll 1
            for (int sl = 0; sl < HTC; ++sl) {
                const unsigned bk = offk + sl * 1024, nbk = bk + 1024, nbv = offv + (sl + 1) * 1024;
                LGKM0(); iv = ivn; HG_ISSUE(B, bk, 64); SCHEDB; oacc = (f32x4){0.f, 0.f, 0.f, 0.f}; HG_HALF(A, 0); SCHEDB;
                LGKM0(); HG_ISSUE(A, nbk, 0); DSR32(ivn, nbv, 768); SCHEDB; HG_HALF(B, 1); SCHEDB;
                const float oval = xsum32((oacc.x + oacc.y) + (oacc.z + oacc.w));
                const int s = chunk * HTC + sl, t = cdir ? SEQL - 1 - s : s;
                if (kp == 0) orow[(size_t)t * PS] = (bf16_t)f2bf(oval);
            }
            LGKM0();
        }
        __syncthreads();
    }
}

__device__ __forceinline__ void conv_wg(const Params& p, int l, int first, int stride, LAS unsigned char* lds) {
    const int tid = opaque_tid(), wave = tid >> 6, lane = tid & 63;
    LAS float* z = (LAS float*)lds;
    LAS float* ot = (LAS float*)(lds + 62 * 256 * 4);
    bf16_t* proj = (bf16_t*)(p.ws + OFF_PROJ);
    const int ch = tid & 255, half = tid >> 8;
    float w[31];
#pragma unroll
    for (int j = 0; j < 31; ++j) w[j] = p.in[18][(size_t)(l * 31 + j) * 256 + ch];
    const float cb = p.in[19][l * 256 + ch];
    const f32x4 lg = ((const f32x4*)(p.in[20] + l * 256))[lane], lbv = ((const f32x4*)(p.in[21] + l * 256))[lane];
    for (int tile = first; tile < MROWS / 32; tile += stride) {
        const int row0 = tile * 32, b = row0 / SEQL, t0 = row0 % SEQL;
        for (int r = half; r < 62; r += 2) { const int t = t0 - 15 + r; float zz = 0.f;
            if (t >= 0 && t < SEQL) { const bf16_t* pr = proj + ((size_t)b * SEQL + t) * PS; zz = bf2f(pr[P_CV + ch]) * sigmoidf_(bf2f(pr[P_CG + ch])); }
            z[r * 256 + ch] = zz; }
        __syncthreads();
#pragma unroll 4
        for (int tt = 0; tt < 16; ++tt) { const int tok = half * 16 + tt; float acc = cb;
#pragma unroll
            for (int j = 0; j < 31; ++j) acc += w[j] * z[(tok + j) * 256 + ch];
            ot[tok * 256 + ch] = acc; }
        __syncthreads();
#pragma unroll
        for (int q = 0; q < 4; ++q) { const int tok = wave * 4 + q;
            f32x4 v = *(const LAS f32x4*)(ot + tok * 256 + lane * 4);
            const float mean = wave_sum((v.x + v.y) + (v.z + v.w)) * (1.f / 256.f);
            v = v - mean;
            const float var = wave_sum((v.x * v.x + v.y * v.y) + (v.z * v.z + v.w * v.w)) * (1.f / 256.f);
            const float rstd = rsqrtf(var + LN_EPS);
            f32x4 y = v * rstd * lg + lbv;
            y.x = y.x * sigmoidf_(y.x); y.y = y.y * sigmoidf_(y.y); y.z = y.z * sigmoidf_(y.z); y.w = y.w * sigmoidf_(y.w);
            u32x2 wv; wv.x = pk2(y.x, y.y); wv.y = pk2(y.z, y.w);
            *(u32x2*)(proj + (size_t)(row0 + tok) * PS + P_YC + lane * 4) = wv; }
        __syncthreads();
    }
}

__device__ __forceinline__ void combine_phase(const Params& p, int l, int widx, int nw, LAS unsigned char* lds) {
    const int tid = opaque_tid(), lane = tid & 63;
    bf16_t* proj = (bf16_t*)(p.ws + OFF_PROJ);
    const bf16_t* o_r = (const bf16_t*)(p.ws + OFF_T);
    LAS unsigned* WA = (LAS unsigned*)lds;
    LAS unsigned* WG = (LAS unsigned*)(lds + 49152);
    {
        const float* aup = p.in[11] + (size_t)(l * 2 * 32) * RW; const float* gup = p.in[12] + (size_t)(l * 64) * RW;
        for (int i = tid; i < 2 * 32 * 3 * 64; i += 512) { const int ln = i & 63, hp = (i >> 6) % 3, dr = i / 192; const float* s = aup + (size_t)dr * RW + (2 * hp) * 64 + ln; WA[i] = pk2(s[0], s[64]); }
        for (int i = tid; i < 64 * 3 * 64; i += 512) { const int ln = i & 63, hp = (i >> 6) % 3, r = i / 192; const float* s = gup + (size_t)r * RW + (2 * hp) * 64 + ln; WG[i] = pk2(s[0], s[64]); }
    }
    __syncthreads();
    const float* mu0 = p.in[7] + (size_t)(l * 2 + 0) * NRW; const float* mu1 = mu0 + NRW;
    const float mad0 = mu0[1216 + lane], mad1 = mu1[1216 + lane], mgd0 = mu0[1280 + lane], mgd1 = mu1[1280 + lane];
    for (int g4 = widx; g4 < MROWS / 2; g4 += nw) {
        const int row0 = g4 * 2;
        float adv[2], sgv[2];
#pragma unroll
        for (int tt = 0; tt < 2; ++tt) { const int row = row0 + tt, t = row % SEQL; const bf16_t* pr = proj + (size_t)row * PS;
            const bool hp = t > 0, hn = t < SEQL - 1; const bf16_t* pp = hp ? pr - PS : pr; const bf16_t* pn = hn ? pr + PS : pr; const float fp = hp ? 1.f : 0.f, fn = hn ? 1.f : 0.f;
            const float ac = bf2f(pr[P_AD + lane]), ap = fp * bf2f(pp[P_AD + lane]), an = fn * bf2f(pn[P_AD + lane]);
            const float gc = bf2f(pr[P_GD + lane]), gp = fp * bf2f(pp[P_GD + lane]), gn = fn * bf2f(pn[P_GD + lane]);
            adv[tt] = ac + mad0 * (ap - ac) + mad1 * (an - ac);
            sgv[tt] = sigmoidf_(gc + mgd0 * (gp - gc) + mgd1 * (gn - gc)); }
        float A0[2][6], A1[2][6], G[2][6];
#pragma unroll
        for (int tt = 0; tt < 2; ++tt)
#pragma unroll
            for (int h = 0; h < 6; ++h) { A0[tt][h] = 0.f; A1[tt][h] = 0.f; G[tt][h] = 0.f; }
#pragma unroll 4
        for (int r = 0; r < 32; ++r) {
            float w0[6], w1[6];
#pragma unroll
            for (int hp = 0; hp < 3; ++hp) { const unsigned u0 = WA[(r * 3 + hp) * 64 + lane], u1 = WA[((32 + r) * 3 + hp) * 64 + lane];
                w0[2 * hp] = __uint_as_float(u0 << 16); w0[2 * hp + 1] = __uint_as_float(u0 & 0xffff0000u); w1[2 * hp] = __uint_as_float(u1 << 16); w1[2 * hp + 1] = __uint_as_float(u1 & 0xffff0000u); }
#pragma unroll
            for (int tt = 0; tt < 2; ++tt) { const float s0 = rdlane(adv[tt], r), s1 = rdlane(adv[tt], 32 + r);
#pragma unroll
                for (int h = 0; h < 6; ++h) { A0[tt][h] += s0 * w0[h]; A1[tt][h] += s1 * w1[h]; } }
        }
#pragma unroll 4
        for (int r = 0; r < 64; ++r) {
            float wg[6];
#pragma unroll
            for (int hp = 0; hp < 3; ++hp) { const unsigned u = WG[(r * 3 + hp) * 64 + lane]; wg[2 * hp] = __uint_as_float(u << 16); wg[2 * hp + 1] = __uint_as_float(u & 0xffff0000u); }
#pragma unroll
            for (int tt = 0; tt < 2; ++tt) { const float s = rdlane(sgv[tt], r);
#pragma unroll
                for (int h = 0; h < 6; ++h) G[tt][h] += s * wg[h]; }
        }
#pragma unroll
        for (int h = 0; h < 6; ++h) {
            const int c = h * 64 + lane;
            const float a00 = p.in[10][(l * 2 + 0) * RW + c], a01 = p.in[10][(l * 2 + 1) * RW + c], kac = p.in[14][l * RW + c];
            const float rk = p.in[15][(l * 6 + h) * 64 + lane], gng = p.in[16][l * RW + c], gnb = p.in[17][l * RW + c], ng = p.in[6][l * RW + c];
            const float mr0 = mu0[c], mr1 = mu1[c], mk0 = mu0[384 + c], mk1 = mu1[384 + c], mv0 = mu0[768 + c], mv1 = mu1[768 + c];
#pragma unroll
            for (int tt = 0; tt < 2; ++tt) { const int row = row0 + tt, t = row % SEQL; bf16_t* pr = proj + (size_t)row * PS;
                const bool hp = t > 0, hn = t < SEQL - 1; const bf16_t* pp = hp ? pr - PS : pr; const bf16_t* pn = hn ? pr + PS : pr; const float fp = hp ? 1.f : 0.f, fn = hn ? 1.f : 0.f;
                const float rc = bf2f(pr[P_R + c]), rp = fp * bf2f(pp[P_R + c]), rn = fn * bf2f(pn[P_R + c]);
                const float kc = bf2f(pr[P_K + c]), kp = fp * bf2f(pp[P_K + c]), kn = fn * bf2f(pn[P_K + c]);
                const float vc = bf2f(pr[P_V + c]), vp = fp * bf2f(pp[P_V + c]), vn = fn * bf2f(pn[P_V + c]);
                const float rs = rc + mr0 * (rp - rc) + mr1 * (rn - rc);
                const float ks = kc + mk0 * (kp - kc) + mk1 * (kn - kc);
                const float vs = vc + mv0 * (vp - vc) + mv1 * (vn - vc);
                const float a0 = sigmoidf_(a00 + A0[tt][h]), a1 = sigmoidf_(a01 + A1[tt][h]);
                const float kh = ks * (1.f + (0.5f * (a0 + a1) - 1.f) * kac);
                const float bsum = wave_sum(rs * kh * rk);
                const float o = bf2f(o_r[(size_t)row * RW + c]) + bf2f(o_r[((size_t)MROWS + row) * RW + c]);
                const float mean = wave_sum(o) * (1.f / 64.f); const float dlt = o - mean;
                const float var = wave_sum(dlt * dlt) * (1.f / 64.f);
                const float on = dlt * rsqrtf(var + GN_EPS) * gng + gnb;
                const float yr = (on + bsum * vs) * G[tt][h];
                const float oh = bf2f(pr[P_FF + c]) + bf2f(pr[P_FB + c]);
                const float ms = wave_sum(oh * oh) * (1.f / 64.f);
                const float gh = bf2f(pr[P_G + c]);
                const float yh = oh * rsqrtf(ms + RMS_EPS) * ng * (gh * sigmoidf_(gh));
                pr[P_I + c] = (bf16_t)f2bf(yr);
                pr[P_Q + c] = (bf16_t)f2bf(yh);
            }
        }
    }
}

__global__ void __launch_bounds__(512, 2) fwd_mega(Params p) {
    extern __shared__ __attribute__((aligned(16))) unsigned char smem_raw[];
    LAS unsigned char* lds = (LAS unsigned char*)smem_raw;
    cg::grid_group grid = cg::this_grid();
    const int tid = threadIdx.x, wave = tid >> 6, lane = tid & 63;
    const int G = gridDim.x, bid = blockIdx.x;
    const int widx = bid * 8 + wave, nw = G * 8;
    bf16_t* win_t = (bf16_t*)(p.ws + OFF_WIN); bf16_t* wout_t = (bf16_t*)(p.ws + OFF_WOUT); bf16_t* wup_t = (bf16_t*)(p.ws + OFF_WUP); bf16_t* wdn_t = (bf16_t*)(p.ws + OFF_WDN);
    bf16_t* proj = (bf16_t*)(p.ws + OFF_PROJ); bf16_t* xb = (bf16_t*)(p.ws + OFF_T); bf16_t* hid = proj;
    float* x = p.out;
    volatile LAS unsigned* xst = (volatile LAS unsigned*)(lds + 131072);
    if (tid == 0) { xst[0] = 0u; xst[1] = 0u; xst[2] = 0u; xst[3] = 0u; }
    __syncthreads();
    XcdBarrier xbar = xcd_barrier_post((unsigned*)(p.ws + OFF_BAR), xst);

    convert_weights(p, 0, lds, widx, nw);
    for (int row = widx; row < MROWS; row += nw) {
        const float* src = row < 16 * SEQL ? p.in[0] + (size_t)row * D : p.in[1] + (size_t)(row - 16 * SEQL) * D;
        ln_row(src, x + (size_t)row * D, xb + (size_t)row * D, p.in[2], p.in[3], lane);
    }
    grid.sync();
    for (int l = 0; l < DEPTH; ++l) {
        {
            pg8::Gemm g{xb, win_t, MROWS, NINP, D, D}; pg8::StaticOrder S; S.init(MROWS, NINP, G, bid);
            pg8::EpiBf16<0> E{proj + 256, PS};
            for (int rep = 0; rep < REP_GIN; ++rep) pg8::gemm_phase(lds, g, S, E);
        }
        GSYNC();
        for (int rep = 0; rep < REP_SCAN; ++rep) {
            if (bid < 144) rwkv_scan_wg(p, l, bid, lds);
            else if (bid < 216) { if (rep == 0) hgrn_scan_wg(p, l, bid - 144, lds); }
            else { }
        }
        GSYNC();
        conv_wg(p, l, bid, G, lds);
        for (int rep = 0; rep < REP_COMB; ++rep) combine_phase(p, l, widx, nw, lds);
        GSYNC();
        {
            pg8::Gemm g{proj, wout_t, MROWS, D, D, PS}; pg8::StaticOrder S; S.init(MROWS, D, G, bid);
            pg8::EpiResid E{x, D, DN_ALPHA};
            pg8::gemm_phase(lds, g, S, E);
        }
        GSYNC();
        for (int row = widx; row < MROWS; row += nw)
            ln_row(x + (size_t)row * D, x + (size_t)row * D, xb + (size_t)row * D, p.in[23] + l * D, p.in[24] + l * D, lane);
        GSYNC();
        for (int third = 0; third < 3; ++third) {
            constexpr int MT = MROWS / 3;
            {   pg8::Gemm g{xb + (size_t)third * MT * D, wup_t, MT, FFN, D, D}; pg8::StaticOrder S; S.init(MT, FFN, G, bid);
                pg8::EpiBf16<1> E{hid, FFN};
                for (int rep = 0; rep < REP_UP; ++rep) pg8::gemm_phase(lds, g, S, E); }
            GSYNC();
            {   pg8::Gemm g{hid, wdn_t, MT, D, FFN, FFN}; pg8::StaticOrder S; S.init(MT, D, G, bid);
                pg8::EpiResid E{x + (size_t)third * MT * D, D, DN_ALPHA};
                pg8::gemm_phase(lds, g, S, E); }
            GSYNC();
        }
        if (l + 1 < DEPTH) convert_weights(p, l + 1, lds, widx, nw);
        for (int row = widx; row < MROWS; row += nw)
            ln_row(x + (size_t)row * D, x + (size_t)row * D, xb + (size_t)row * D, p.in[27] + l * D, p.in[28] + l * D, lane);
        GSYNC();
    }
}

extern "C" void kernel_launch(void* const* d_in, const int* in_sizes, int n_in, void* d_out, int out_size, void* d_ws, size_t ws_size, hipStream_t stream) {
    static int grid = 0;
    if (grid == 0) {
        if (n_in != 29 || out_size != MROWS * D || ws_size < WS_END) { fprintf(stderr, "kernel_launch: unexpected shapes (n_in %d out %d ws %zu need %zu)\n", n_in, out_size, ws_size, (size_t)WS_END); grid = -1; return; }
        int dev = 0, cus = 0, per_cu = 0;
        hipGetDevice(&dev);
        hipDeviceGetAttribute(&cus, hipDeviceAttributeMultiprocessorCount, dev);
        if (hipFuncSetAttribute((const void*)fwd_mega, hipFuncAttributeMaxDynamicSharedMemorySize, LDS_BYTES) != hipSuccess) { fprintf(stderr, "kernel_launch: hipFuncSetAttribute failed\n"); grid = -1; return; }
        hipOccupancyMaxActiveBlocksPerMultiprocessor(&per_cu, (const void*)fwd_mega, 512, LDS_BYTES);
        (void)hipGetLastError();
        if (per_cu < 1) per_cu = 1;
        grid = cus;
        if (grid != 256) fprintf(stderr, "kernel_launch: note: %d CUs\n", grid);
    }
    if (grid < 0) return;
    if (hipMemsetAsync((char*)d_ws + OFF_BAR, 0, SZ_BAR, stream) != hipSuccess) { fprintf(stderr, "kernel_launch: memset failed\n"); return; }
    Params p{};
    for (int i = 0; i < 29; ++i) p.in[i] = (const float*)d_in[i];
    p.out = (float*)d_out; p.ws = (unsigned char*)d_ws;
    void* args[] = {&p};
    hipError_t e = hipLaunchCooperativeKernel((const void*)fwd_mega, dim3(grid), dim3(512), args, LDS_BYTES, stream);
    if (e != hipSuccess) fprintf(stderr, "cooperative launch failed: %s (grid %d)\n", hipGetErrorString(e), grid);
}
```

```cpp
#include <hip/hip_runtime.h>
#include <hip/hip_cooperative_groups.h>
#include <cstdio>
#include <cstdint>
namespace cg = cooperative_groups;

#define LAS __attribute__((address_space(3)))
typedef unsigned short bf16_t;
typedef short bf16x8 __attribute__((ext_vector_type(8)));
typedef float f32x4 __attribute__((ext_vector_type(4)));
typedef unsigned u32x4 __attribute__((ext_vector_type(4)));
typedef unsigned u32x2 __attribute__((ext_vector_type(2)));

constexpr int D = 1024, SEQL = 2048, NSEQ = 24, MROWS = NSEQ * SEQL, DEPTH = 4, FFN = 4096;
constexpr int NIN = 3776, NINP = 3840, PS = 4096;
constexpr int RW = 384, NRW = 1344;
constexpr int P_YC = 0, P_Q = 256, P_I = 640, P_FF = 1024, P_FB = 1408, P_G = 1792;
constexpr int P_RW = 2176, P_R = P_RW, P_K = P_RW + 384, P_V = P_RW + 768, P_WD = P_RW + 1152, P_AD = P_RW + 1216, P_GD = P_RW + 1280;
constexpr int P_CV = 3520, P_CG = 3776;
constexpr float LN_EPS = 1e-5f, RMS_EPS = 1e-6f, GN_EPS = 64e-5f;
constexpr float DN_ALPHA = 1.681792830507429f;

constexpr size_t OFF_WIN = 0, SZ_WIN = (size_t)NINP * D * 2;
constexpr size_t OFF_WOUT = OFF_WIN + SZ_WIN, SZ_WOUT = (size_t)D * D * 2;
constexpr size_t OFF_WUP = OFF_WOUT + SZ_WOUT, SZ_WUP = (size_t)FFN * D * 2;
constexpr size_t OFF_WDN = OFF_WUP + SZ_WUP, SZ_WDN = (size_t)FFN * D * 2;
constexpr size_t OFF_PROJ = OFF_WDN + SZ_WDN, SZ_PROJ = (size_t)MROWS * PS * 2;
constexpr size_t OFF_T = OFF_PROJ + SZ_PROJ, SZ_T = (size_t)MROWS * D * 2;
constexpr size_t OFF_BAR = OFF_T + SZ_T, SZ_BAR = 3456 * 4;
constexpr size_t WS_END = OFF_BAR + SZ_BAR;
constexpr int LDS_BYTES = 131072 + 16;
#define REP_SCAN 1
#define REP_COMB 1
#define REP_GIN 1
#define REP_UP 1
#define REP_SYNC 1
#define GSYNC() do { for (int r_ = 0; r_ < REP_SYNC; ++r_) xcd_barrier(xbar); } while (0)

struct Params {
    const float* in[29];
    float* out;
    unsigned char* ws;
};

__device__ __forceinline__ float bf2f(bf16_t b) { return __uint_as_float(((unsigned)b) << 16); }
__device__ __forceinline__ unsigned f2bf(float f) { unsigned u = __float_as_uint(f); u += 0x7FFFu + ((u >> 16) & 1u); return u >> 16; }
__device__ __forceinline__ unsigned pk2(float lo, float hi) { return f2bf(lo) | (f2bf(hi) << 16); }
__device__ __forceinline__ float dpp_add(float v, const int ctrl_sel) {
    int r;
    switch (ctrl_sel) {
        case 0: r = __builtin_amdgcn_update_dpp(0, __float_as_int(v), 0xB1, 0xF, 0xF, true); break;
        case 1: r = __builtin_amdgcn_update_dpp(0, __float_as_int(v), 0x4E, 0xF, 0xF, true); break;
        case 2: r = __builtin_amdgcn_update_dpp(0, __float_as_int(v), 0x141, 0xF, 0xF, true); break;
        default: r = __builtin_amdgcn_update_dpp(0, __float_as_int(v), 0x140, 0xF, 0xF, true); break;
    }
    return v + __int_as_float(r);
}
__device__ __forceinline__ float wave_sum(float v) {
    v = dpp_add(v, 0); v = dpp_add(v, 1); v = dpp_add(v, 2); v = dpp_add(v, 3);
    { auto r = __builtin_amdgcn_permlane16_swap(__float_as_uint(v), __float_as_uint(v), false, false); v = __uint_as_float(r[0]) + __uint_as_float(r[1]); }
    { auto r = __builtin_amdgcn_permlane32_swap(__float_as_uint(v), __float_as_uint(v), false, false); v = __uint_as_float(r[0]) + __uint_as_float(r[1]); }
    return v;
}
__device__ __forceinline__ int opaque_tid() { int t = threadIdx.x; asm volatile("" : "+v"(t)); return t; }
__device__ __forceinline__ float sigmoidf_(float x) { return 1.0f / (1.0f + __expf(-x)); }
__device__ __forceinline__ float rdlane(float v, int l) { return __int_as_float(__builtin_amdgcn_readlane(__float_as_int(v), l)); }

#define XB_TMO      128
#define XB_XCNT(j)  (256  + 64 * (j))
#define XB_XSUB(j)  (1280 + 64 * (j))
#define XB_XGEN(j)  (2304 + 64 * (j))
#define XB_TOP      3328
#define XB_TOPGEN   3392
#define XCD_BAR_WORDS 3456
#define XB_SPIN_CAP (1u << 22)
__device__ __forceinline__ unsigned xb_ld(unsigned* p)              { return __hip_atomic_load(p, __ATOMIC_RELAXED, __HIP_MEMORY_SCOPE_AGENT); }
__device__ __forceinline__ unsigned xb_add(unsigned* p, unsigned v) { return __hip_atomic_fetch_add(p, v, __ATOMIC_RELAXED, __HIP_MEMORY_SCOPE_AGENT); }
__device__ __forceinline__ unsigned xb_xcc_id() { return (unsigned)__builtin_amdgcn_s_getreg((3 << 11) | 20) & 0xFu; }
#define XB_SPIN(cond, bar) do { unsigned _sp = 0; while (cond) { __builtin_amdgcn_s_sleep(1); \
    if ((++_sp & 255u) == 0u) { if (xb_ld(&(bar)[XB_TMO])) break; if (_sp > XB_SPIN_CAP) { atomicAdd(&(bar)[XB_TMO], 1u); break; } } } } while (0)
struct XcdBarrier { unsigned* bar; unsigned x; volatile LAS unsigned* st; };
__device__ __forceinline__ XcdBarrier xcd_barrier_post(unsigned* bar, volatile LAS unsigned* st) {
    XcdBarrier b; b.bar = bar; b.x = xb_xcc_id(); b.st = st;
    if (threadIdx.x == 0) (void)xb_add(&bar[XB_XCNT(b.x)], 1u);
    return b;
}
__device__ __forceinline__ void xcd_barrier_complete(unsigned* bar, unsigned x, unsigned& nloc, unsigned& nx) {
    const unsigned G = gridDim.x * gridDim.y * gridDim.z;
    unsigned sum, cnt, mine, sp = 0u;
    for (;;) {
        sum = 0u; cnt = 0u; mine = 0u;
#pragma unroll
        for (unsigned j = 0; j < 16; ++j) { const unsigned c = xb_ld(&bar[XB_XCNT(j)]); sum += c; cnt += (c > 0u) ? 1u : 0u; mine = (j == x) ? c : mine; }
        if (sum == G) break;
        __builtin_amdgcn_s_sleep(1);
        if ((++sp & 255u) == 0u) { if (xb_ld(&bar[XB_TMO])) break; if (sp > XB_SPIN_CAP) { atomicAdd(&bar[XB_TMO], 1u); break; } }
    }
    nloc = mine > 0u ? mine : 1u; nx = cnt > 0u ? cnt : 1u;
}
__device__ __forceinline__ void xcd_barrier(const XcdBarrier& b) {
    asm volatile("s_waitcnt vmcnt(0)" ::: "memory");
    __syncthreads();
    if (threadIdx.x == 0) {
        unsigned* bar = b.bar;
        __builtin_amdgcn_s_waitcnt(0);
        unsigned nloc = b.st[0], nx = b.st[1];
        if (nloc == 0u) { xcd_barrier_complete(bar, b.x, nloc, nx); b.st[0] = nloc; b.st[1] = nx; }
        const unsigned old = xb_add(&bar[XB_XSUB(b.x)], 1u);
        const unsigned gen = old / nloc;
        if (old + 1u == (gen + 1u) * nloc) {
            __builtin_amdgcn_fence(__ATOMIC_RELEASE, "agent");
            asm volatile("s_waitcnt vmcnt(0)" ::: "memory");
            const unsigned og = xb_add(&bar[XB_TOP], 1u);
            const unsigned tg = og / nx;
            if (og + 1u == (tg + 1u) * nx) xb_add(&bar[XB_TOPGEN], 1u);
            else XB_SPIN(xb_ld(&bar[XB_TOPGEN]) == tg, bar);
            __builtin_amdgcn_fence(__ATOMIC_ACQUIRE, "agent");
            xb_add(&bar[XB_XGEN(b.x)], 1u);
            asm volatile("s_waitcnt vmcnt(0)" ::: "memory");
        } else {
            XB_SPIN(xb_ld(&bar[XB_XGEN(b.x)]) == gen, bar);
            __builtin_amdgcn_fence(__ATOMIC_ACQUIRE, "agent");
            asm volatile("s_waitcnt vmcnt(0)" ::: "memory");
        }
    }
    __syncthreads();
}

namespace pg8 {
constexpr int BM = 256, BK = 64, HALF = 128, HTB = HALF * BK * 2, STAGE_BYTES = 8 * HTB, NXCD = 8, WGM = 8;
__device__ __forceinline__ int lds_byte(int r, int c) { const int st = (r >> 4) * 2 + (c >> 5), rr = r & 15, cc = c & 31, ob = rr * 64 + cc * 2; return st * 1024 + (ob ^ (((ob >> 9) & 1) << 5)); }
__device__ __forceinline__ void stage_rc(int b, int& R, int& C) { const int st = b / 1024, sb = b % 1024, swz = sb ^ (((sb >> 9) & 1) << 5); R = (st >> 1) * 16 + swz / 64; C = (st & 1) * 32 + (swz % 64) / 2; }
__device__ __forceinline__ int perm32(int rho) { const int n = rho >> 4, i = rho & 15; return 8 * (i >> 2) + 4 * n + (i & 3); }
struct Unit { int pm, pn; };
struct Gemm { const bf16_t* A; const bf16_t* Bt; int M, N, K, lda; };
struct StaticOrder {
    int nM, nN, nwg, G, c;
    __device__ void init(int M, int N, int G_, int c_) { nM = M / BM; nN = N / BM; nwg = nM * nN; G = G_; c = c_; }
    __device__ bool next(int i, Unit& u) const {
        const long L = (long)i * G + c; if (L >= nwg) return false;
        int wgid = (int)L; { const int q = nwg / NXCD, r = nwg % NXCD, xcd = wgid % NXCD, off = wgid / NXCD; wgid = (xcd < r ? xcd * (q + 1) : r * (q + 1) + (xcd - r) * q) + off; }
        const int nig = WGM * nN, gid = wgid / nig, fm = gid * WGM, gsz = (nM - fm) < WGM ? (nM - fm) : WGM;
        u.pm = fm + ((wgid % nig) % gsz); u.pn = (wgid % nig) / gsz; return true;
    }
};
__device__ __forceinline__ unsigned cvt_pk_bf16(float lo, float hi) { unsigned r; asm volatile("v_cvt_pk_bf16_f32 %0, %1, %2" : "=v"(r) : "v"(lo), "v"(hi)); return r; }

template <int ACT  > struct EpiBf16 {
    static constexpr bool PERM = true;
    bf16_t* O; int ldc;
    __device__ __forceinline__ void operator()(const f32x4 (&acc)[2][2][4][2], const Unit& u, int wr, int wc, int fr, int fq) const {
        const int row0 = u.pm * BM + wr * 64 + fr; const int col0 = u.pn * BM + wc * 32 + 8 * fq;
#pragma unroll
        for (int ai = 0; ai < 2; ++ai)
#pragma unroll
            for (int m = 0; m < 4; ++m) { bf16_t* rowp = O + (size_t)(row0 + ai * HALF + m * 16) * ldc + col0;
#pragma unroll
                for (int bj = 0; bj < 2; ++bj) { f32x4 v0 = acc[ai][bj][m][0], v1 = acc[ai][bj][m][1];
                    if (ACT == 1) {
#pragma unroll
                        for (int j = 0; j < 4; ++j) { float a = fmaxf(v0[j], 0.f), b = fmaxf(v1[j], 0.f); v0[j] = a * a; v1[j] = b * b; } }
                    u32x4 w; w.x = cvt_pk_bf16(v0[0], v0[1]); w.y = cvt_pk_bf16(v0[2], v0[3]); w.z = cvt_pk_bf16(v1[0], v1[1]); w.w = cvt_pk_bf16(v1[2], v1[3]);
                    *(u32x4*)(rowp + bj * HALF) = w; } }
    }
};
struct EpiResid {
    static constexpr bool PERM = false;
    float* C; int ldc; float alpha;
    __device__ __forceinline__ void operator()(const f32x4 (&acc)[2][2][4][2], const Unit& u, int wr, int wc, int fr, int fq) const {
        const int row0 = u.pm * BM + wr * 64 + fr, col0 = u.pn * BM + wc * 32 + 4 * fq;
#pragma unroll
        for (int ai = 0; ai < 2; ++ai)
#pragma unroll
            for (int m = 0; m < 4; ++m) { float* rowp = C + (size_t)(row0 + ai * HALF + m * 16) * ldc + col0;
                f32x4 old[2][2];
#pragma unroll
                for (int bj = 0; bj < 2; ++bj)
#pragma unroll
                    for (int n = 0; n < 2; ++n) old[bj][n] = *(const f32x4*)(rowp + bj * HALF + n * 16);
#pragma unroll
                for (int bj = 0; bj < 2; ++bj)
#pragma unroll
                    for (int n = 0; n < 2; ++n) *(f32x4*)(rowp + bj * HALF + n * 16) = old[bj][n] * alpha + acc[ai][bj][m][n]; }
    }
};

template <class Epi, class Sched>
__device__ __forceinline__ void gemm_phase(LAS unsigned char* lds, const Gemm g, const Sched& S, const Epi& E) {
    const int tid = opaque_tid(), wid = __builtin_amdgcn_readfirstlane(tid >> 6), lane = tid & 63, wr = wid >> 2, wc = wid & 3, fr = lane & 15, fq = lane >> 4;
    const int K = g.K, nt = K / BK, lda = g.lda;
    unsigned voffA[2], voffB[2];
#pragma unroll
    for (int i = 0; i < 2; ++i) { int R, C; stage_rc(tid * 16 + i * 8192, R, C); const int Rb = Epi::PERM ? ((R & ~31) + perm32(R & 31)) : R;
        voffA[i] = (unsigned)(R * lda + C) * 2u; voffB[i] = (unsigned)(Rb * K + C) * 2u; }
    const size_t kstep = (size_t)(BK * 2);
    const size_t hstepA = (size_t)HALF * lda * 2, hstepB = (size_t)HALF * K * 2;
    const size_t tstepA = 2 * hstepA, tstepB = 2 * hstepB;
    const unsigned ldsw = (unsigned)wid * 1024u;
    const int aoff = lds_byte(wr * 64 + fr, fq * 8), boff = lds_byte(wc * 32 + fr, fq * 8);
#define PG8_SA(b, h) (((b) * 2 + (h)) * HTB)
#define PG8_SB(b, h) ((4 + (b) * 2 + (h)) * HTB)
#define PG8_STAGE(bufoff, gbase, voff) do { _Pragma("unroll") for (int _i = 0; _i < 2; ++_i) \
        __builtin_amdgcn_global_load_lds((const unsigned*)((const char*)(gbase) + (voff)[_i]), (LAS unsigned*)(lds + (bufoff) + ldsw + _i * 8192), 16, 0, 0); } while (0)
#define PG8_LDA(dst, b, h) do { _Pragma("unroll") for (int m = 0; m < 4; ++m) _Pragma("unroll") for (int k = 0; k < 2; ++k) dst[m][k] = *(const LAS bf16x8*)(lds + PG8_SA(b, h) + aoff + m * 2048 + k * 1024); } while (0)
#define PG8_LDB(dst, b, h) do { _Pragma("unroll") for (int n = 0; n < 2; ++n) _Pragma("unroll") for (int k = 0; k < 2; ++k) dst[n][k] = *(const LAS bf16x8*)(lds + PG8_SB(b, h) + boff + n * 2048 + k * 1024); } while (0)
#define PG8_MMA(ai, bj, At, Bt) do { __builtin_amdgcn_s_setprio(1); _Pragma("unroll") for (int m = 0; m < 4; ++m) _Pragma("unroll") for (int n = 0; n < 2; ++n) _Pragma("unroll") for (int k = 0; k < 2; ++k) \
        acc[ai][bj][m][n] = __builtin_amdgcn_mfma_f32_16x16x32_bf16(Bt[n][k], At[m][k], acc[ai][bj][m][n], 0, 0, 0); __builtin_amdgcn_s_setprio(0); } while (0)
#define PG8_WAIT_V(n) asm volatile("s_waitcnt vmcnt(" #n ")" ::: "memory")
#define PG8_WAIT_L(n) asm volatile("s_waitcnt lgkmcnt(" #n ")" ::: "memory")
#define PG8_BAR __builtin_amdgcn_s_barrier()
#define PG8_SCHED __builtin_amdgcn_sched_barrier(0)
    Unit cur, nxt; int ui = 0;
    if (!S.next(0, cur)) return;
    f32x4 acc[2][2][4][2];
#pragma unroll
    for (int a = 0; a < 2; ++a)
#pragma unroll
        for (int b = 0; b < 2; ++b)
#pragma unroll
            for (int m = 0; m < 4; ++m)
#pragma unroll
                for (int n = 0; n < 2; ++n) acc[a][b][m][n] = (f32x4){0.f, 0.f, 0.f, 0.f};
    bf16x8 At[4][2], B0[2][2], B1[2][2];
    const char* cA = (const char*)g.A + (size_t)cur.pm * tstepA; const char* cB = (const char*)g.Bt + (size_t)cur.pn * tstepB;
    PG8_STAGE(PG8_SB(0, 0), cB, voffB); PG8_STAGE(PG8_SA(0, 0), cA, voffA); PG8_STAGE(PG8_SB(0, 1), cB + hstepB, voffB); PG8_STAGE(PG8_SA(0, 1), cA + hstepA, voffA);
    if (wr == 1) PG8_BAR;
    PG8_WAIT_V(4); PG8_BAR;
    PG8_STAGE(PG8_SB(1, 0), cB + kstep, voffB); PG8_STAGE(PG8_SA(1, 0), cA + kstep, voffA); PG8_STAGE(PG8_SB(1, 1), cB + hstepB + kstep, voffB);
    PG8_WAIT_V(6); PG8_BAR;
    for (;;) {
        const bool has_next = S.next(ui + 1, nxt);
        const char* nA = has_next ? (const char*)g.A + (size_t)nxt.pm * tstepA : cA; const char* nB = has_next ? (const char*)g.Bt + (size_t)nxt.pn * tstepB : cB;
        for (int t = 0; t < nt; t += 2) {
            const bool last = (t == nt - 2);
            const char* a1 = cA + (size_t)(t + 1) * kstep;
            const char* a2 = last ? nA : cA + (size_t)(t + 2) * kstep; const char* b2 = last ? nB : cB + (size_t)(t + 2) * kstep;
            const char* a3 = a2 + kstep; const char* b3 = b2 + kstep;
            PG8_LDB(B0, 0, 0); PG8_SCHED; PG8_LDA(At, 0, 0); PG8_STAGE(PG8_SA(1, 1), a1 + hstepA, voffA);
            PG8_WAIT_L(8); PG8_BAR; PG8_WAIT_L(0); PG8_MMA(0, 0, At, B0); PG8_BAR; PG8_SCHED;
            PG8_LDB(B1, 0, 1); PG8_STAGE(PG8_SB(0, 0), b2, voffB);
            PG8_BAR; PG8_WAIT_L(0); PG8_MMA(0, 1, At, B1); PG8_BAR;
            PG8_LDA(At, 0, 1); PG8_STAGE(PG8_SA(0, 0), a2, voffA);
            PG8_BAR; PG8_WAIT_L(0); PG8_MMA(1, 0, At, B0); PG8_BAR; PG8_SCHED;
            PG8_STAGE(PG8_SB(0, 1), b2 + hstepB, voffB);
            PG8_WAIT_V(6); PG8_BAR; PG8_MMA(1, 1, At, B1); PG8_BAR;
            PG8_LDB(B0, 1, 0); PG8_SCHED; PG8_LDA(At, 1, 0); PG8_STAGE(PG8_SA(0, 1), a2 + hstepA, voffA);
            PG8_WAIT_L(8); PG8_BAR; PG8_WAIT_L(0); PG8_MMA(0, 0, At, B0); PG8_BAR; PG8_SCHED;
            PG8_LDB(B1, 1, 1); PG8_STAGE(PG8_SB(1, 0), b3, voffB);
            PG8_BAR; PG8_WAIT_L(0); PG8_MMA(0, 1, At, B1); PG8_BAR;
            PG8_LDA(At, 1, 1); PG8_STAGE(PG8_SA(1, 0), a3, voffA);
            PG8_BAR; PG8_WAIT_L(0); PG8_MMA(1, 0, At, B0); PG8_BAR; PG8_SCHED;
            PG8_STAGE(PG8_SB(1, 1), b3 + hstepB, voffB);
            PG8_WAIT_V(6); PG8_BAR; PG8_MMA(1, 1, At, B1); PG8_BAR;
        }
        E(acc, cur, wr, wc, fr, fq);
        if (!has_next) break;
#pragma unroll
        for (int a = 0; a < 2; ++a)
#pragma unroll
            for (int b = 0; b < 2; ++b)
#pragma unroll
                for (int m = 0; m < 4; ++m)
#pragma unroll
                    for (int n = 0; n < 2; ++n) acc[a][b][m][n] = (f32x4){0.f, 0.f, 0.f, 0.f};
        cur = nxt; cA = nA; cB = nB; ++ui;
    }
    PG8_WAIT_V(0);
    if (wr == 0) PG8_BAR;
    PG8_BAR;
#undef PG8_SA
#undef PG8_SB
#undef PG8_STAGE
#undef PG8_LDA
#undef PG8_LDB
#undef PG8_MMA
#undef PG8_WAIT_V
#undef PG8_WAIT_L
#undef PG8_BAR
#undef PG8_SCHED
}
}

__device__ __forceinline__ void transpose_item(const float* W, int Nsrc, int ksrc0, int nsrc0, bf16_t* WT, int K, int k0, int n0, LAS float* scr, int lane) {
#pragma unroll 8
    for (int i = 0; i < 32; ++i) { const int kk = 2 * i + (lane >> 5);
        scr[kk * 33 + (lane & 31)] = nsrc0 >= 0 ? W[(size_t)(ksrc0 + kk) * Nsrc + nsrc0 + (lane & 31)] : 0.f; }
    asm volatile("s_waitcnt lgkmcnt(0)" ::: "memory");
    const int c = lane & 7;
#pragma unroll
    for (int j = 0; j < 4; ++j) { const int n = (lane >> 3) + 8 * j; const LAS float* s = scr + (8 * c) * 33 + n;
        u32x4 o; o.x = pk2(s[0 * 33], s[1 * 33]); o.y = pk2(s[2 * 33], s[3 * 33]); o.z = pk2(s[4 * 33], s[5 * 33]); o.w = pk2(s[6 * 33], s[7 * 33]);
        *(u32x4*)(WT + (size_t)(n0 + n) * K + k0 + 8 * c) = o; }
    asm volatile("s_waitcnt lgkmcnt(0)" ::: "memory");
}
__device__ __forceinline__ int win_colmap(int n0) {
    if (n0 < 384) return n0;
    if (n0 < 768) return 1152 + (n0 - 384);
    if (n0 < 1152) return 384 + (n0 - 768);
    if (n0 < 1536) return 768 + (n0 - 1152);
    if (n0 < NIN) return n0;
    return -1;
}
__device__ __forceinline__ void convert_weights(const Params& p, int l, LAS unsigned char* lds, int widx, int nw) {
    const int tid_ = opaque_tid(); const int wave = tid_ >> 6, lane = tid_ & 63;
    LAS float* scr = (LAS float*)(lds + wave * 8448);
    bf16_t* win_t = (bf16_t*)(p.ws + OFF_WIN); bf16_t* wout_t = (bf16_t*)(p.ws + OFF_WOUT); bf16_t* wup_t = (bf16_t*)(p.ws + OFF_WUP); bf16_t* wdn_t = (bf16_t*)(p.ws + OFF_WDN);
    const float* w_in = p.in[5] + (size_t)l * D * NIN; const float* w_out = p.in[22] + (size_t)l * D * D;
    const float* w_up = p.in[25] + (size_t)l * D * FFN; const float* w_dn = p.in[26] + (size_t)l * FFN * D;
    constexpr int I_IN = (D / 64) * (NINP / 32), I_OUT = (D / 64) * (D / 32), I_UP = (D / 64) * (FFN / 32), I_DN = (FFN / 64) * (D / 32);
    for (int it = widx; it < I_IN + I_OUT + I_UP + I_DN; it += nw) {
        int r = it;
        if (r < I_IN) { const int nb = NINP / 32, kb = r / nb, n0 = (r % nb) * 32; transpose_item(w_in, NIN, kb * 64, win_colmap(n0), win_t, D, kb * 64, n0, scr, lane); continue; } r -= I_IN;
        if (r < I_OUT) { const int nb = D / 32, kb = r / nb, n0 = (r % nb) * 32, k0 = kb * 64; const int ks = k0 < 256 ? 768 + k0 : k0 - 256;
            transpose_item(w_out, D, ks, n0, wout_t, D, k0, n0, scr, lane); continue; } r -= I_OUT;
        if (r < I_UP) { const int nb = FFN / 32, kb = r / nb, n0 = (r % nb) * 32; transpose_item(w_up, FFN, kb * 64, n0, wup_t, D, kb * 64, n0, scr, lane); continue; } r -= I_UP;
        { const int nb = D / 32, kb = r / nb, n0 = (r % nb) * 32; transpose_item(w_dn, D, kb * 64, n0, wdn_t, FFN, kb * 64, n0, scr, lane); }
    }
}

__device__ __forceinline__ void ln_row(const float* src, float* dst32, bf16_t* dstb, const float* g, const float* b, int lane_) {
    int lane = lane_; asm volatile("" : "+v"(lane));
    const f32x4* xr = (const f32x4*)src + lane;
    f32x4 v[4]; float s = 0.f;
#pragma unroll
    for (int j = 0; j < 4; ++j) { v[j] = xr[64 * j]; s += (v[j].x + v[j].y) + (v[j].z + v[j].w); }
    const float mean = wave_sum(s) * (1.f / D); float s2 = 0.f;
#pragma unroll
    for (int j = 0; j < 4; ++j) { v[j] = v[j] - mean; s2 += (v[j].x * v[j].x + v[j].y * v[j].y) + (v[j].z * v[j].z + v[j].w * v[j].w); }
    const float rstd = rsqrtf(wave_sum(s2) * (1.f / D) + LN_EPS);
#pragma unroll
    for (int j = 0; j < 4; ++j) {
        const f32x4 gg = ((const f32x4*)g)[lane + 64 * j], bb = ((const f32x4*)b)[lane + 64 * j];
        f32x4 o = v[j] * rstd * gg + bb;
        ((f32x4*)dst32)[lane + 64 * j] = o;
        u32x2 w; w.x = pk2(o.x, o.y); w.y = pk2(o.z, o.w);
        ((u32x2*)dstb)[lane + 64 * j] = w;
    }
}

#define DSR128(dst, addr, off) asm volatile("ds_read_b128 %0, %1 offset:%2" : "=v"(dst) : "v"(addr), "n"(off))
#define DSR32(dst, addr, off) asm volatile("ds_read_b32 %0, %1 offset:%2" : "=v"(dst) : "v"(addr), "n"(off))
#define LGKM0() do { asm volatile("s_waitcnt lgkmcnt(0)" ::: "memory"); __builtin_amdgcn_sched_barrier(0); } while (0)
#define SCHEDB __builtin_amdgcn_sched_barrier(0)
__device__ __forceinline__ float xsum32(float x) { auto r = __builtin_amdgcn_permlane32_swap(__float_as_uint(x), __float_as_uint(x), false, false); return __uint_as_float(r[0]) + __uint_as_float(r[1]); }
__device__ __forceinline__ float xsum16(float x) { auto r = __builtin_amdgcn_permlane16_swap(__float_as_uint(x), __float_as_uint(x), false, false); return __uint_as_float(r[0]) + __uint_as_float(r[1]); }

constexpr int RTC = 32;
#define RW_ISSUE(BUF, bk, bv, vvn) do { \
    DSR128(BUF[0], bk, 0); DSR128(BUF[1], bk, 16); DSR128(BUF[2], bk, 32); DSR128(BUF[3], bk, 48); \
    DSR128(BUF[4], bk, 256); DSR128(BUF[5], bk, 272); DSR128(BUF[6], bk, 288); DSR128(BUF[7], bk, 304); \
    DSR128(BUF[8], bk, 512); DSR128(BUF[9], bk, 528); DSR128(BUF[10], bk, 544); DSR128(BUF[11], bk, 560); \
    DSR128(BUF[12], bk, 768); DSR128(BUF[13], bk, 784); DSR128(BUF[14], bk, 800); DSR128(BUF[15], bk, 816); \
    DSR32(vvn, bv, 1024); } while (0)
#define RW_COMPUTE(BUF) do { \
    f32x4 sacc = S4[0] * BUF[0] + S4[1] * BUF[1]; sacc += S4[2] * BUF[2] + S4[3] * BUF[3]; \
    const float sa = xsum16(xsum32((sacc.x + sacc.y) + (sacc.z + sacc.w))); \
    f32x4 oacc = (f32x4){0.f, 0.f, 0.f, 0.f}; \
    _Pragma("unroll") for (int i_ = 0; i_ < 4; ++i_) { f32x4 sv = S4[i_] + (sa * BUF[4 + i_] + vv * BUF[8 + i_]); S4[i_] = sv; oacc += sv * BUF[12 + i_]; } \
    oval = xsum16(xsum32((oacc.x + oacc.y) + (oacc.z + oacc.w))); } while (0)

__device__ __forceinline__ void rwkv_scan_wg(const Params& p, int l, int pairIdx, LAS unsigned char* lds) {
    const int tid = opaque_tid(), wave = tid >> 6, lane = tid & 63;
    const int b = pairIdx / 6, h = pairIdx % 6;
    LAS float* ring = (LAS float*)lds;
    LAS float* lam = (LAS float*)(lds + 81920);
    const int dir = wave >> 2, rq = wave & 3;
    const int c = h * 64 + lane;
    const bf16_t* proj = (const bf16_t*)(p.ws + OFF_PROJ);
    bf16_t* o_r = (bf16_t*)(p.ws + OFF_T);
    constexpr int NCH = SEQL / RTC;
    const int kp = lane >> 4, row = lane & 15, v0 = rq * 16 + row;
    f32x4 S4[4];
#pragma unroll
    for (int k = 0; k < 4; ++k) S4[k] = (f32x4){0.f, 0.f, 0.f, 0.f};
    f32x4 A[16], B[16]; float vv = 0.f, vvn = 0.f, oval = 0.f;
    const unsigned ring_addr = (unsigned)(unsigned long long)ring + (unsigned)(dir * RTC * 1280);
    const unsigned lam_addr = (unsigned)(unsigned long long)lam + (unsigned)(dir * 4 * 256) + kp * 64;
    const unsigned offk = ring_addr + kp * 64, offv = ring_addr + v0 * 4;
    bf16_t* orow = o_r + ((size_t)dir * MROWS + (size_t)b * SEQL) * RW + h * 64 + v0;
    const float w0c = p.in[8][(l * 2 + dir) * RW + c], a0c = p.in[10][(l * 2 + dir) * RW + c];
    const float kkc = p.in[13][l * RW + c], kac = p.in[14][l * RW + c];
    const float* mu0 = p.in[7] + (size_t)(l * 2 + 0) * NRW; const float* mu1 = mu0 + NRW;
    const float mr0 = mu0[c], mr1 = mu1[c], mk0 = mu0[384 + c], mk1 = mu1[384 + c], mv0 = mu0[768 + c], mv1 = mu1[768 + c];
    const int lcol = lane < 32 ? 1152 + dir * 32 + lane : 1216 + dir * 32 + (lane - 32);
    const float ml0 = mu0[lcol], ml1 = mu1[lcol];
    bf16x8 Bw[4], Ba[4];
    {   const float* wu = p.in[9] + (size_t)((l * 2 + dir) * 32) * RW + h * 64 + (lane & 15); const float* au = p.in[11] + (size_t)((l * 2 + dir) * 32) * RW + h * 64 + (lane & 15);
#pragma unroll
        for (int ct = 0; ct < 4; ++ct)
#pragma unroll
            for (int jj = 0; jj < 8; ++jj) { const int r = (lane >> 4) * 8 + jj;
                Bw[ct][jj] = (short)f2bf(wu[(size_t)r * RW + ct * 16]); Ba[ct][jj] = (short)f2bf(au[(size_t)r * RW + ct * 16]); } }
    for (int chunk = 0; chunk < NCH; ++chunk) {
        {
            const int s0 = chunk * RTC + rq * 8;
            const int tlo = dir ? SEQL - 8 - s0 : s0;
            float rr[10], rk_[10], rv[10], rl[10];
#pragma unroll
            for (int q = 0; q < 10; ++q) {
                const int tr = tlo - 1 + q; const bool ok = (tr >= 0) && (tr < SEQL);
                const bf16_t* pr = proj + ((size_t)b * SEQL + (ok ? tr : 0)) * PS; const float m = ok ? 1.f : 0.f;
                rr[q] = m * bf2f(pr[P_R + c]); rk_[q] = m * bf2f(pr[P_K + c]); rv[q] = m * bf2f(pr[P_V + c]); rl[q] = m * bf2f(pr[P_RW + lcol]);
            }
            float rs[8], ks[8], vs[8], lo[8];
#pragma unroll
            for (int i = 0; i < 8; ++i) {
                const float rc = dir ? rr[8 - i] : rr[i + 1], rp = dir ? rr[7 - i] : rr[i], rn = dir ? rr[9 - i] : rr[i + 2];
                const float kc = dir ? rk_[8 - i] : rk_[i + 1], kp_ = dir ? rk_[7 - i] : rk_[i], kn = dir ? rk_[9 - i] : rk_[i + 2];
                const float vc = dir ? rv[8 - i] : rv[i + 1], vp = dir ? rv[7 - i] : rv[i], vn = dir ? rv[9 - i] : rv[i + 2];
                const float lc = dir ? rl[8 - i] : rl[i + 1], lp = dir ? rl[7 - i] : rl[i], ln = dir ? rl[9 - i] : rl[i + 2];
                rs[i] = rc + mr0 * (rp - rc) + mr1 * (rn - rc);
                ks[i] = kc + mk0 * (kp_ - kc) + mk1 * (kn - kc);
                vs[i] = vc + mv0 * (vp - vc) + mv1 * (vn - vc);
                lo[i] = lc + ml0 * (lp - lc) + ml1 * (ln - lc);
            }
            LAS unsigned short* xs = (LAS unsigned short*)(lds + 86016 + wave * 4096);
#pragma unroll
            for (int i = 0; i < 8; ++i) {
                const float e2 = __expf(2.f * lo[i]); const float th = 1.f - 2.f / (e2 + 1.f);
                xs[i * 64 + lane] = (unsigned short)f2bf(lane < 32 ? th : lo[i]);
            }
            const bf16x8 Aw = *(const LAS bf16x8*)(xs + (lane & 15) * 64 + (lane >> 4) * 8);
            const bf16x8 Aa = *(const LAS bf16x8*)(xs + (lane & 15) * 64 + 32 + (lane >> 4) * 8);
            f32x4 Dw[4], Da[4];
#pragma unroll
            for (int ct = 0; ct < 4; ++ct) {
                Dw[ct] = __builtin_amdgcn_mfma_f32_16x16x32_bf16(Aw, Bw[ct], (f32x4){0.f, 0.f, 0.f, 0.f}, 0, 0, 0);
                Da[ct] = __builtin_amdgcn_mfma_f32_16x16x32_bf16(Aa, Ba[ct], (f32x4){0.f, 0.f, 0.f, 0.f}, 0, 0, 0);
            }
            LAS float* wsf = (LAS float*)xs;
            if (lane < 32) {
#pragma unroll
                for (int ct = 0; ct < 4; ++ct)
#pragma unroll
                    for (int jj = 0; jj < 4; ++jj) {
                        wsf[((lane >> 4) * 4 + jj) * 64 + ct * 16 + (lane & 15)] = Dw[ct][jj];
                        wsf[(8 + (lane >> 4) * 4 + jj) * 64 + ct * 16 + (lane & 15)] = Da[ct][jj];
                    }
            }
            float lamr = 0.f;
#pragma unroll
            for (int i = 0; i < 8; ++i) {
                const int sl = rq * 8 + i;
                const float wpre = w0c + wsf[i * 64 + lane], apre = a0c + wsf[(8 + i) * 64 + lane];
                const float w = -__logf(1.f + __expf(-wpre)) - 0.5f;
                const float ew = __expf(w);
                const float a = sigmoidf_(apre);
                float kk = ks[i] * kkc; const float n2 = wave_sum(kk * kk); kk = kk / fmaxf(sqrtf(n2), 1e-12f);
                const float kd = ks[i] * (1.f + (a - 1.f) * kac);
                const float Lprev = __expf(-lamr); lamr += ew; const float Lcur = __expf(-lamr), Linv = __expf(lamr);
                LAS float* o = ring + (size_t)((dir * RTC + sl) * 5) * 64;
                o[0 * 64 + lane] = -kk * Lprev; o[1 * 64 + lane] = kk * a * Linv; o[2 * 64 + lane] = kd * Linv; o[3 * 64 + lane] = rs[i] * Lcur; o[4 * 64 + lane] = vs[i];
            }
            lam[(dir * 4 + rq) * 64 + lane] = __expf(-lamr);
        }
        __syncthreads();
        {
            RW_ISSUE(A, offk, offv, vvn);
#pragma unroll 1
            for (int sub = 0; sub < 4; ++sub) {
#pragma unroll 1
                for (int it = 0; it < 4; ++it) {
                    const int sl = sub * 8 + it * 2;
                    const unsigned bk1 = offk + (sl + 1) * 1280, bv1 = offv + (sl + 1) * 1280, bk2 = bk1 + 1280, bv2 = bv1 + 1280;
                    const int s = chunk * RTC + sl;
                    LGKM0(); vv = vvn; RW_ISSUE(B, bk1, bv1, vvn); SCHEDB; RW_COMPUTE(A); SCHEDB;
                    if (kp == 0) { const int t = dir ? SEQL - 1 - s : s; orow[(size_t)t * RW] = (bf16_t)f2bf(oval); }
                    LGKM0(); vv = vvn; RW_ISSUE(A, bk2, bv2, vvn); SCHEDB; RW_COMPUTE(B); SCHEDB;
                    if (kp == 0) { const int t = dir ? SEQL - 2 - s : s + 1; orow[(size_t)t * RW] = (bf16_t)f2bf(oval); }
                }
                {   f32x4 L0, L1, L2, L3; const unsigned la = lam_addr + sub * 256;
                    DSR128(L0, la, 0); DSR128(L1, la, 16); DSR128(L2, la, 32); DSR128(L3, la, 48);
                    LGKM0();
                    S4[0] *= L0; S4[1] *= L1; S4[2] *= L2; S4[3] *= L3; SCHEDB; }
            }
            LGKM0();
        }
        __syncthreads();
    }
}

constexpr int TC = 16;
#define HG_ISSUE(BUF, bk, Q) do { \
    DSR128(BUF[0], bk, Q); DSR128(BUF[1], bk, Q + 16); DSR128(BUF[2], bk, Q + 32); DSR128(BUF[3], bk, Q + 48); \
    DSR128(BUF[4], bk, 256 + Q); DSR128(BUF[5], bk, 256 + Q + 16); DSR128(BUF[6], bk, 256 + Q + 32); DSR128(BUF[7], bk, 256 + Q + 48); \
    DSR128(BUF[8], bk, 512 + Q); DSR128(BUF[9], bk, 512 + Q + 16); DSR128(BUF[10], bk, 512 + Q + 32); DSR128(BUF[11], bk, 512 + Q + 48); } while (0)
#define HG_HALF(BUF, J) do { _Pragma("unroll") for (int i_ = 0; i_ < 4; ++i_) { \
    f32x4 sv = S4[4 * (J) + i_] * BUF[i_] + BUF[4 + i_] * iv; S4[4 * (J) + i_] = sv; oacc += sv * BUF[8 + i_]; } } while (0)

__device__ __forceinline__ void hgrn_scan_wg(const Params& p, int l, int grp, LAS unsigned char* lds) {
    const int tid = opaque_tid(), wave = tid >> 6, lane = tid & 63;
    constexpr int HTC = 16, NCH = SEQL / HTC;
    LAS float* ring = (LAS float*)lds;
    LAS float* lbt = (LAS float*)(lds + 4 * HTC * 4 * 64 * 4);
    bf16_t* proj = (bf16_t*)(p.ws + OFF_PROJ);
    for (int i = tid; i < 2 * RW; i += 512) { const int dr = i / RW, cc = i % RW; const float* lg = p.in[4] + (size_t)dr * 5 * RW + cc;
        float e[5], mx = -1e30f;
#pragma unroll
        for (int j = 0; j < 5; ++j) { e[j] = lg[j * RW]; mx = fmaxf(mx, e[j]); }
        float sum = 0.f, cum = 0.f;
#pragma unroll
        for (int j = 0; j < 5; ++j) { e[j] = __expf(e[j] - mx); sum += e[j]; if (j <= l) cum += e[j]; }
        lbt[i] = cum / sum; }
    __syncthreads();
    const int j = wave >> 1, half = wave & 1, kp = lane >> 5, col = half * 32 + (lane & 31);
    const int cch = grp * 4 + j;
    const int cdir = cch & 1, cb = (cch >> 1) / 6, chh = (cch >> 1) % 6;
    bf16_t* orow = proj + (size_t)cb * SEQL * PS + (cdir ? P_FB : P_FF) + chh * 64 + col;
    const bf16_t* prow = proj + (size_t)cb * SEQL * PS + chh * 64 + lane;
    const float lb = lbt[cdir * RW + chh * 64 + lane];
    f32x4 S4[8];
#pragma unroll
    for (int k = 0; k < 8; ++k) S4[k] = (f32x4){0.f, 0.f, 0.f, 0.f};
    f32x4 A[12], B[12], oacc = (f32x4){0.f, 0.f, 0.f, 0.f}; float iv = 0.f, ivn = 0.f;
    const unsigned ring_addr = (unsigned)(unsigned long long)ring;
    const unsigned cbase = ring_addr + (unsigned)((j * HTC) * 1024);
    const unsigned offk = cbase + kp * 128, offv = cbase + col * 4;
    for (int chunk = 0; chunk < NCH; ++chunk) {
        {
            float qv[8], fv[8], ivv[8];
#pragma unroll
            for (int i = 0; i < 8; ++i) {
                const int sl = half * 8 + i, s = chunk * HTC + sl, t = cdir ? SEQL - 1 - s : s;
                const bf16_t* pr = prow + (size_t)t * PS;
                qv[i] = bf2f(pr[P_Q]); fv[i] = bf2f(pr[cdir ? P_FB : P_FF]); ivv[i] = bf2f(pr[P_I]);
            }
#pragma unroll
            for (int i = 0; i < 8; ++i) {
                const int sl = half * 8 + i;
                const float f = lb + (1.f - lb) * sigmoidf_(fv[i]);
                LAS float* o = ring + (size_t)((j * HTC + sl) * 4) * 64;
                o[lane] = f; o[64 + lane] = 1.f - f; o[128 + lane] = qv[i]; o[192 + lane] = ivv[i];
            }
        }
        __syncthreads();
        {
            HG_ISSUE(A, offk, 0); DSR32(ivn, offv, 768);
#pragma unroll 1
            for (int sl = 0; sl < HTC; ++sl) {
                const unsigned bk = offk + sl * 1024, nbk = bk + 1024, nbv = offv + (sl + 1) * 1024;
                LGKM0(); iv = ivn; HG_ISSUE(B, bk, 64); SCHEDB; oacc = (f32x4){0.f, 0.f, 0.f, 0.f}; HG_HALF(A, 0); SCHEDB;
                LGKM0(); HG_ISSUE(A, nbk, 0); DSR32(ivn, nbv, 768); SCHEDB; HG_HALF(B, 1); SCHEDB;
                const float oval = xsum32((oacc.x + oacc.y) + (oacc.z + oacc.w));
                const int s = chunk * HTC + sl, t = cdir ? SEQL - 1 - s : s;
                if (kp == 0) orow[(size_t)t * PS] = (bf16_t)f2bf(oval);
            }
            LGKM0();
        }
        __syncthreads();
    }
}

__device__ __forceinline__ void conv_wg(const Params& p, int l, int first, int stride, LAS unsigned char* lds) {
    const int tid = opaque_tid(), wave = tid >> 6, lane = tid & 63;
    LAS float* z = (LAS float*)lds;
    LAS float* ot = (LAS float*)(lds + 62 * 256 * 4);
    bf16_t* proj = (bf16_t*)(p.ws + OFF_PROJ);
    const int ch = tid & 255, half = tid >> 8;
    float w[31];
#pragma unroll
    for (int j = 0; j < 31; ++j) w[j] = p.in[18][(size_t)(l * 31 + j) * 256 + ch];
    const float cb = p.in[19][l * 256 + ch];
    const f32x4 lg = ((const f32x4*)(p.in[20] + l * 256))[lane], lbv = ((const f32x4*)(p.in[21] + l * 256))[lane];
    for (int tile = first; tile < MROWS / 32; tile += stride) {
        const int row0 = tile * 32, b = row0 / SEQL, t0 = row0 % SEQL;
        for (int r = half; r < 62; r += 2) { const int t = t0 - 15 + r; float zz = 0.f;
            if (t >= 0 && t < SEQL) { const bf16_t* pr = proj + ((size_t)b * SEQL + t) * PS; zz = bf2f(pr[P_CV + ch]) * sigmoidf_(bf2f(pr[P_CG + ch])); }
            z[r * 256 + ch] = zz; }
        __syncthreads();
#pragma unroll 4
        for (int tt = 0; tt < 16; ++tt) { const int tok = half * 16 + tt; float acc = cb;
#pragma unroll
            for (int j = 0; j < 31; ++j) acc += w[j] * z[(tok + j) * 256 + ch];
            ot[tok * 256 + ch] = acc; }
        __syncthreads();
#pragma unroll
        for (int q = 0; q < 4; ++q) { const int tok = wave * 4 + q;
            f32x4 v = *(const LAS f32x4*)(ot + tok * 256 + lane * 4);
            const float mean = wave_sum((v.x + v.y) + (v.z + v.w)) * (1.f / 256.f);
            v = v - mean;
            const float var = wave_sum((v.x * v.x + v.y * v.y) + (v.z * v.z + v.w * v.w)) * (1.f / 256.f);
            const float rstd = rsqrtf(var + LN_EPS);
            f32x4 y = v * rstd * lg + lbv;
            y.x = y.x * sigmoidf_(y.x); y.y = y.y * sigmoidf_(y.y); y.z = y.z * sigmoidf_(y.z); y.w = y.w * sigmoidf_(y.w);
            u32x2 wv; wv.x = pk2(y.x, y.y); wv.y = pk2(y.z, y.w);
            *(u32x2*)(proj + (size_t)(row0 + tok) * PS + P_YC + lane * 4) = wv; }
        __syncthreads();
    }
}

__device__ __forceinline__ void combine_phase(const Params& p, int l, int widx, int nw, LAS unsigned char* lds) {
    const int tid = opaque_tid(), lane = tid & 63;
    bf16_t* proj = (bf16_t*)(p.ws + OFF_PROJ);
    const bf16_t* o_r = (const bf16_t*)(p.ws + OFF_T);
    LAS unsigned* WA = (LAS unsigned*)lds;
    LAS unsigned* WG = (LAS unsigned*)(lds + 49152);
    {
        const float* aup = p.in[11] + (size_t)(l * 2 * 32) * RW; const float* gup = p.in[12] + (size_t)(l * 64) * RW;
        for (int i = tid; i < 2 * 32 * 3 * 64; i += 512) { const int ln = i & 63, hp = (i >> 6) % 3, dr = i / 192; const float* s = aup + (size_t)dr * RW + (2 * hp) * 64 + ln; WA[i] = pk2(s[0], s[64]); }
        for (int i = tid; i < 64 * 3 * 64; i += 512) { const int ln = i & 63, hp = (i >> 6) % 3, r = i / 192; const float* s = gup + (size_t)r * RW + (2 * hp) * 64 + ln; WG[i] = pk2(s[0], s[64]); }
    }
    __syncthreads();
    const float* mu0 = p.in[7] + (size_t)(l * 2 + 0) * NRW; const float* mu1 = mu0 + NRW;
    const float mad0 = mu0[1216 + lane], mad1 = mu1[1216 + lane], mgd0 = mu0[1280 + lane], mgd1 = mu1[1280 + lane];
    for (int g4 = widx; g4 < MROWS / 2; g4 += nw) {
        const int row0 = g4 * 2;
        float adv[2], sgv[2];
#pragma unroll
        for (int tt = 0; tt < 2; ++tt) { const int row = row0 + tt, t = row % SEQL; const bf16_t* pr = proj + (size_t)row * PS;
            const bool hp = t > 0, hn = t < SEQL - 1; const bf16_t* pp = hp ? pr - PS : pr; const bf16_t* pn = hn ? pr + PS : pr; const float fp = hp ? 1.f : 0.f, fn = hn ? 1.f : 0.f;
            const float ac = bf2f(pr[P_AD + lane]), ap = fp * bf2f(pp[P_AD + lane]), an = fn * bf2f(pn[P_AD + lane]);
            const float gc = bf2f(pr[P_GD + lane]), gp = fp * bf2f(pp[P_GD + lane]), gn = fn * bf2f(pn[P_GD + lane]);
            adv[tt] = ac + mad0 * (ap - ac) + mad1 * (an - ac);
            sgv[tt] = sigmoidf_(gc + mgd0 * (gp - gc) + mgd1 * (gn - gc)); }
        float A0[2][6], A1[2][6], G[2][6];
#pragma unroll
        for (int tt = 0; tt < 2; ++tt)
#pragma unroll
            for (int h = 0; h < 6; ++h) { A0[tt][h] = 0.f; A1[tt][h] = 0.f; G[tt][h] = 0.f; }
#pragma unroll 4
        for (int r = 0; r < 32; ++r) {
            float w0[6], w1[6];
#pragma unroll
            for (int hp = 0; hp < 3; ++hp) { const unsigned u0 = WA[(r * 3 + hp) * 64 + lane], u1 = WA[((32 + r) * 3 + hp) * 64 + lane];
                w0[2 * hp] = __uint_as_float(u0 << 16); w0[2 * hp + 1] = __uint_as_float(u0 & 0xffff0000u); w1[2 * hp] = __uint_as_float(u1 << 16); w1[2 * hp + 1] = __uint_as_float(u1 & 0xffff0000u); }
#pragma unroll
            for (int tt = 0; tt < 2; ++tt) { const float s0 = rdlane(adv[tt], r), s1 = rdlane(adv[tt], 32 + r);
#pragma unroll
                for (int h = 0; h < 6; ++h) { A0[tt][h] += s0 * w0[h]; A1[tt][h] += s1 * w1[h]; } }
        }
#pragma unroll 4
        for (int r = 0; r < 64; ++r) {
            float wg[6];
#pragma unroll
            for (int hp = 0; hp < 3; ++hp) { const unsigned u = WG[(r * 3 + hp) * 64 + lane]; wg[2 * hp] = __uint_as_float(u << 16); wg[2 * hp + 1] = __uint_as_float(u & 0xffff0000u); }
#pragma unroll
            for (int tt = 0; tt < 2; ++tt) { const float s = rdlane(sgv[tt], r);
#pragma unroll
                for (int h = 0; h < 6; ++h) G[tt][h] += s * wg[h]; }
        }
#pragma unroll
        for (int h = 0; h < 6; ++h) {
            const int c = h * 64 + lane;
            const float a00 = p.in[10][(l * 2 + 0) * RW + c], a01 = p.in[10][(l * 2 + 1) * RW + c], kac = p.in[14][l * RW + c];
            const float rk = p.in[15][(l * 6 + h) * 64 + lane], gng = p.in[16][l * RW + c], gnb = p.in[17][l * RW + c], ng = p.in[6][l * RW + c];
            const float mr0 = mu0[c], mr1 = mu1[c], mk0 = mu0[384 + c], mk1 = mu1[384 + c], mv0 = mu0[768 + c], mv1 = mu1[768 + c];
#pragma unroll
            for (int tt = 0; tt < 2; ++tt) { const int row = row0 + tt, t = row % SEQL; bf16_t* pr = proj + (size_t)row * PS;
                const bool hp = t > 0, hn = t < SEQL - 1; const bf16_t* pp = hp ? pr - PS : pr; const bf16_t* pn = hn ? pr + PS : pr; const float fp = hp ? 1.f : 0.f, fn = hn ? 1.f : 0.f;
                const float rc = bf2f(pr[P_R + c]), rp = fp * bf2f(pp[P_R + c]), rn = fn * bf2f(pn[P_R + c]);
                const float kc = bf2f(pr[P_K + c]), kp = fp * bf2f(pp[P_K + c]), kn = fn * bf2f(pn[P_K + c]);
                const float vc = bf2f(pr[P_V + c]), vp = fp * bf2f(pp[P_V + c]), vn = fn * bf2f(pn[P_V + c]);
                const float rs = rc + mr0 * (rp - rc) + mr1 * (rn - rc);
                const float ks = kc + mk0 * (kp - kc) + mk1 * (kn - kc);
                const float vs = vc + mv0 * (vp - vc) + mv1 * (vn - vc);
                const float a0 = sigmoidf_(a00 + A0[tt][h]), a1 = sigmoidf_(a01 + A1[tt][h]);
                const float kh = ks * (1.f + (0.5f * (a0 + a1) - 1.f) * kac);
                const float bsum = wave_sum(rs * kh * rk);
                const float o = bf2f(o_r[(size_t)row * RW + c]) + bf2f(o_r[((size_t)MROWS + row) * RW + c]);
                const float mean = wave_sum(o) * (1.f / 64.f); const float dlt = o - mean;
                const float var = wave_sum(dlt * dlt) * (1.f / 64.f);
                const float on = dlt * rsqrtf(var + GN_EPS) * gng + gnb;
                const float yr = (on + bsum * vs) * G[tt][h];
                const float oh = bf2f(pr[P_FF + c]) + bf2f(pr[P_FB + c]);
                const float ms = wave_sum(oh * oh) * (1.f / 64.f);
                const float gh = bf2f(pr[P_G + c]);
                const float yh = oh * rsqrtf(ms + RMS_EPS) * ng * (gh * sigmoidf_(gh));
                pr[P_I + c] = (bf16_t)f2bf(yr);
                pr[P_Q + c] = (bf16_t)f2bf(yh);
            }
        }
    }
}

__global__ void __launch_bounds__(512, 2) fwd_mega(Params p) {
    extern __shared__ __attribute__((aligned(16))) unsigned char smem_raw[];
    LAS unsigned char* lds = (LAS unsigned char*)smem_raw;
    cg::grid_group grid = cg::this_grid();
    const int tid = threadIdx.x, wave = tid >> 6, lane = tid & 63;
    const int G = gridDim.x, bid = blockIdx.x;
    const int widx = bid * 8 + wave, nw = G * 8;
    bf16_t* win_t = (bf16_t*)(p.ws + OFF_WIN); bf16_t* wout_t = (bf16_t*)(p.ws + OFF_WOUT); bf16_t* wup_t = (bf16_t*)(p.ws + OFF_WUP); bf16_t* wdn_t = (bf16_t*)(p.ws + OFF_WDN);
    bf16_t* proj = (bf16_t*)(p.ws + OFF_PROJ); bf16_t* xb = (bf16_t*)(p.ws + OFF_T); bf16_t* hid = proj;
    float* x = p.out;
    volatile LAS unsigned* xst = (volatile LAS unsigned*)(lds + 131072);
    if (tid == 0) { xst[0] = 0u; xst[1] = 0u; xst[2] = 0u; xst[3] = 0u; }
    __syncthreads();
    XcdBarrier xbar = xcd_barrier_post((unsigned*)(p.ws + OFF_BAR), xst);

    convert_weights(p, 0, lds, widx, nw);
    for (int row = widx; row < MROWS; row += nw) {
        const float* src = row < 16 * SEQL ? p.in[0] + (size_t)row * D : p.in[1] + (size_t)(row - 16 * SEQL) * D;
        ln_row(src, x + (size_t)row * D, xb + (size_t)row * D, p.in[2], p.in[3], lane);
    }
    grid.sync();
    for (int l = 0; l < DEPTH; ++l) {
        {
            pg8::Gemm g{xb, win_t, MROWS, NINP, D, D}; pg8::StaticOrder S; S.init(MROWS, NINP, G, bid);
            pg8::EpiBf16<0> E{proj + 256, PS};
            for (int rep = 0; rep < REP_GIN; ++rep) pg8::gemm_phase(lds, g, S, E);
        }
        GSYNC();
        for (int rep = 0; rep < REP_SCAN; ++rep) {
            if (bid < 144) rwkv_scan_wg(p, l, bid, lds);
            else if (bid < 216) { if (rep == 0) hgrn_scan_wg(p, l, bid - 144, lds); }
            else { }
        }
        GSYNC();
        conv_wg(p, l, bid, G, lds);
        for (int rep = 0; rep < REP_COMB; ++rep) combine_phase(p, l, widx, nw, lds);
        GSYNC();
        {
            pg8::Gemm g{proj, wout_t, MROWS, D, D, PS}; pg8::StaticOrder S; S.init(MROWS, D, G, bid);
            pg8::EpiResid E{x, D, DN_ALPHA};
            pg8::gemm_phase(lds, g, S, E);
        }
        GSYNC();
        for (int row = widx; row < MROWS; row += nw)
            ln_row(x + (size_t)row * D, x + (size_t)row * D, xb + (size_t)row * D, p.in[23] + l * D, p.in[24] + l * D, lane);
        GSYNC();
        for (int third = 0; third < 3; ++third) {
            constexpr int MT = MROWS / 3;
            {   pg8::Gemm g{xb + (size_t)third * MT * D, wup_t, MT, FFN, D, D}; pg8::StaticOrder S; S.init(MT, FFN, G, bid);
                pg8::EpiBf16<1> E{hid, FFN};
                for (int rep = 0; rep < REP_UP; ++rep) pg8::gemm_phase(lds, g, S, E); }
            GSYNC();
            {   pg8::Gemm g{hid, wdn_t, MT, D, FFN, FFN}; pg8::StaticOrder S; S.init(MT, D, G, bid);
                pg8::EpiResid E{x + (size_t)third * MT * D, D, DN_ALPHA};
                pg8::gemm_phase(lds, g, S, E); }
            GSYNC();
        }
        if (l + 1 < DEPTH) convert_weights(p, l + 1, lds, widx, nw);
        for (int row = widx; row < MROWS; row += nw)
            ln_row(x + (size_t)row * D, x + (size_t)row * D, xb + (size_t)row * D, p.in[27] + l * D, p.in[28] + l * D, lane);
        GSYNC();
    }
}

extern "C" void kernel_launch(void* const* d_in, const int* in_sizes, int n_in, void* d_out, int out_size, void* d_ws, size_t ws_size, hipStream_t stream) {
    static int grid = 0;
    if (grid == 0) {
        if (n_in != 29 || out_size != MROWS * D || ws_size < WS_END) { fprintf(stderr, "kernel_launch: unexpected shapes (n_in %d out %d ws %zu need %zu)\n", n_in, out_size, ws_size, (size_t)WS_END); grid = -1; return; }
        int dev = 0, cus = 0, per_cu = 0;
        hipGetDevice(&dev);
        hipDeviceGetAttribute(&cus, hipDeviceAttributeMultiprocessorCount, dev);
        if (hipFuncSetAttribute((const void*)fwd_mega, hipFuncAttributeMaxDynamicSharedMemorySize, LDS_BYTES) != hipSuccess) { fprintf(stderr, "kernel_launch: hipFuncSetAttribute failed\n"); grid = -1; return; }
        hipOccupancyMaxActiveBlocksPerMultiprocessor(&per_cu, (const void*)fwd_mega, 512, LDS_BYTES);
        (void)hipGetLastError();
        if (per_cu < 1) per_cu = 1;
        grid = cus;
        if (grid != 256) fprintf(stderr, "kernel_launch: note: %d CUs\n", grid);
    }
    if (grid < 0) return;
    if (hipMemsetAsync((char*)d_ws + OFF_BAR, 0, SZ_BAR, stream) != hipSuccess) { fprintf(stderr, "kernel_launch: memset failed\n"); return; }
    Params p{};
    for (int i = 0; i < 29; ++i) p.in[i] = (const float*)d_in[i];
    p.out = (float*)d_out; p.ws = (unsigned char*)d_ws;
    void* args[] = {&p};
    hipError_t e = hipLaunchCooperativeKernel((const void*)fwd_mega, dim3(grid), dim3(512), args, LDS_BYTES, stream);
    if (e != hipSuccess) fprintf(stderr, "cooperative launch failed: %s (grid %d)\n", hipGetErrorString(e), grid);
}
```

```cpp
#include <hip/hip_runtime.h>
#include <hip/hip_cooperative_groups.h>
#include <cstdio>
#include <cstdint>
namespace cg = cooperative_groups;

#define LAS __attribute__((address_space(3)))
typedef unsigned short bf16_t;
typedef short bf16x8 __attribute__((ext_vector_type(8)));
typedef float f32x4 __attribute__((ext_vector_type(4)));
typedef unsigned u32x4 __attribute__((ext_vector_type(4)));
typedef unsigned u32x2 __attribute__((ext_vector_type(2)));

constexpr int D = 1024, SEQL = 2048, NSEQ = 24, MROWS = NSEQ * SEQL, DEPTH = 4, FFN = 4096;
constexpr int NIN = 3776, NINP = 3840, PS = 4096;
constexpr int RW = 384, NRW = 1344;
constexpr int P_YC = 0, P_Q = 256, P_I = 640, P_FF = 1024, P_FB = 1408, P_G = 1792;
constexpr int P_RW = 2176, P_R = P_RW, P_K = P_RW + 384, P_V = P_RW + 768, P_WD = P_RW + 1152, P_AD = P_RW + 1216, P_GD = P_RW + 1280;
constexpr int P_CV = 3520, P_CG = 3776;
constexpr float LN_EPS = 1e-5f, RMS_EPS = 1e-6f, GN_EPS = 64e-5f;
constexpr float DN_ALPHA = 1.681792830507429f;

constexpr size_t OFF_WIN = 0, SZ_WIN = (size_t)NINP * D * 2;
constexpr size_t OFF_WOUT = OFF_WIN + SZ_WIN, SZ_WOUT = (size_t)D * D * 2;
constexpr size_t OFF_WUP = OFF_WOUT + SZ_WOUT, SZ_WUP = (size_t)FFN * D * 2;
constexpr size_t OFF_WDN = OFF_WUP + SZ_WUP, SZ_WDN = (size_t)FFN * D * 2;
constexpr size_t OFF_PROJ = OFF_WDN + SZ_WDN, SZ_PROJ = (size_t)MROWS * PS * 2;
constexpr size_t OFF_T = OFF_PROJ + SZ_PROJ, SZ_T = (size_t)MROWS * D * 2;
constexpr size_t OFF_BAR = OFF_T + SZ_T, SZ_BAR = 3456 * 4;
constexpr size_t WS_END = OFF_BAR + SZ_BAR;
constexpr int LDS_BYTES = 131072 + 16;
#define REP_SCAN 1
#define REP_COMB 1
#define REP_GIN 1
#define REP_UP 1
#define REP_SYNC 1
#define GSYNC() do { for (int r_ = 0; r_ < REP_SYNC; ++r_) xcd_barrier(xbar); } while (0)

struct Params {
    const float* in[29];
    float* out;
    unsigned char* ws;
};

__device__ __forceinline__ float bf2f(bf16_t b) { return __uint_as_float(((unsigned)b) << 16); }
__device__ __forceinline__ unsigned f2bf(float f) { unsigned u = __float_as_uint(f); u += 0x7FFFu + ((u >> 16) & 1u); return u >> 16; }
__device__ __forceinline__ unsigned pk2(float lo, float hi) { return f2bf(lo) | (f2bf(hi) << 16); }
__device__ __forceinline__ float dpp_add(float v, const int ctrl_sel) {
    int r;
    switch (ctrl_sel) {
        case 0: r = __builtin_amdgcn_update_dpp(0, __float_as_int(v), 0xB1, 0xF, 0xF, true); break;
        case 1: r = __builtin_amdgcn_update_dpp(0, __float_as_int(v), 0x4E, 0xF, 0xF, true); break;
        case 2: r = __builtin_amdgcn_update_dpp(0, __float_as_int(v), 0x141, 0xF, 0xF, true); break;
        default: r = __builtin_amdgcn_update_dpp(0, __float_as_int(v), 0x140, 0xF, 0xF, true); break;
    }
    return v + __int_as_float(r);
}
__device__ __forceinline__ float wave_sum(float v) {
    v = dpp_add(v, 0); v = dpp_add(v, 1); v = dpp_add(v, 2); v = dpp_add(v, 3);
    { auto r = __builtin_amdgcn_permlane16_swap(__float_as_uint(v), __float_as_uint(v), false, false); v = __uint_as_float(r[0]) + __uint_as_float(r[1]); }
    { auto r = __builtin_amdgcn_permlane32_swap(__float_as_uint(v), __float_as_uint(v), false, false); v = __uint_as_float(r[0]) + __uint_as_float(r[1]); }
    return v;
}
__device__ __forceinline__ int opaque_tid() { int t = threadIdx.x; asm volatile("" : "+v"(t)); return t; }
__device__ __forceinline__ float sigmoidf_(float x) { return 1.0f / (1.0f + __expf(-x)); }
__device__ __forceinline__ float rdlane(float v, int l) { return __int_as_float(__builtin_amdgcn_readlane(__float_as_int(v), l)); }

#define XB_TMO      128
#define XB_XCNT(j)  (256  + 64 * (j))
#define XB_XSUB(j)  (1280 + 64 * (j))
#define XB_XGEN(j)  (2304 + 64 * (j))
#define XB_TOP      3328
#define XB_TOPGEN   3392
#define XCD_BAR_WORDS 3456
#define XB_SPIN_CAP (1u << 22)
__device__ __forceinline__ unsigned xb_ld(unsigned* p)              { return __hip_atomic_load(p, __ATOMIC_RELAXED, __HIP_MEMORY_SCOPE_AGENT); }
__device__ __forceinline__ unsigned xb_add(unsigned* p, unsigned v) { return __hip_atomic_fetch_add(p, v, __ATOMIC_RELAXED, __HIP_MEMORY_SCOPE_AGENT); }
__device__ __forceinline__ unsigned xb_xcc_id() { return (unsigned)__builtin_amdgcn_s_getreg((3 << 11) | 20) & 0xFu; }
#define XB_SPIN(cond, bar) do { unsigned _sp = 0; while (cond) { __builtin_amdgcn_s_sleep(1); \
    if ((++_sp & 255u) == 0u) { if (xb_ld(&(bar)[XB_TMO])) break; if (_sp > XB_SPIN_CAP) { atomicAdd(&(bar)[XB_TMO], 1u); break; } } } } while (0)
struct XcdBarrier { unsigned* bar; unsigned x; volatile LAS unsigned* st; };
__device__ __forceinline__ XcdBarrier xcd_barrier_post(unsigned* bar, volatile LAS unsigned* st) {
    XcdBarrier b; b.bar = bar; b.x = xb_xcc_id(); b.st = st;
    if (threadIdx.x == 0) (void)xb_add(&bar[XB_XCNT(b.x)], 1u);
    return b;
}
__device__ __forceinline__ void xcd_barrier_complete(unsigned* bar, unsigned x, unsigned& nloc, unsigned& nx) {
    const unsigned G = gridDim.x * gridDim.y * gridDim.z;
    unsigned sum, cnt, mine, sp = 0u;
    for (;;) {
        sum = 0u; cnt = 0u; mine = 0u;
#pragma unroll
        for (unsigned j = 0; j < 16; ++j) { const unsigned c = xb_ld(&bar[XB_XCNT(j)]); sum += c; cnt += (c > 0u) ? 1u : 0u; mine = (j == x) ? c : mine; }
        if (sum == G) break;
        __builtin_amdgcn_s_sleep(1);
        if ((++sp & 255u) == 0u) { if (xb_ld(&bar[XB_TMO])) break; if (sp > XB_SPIN_CAP) { atomicAdd(&bar[XB_TMO], 1u); break; } }
    }
    nloc = mine > 0u ? mine : 1u; nx = cnt > 0u ? cnt : 1u;
}
__device__ __forceinline__ void xcd_barrier(const XcdBarrier& b) {
    asm volatile("s_waitcnt vmcnt(0)" ::: "memory");
    __syncthreads();
    if (threadIdx.x == 0) {
        unsigned* bar = b.bar;
        __builtin_amdgcn_s_waitcnt(0);
        unsigned nloc = b.st[0], nx = b.st[1];
        if (nloc == 0u) { xcd_barrier_complete(bar, b.x, nloc, nx); b.st[0] = nloc; b.st[1] = nx; }
        const unsigned old = xb_add(&bar[XB_XSUB(b.x)], 1u);
        const unsigned gen = old / nloc;
        if (old + 1u == (gen + 1u) * nloc) {
            __builtin_amdgcn_fence(__ATOMIC_RELEASE, "agent");
            asm volatile("s_waitcnt vmcnt(0)" ::: "memory");
            const unsigned og = xb_add(&bar[XB_TOP], 1u);
            const unsigned tg = og / nx;
            if (og + 1u == (tg + 1u) * nx) xb_add(&bar[XB_TOPGEN], 1u);
            else XB_SPIN(xb_ld(&bar[XB_TOPGEN]) == tg, bar);
            __builtin_amdgcn_fence(__ATOMIC_ACQUIRE, "agent");
            xb_add(&bar[XB_XGEN(b.x)], 1u);
            asm volatile("s_waitcnt vmcnt(0)" ::: "memory");
        } else {
            XB_SPIN(xb_ld(&bar[XB_XGEN(b.x)]) == gen, bar);
            __builtin_amdgcn_fence(__ATOMIC_ACQUIRE, "agent");
            asm volatile("s_waitcnt vmcnt(0)" ::: "memory");
        }
    }
    __syncthreads();
}

namespace pg8 {
constexpr int BM = 256, BK = 64, HALF = 128, HTB = HALF * BK * 2, STAGE_BYTES = 8 * HTB, NXCD = 8, WGM = 8;
__device__ __forceinline__ int lds_byte(int r, int c) { const int st = (r >> 4) * 2 + (c >> 5), rr = r & 15, cc = c & 31, ob = rr * 64 + cc * 2; return st * 1024 + (ob ^ (((ob >> 9) & 1) << 5)); }
__device__ __forceinline__ void stage_rc(int b, int& R, int& C) { const int st = b / 1024, sb = b % 1024, swz = sb ^ (((sb >> 9) & 1) << 5); R = (st >> 1) * 16 + swz / 64; C = (st & 1) * 32 + (swz % 64) / 2; }
__device__ __forceinline__ int perm32(int rho) { const int n = rho >> 4, i = rho & 15; return 8 * (i >> 2) + 4 * n + (i & 3); }
struct Unit { int pm, pn; };
struct Gemm { const bf16_t* A; const bf16_t* Bt; int M, N, K, lda; };
struct StaticOrder {
    int nM, nN, nwg, G, c;
    __device__ void init(int M, int N, int G_, int c_) { nM = M / BM; nN = N / BM; nwg = nM * nN; G = G_; c = c_; }
    __device__ bool next(int i, Unit& u) const {
        const long L = (long)i * G + c; if (L >= nwg) return false;
        int wgid = (int)L; { const int q = nwg / NXCD, r = nwg % NXCD, xcd = wgid % NXCD, off = wgid / NXCD; wgid = (xcd < r ? xcd * (q + 1) : r * (q + 1) + (xcd - r) * q) + off; }
        const int nig = WGM * nN, gid = wgid / nig, fm = gid * WGM, gsz = (nM - fm) < WGM ? (nM - fm) : WGM;
        u.pm = fm + ((wgid % nig) % gsz); u.pn = (wgid % nig) / gsz; return true;
    }
};
__device__ __forceinline__ unsigned cvt_pk_bf16(float lo, float hi) { unsigned r; asm volatile("v_cvt_pk_bf16_f32 %0, %1, %2" : "=v"(r) : "v"(lo), "v"(hi)); return r; }

template <int ACT  > struct EpiBf16 {
    static constexpr bool PERM = true;
    bf16_t* O; int ldc;
    __device__ __forceinline__ void operator()(const f32x4 (&acc)[2][2][4][2], const Unit& u, int wr, int wc, int fr, int fq) const {
        const int row0 = u.pm * BM + wr * 64 + fr; const int col0 = u.pn * BM + wc * 32 + 8 * fq;
#pragma unroll
        for (int ai = 0; ai < 2; ++ai)
#pragma unroll
            for (int m = 0; m < 4; ++m) { bf16_t* rowp = O + (size_t)(row0 + ai * HALF + m * 16) * ldc + col0;
#pragma unroll
                for (int bj = 0; bj < 2; ++bj) { f32x4 v0 = acc[ai][bj][m][0], v1 = acc[ai][bj][m][1];
                    if (ACT == 1) {
#pragma unroll
                        for (int j = 0; j < 4; ++j) { float a = fmaxf(v0[j], 0.f), b = fmaxf(v1[j], 0.f); v0[j] = a * a; v1[j] = b * b; } }
                    u32x4 w; w.x = cvt_pk_bf16(v0[0], v0[1]); w.y = cvt_pk_bf16(v0[2], v0[3]); w.z = cvt_pk_bf16(v1[0], v1[1]); w.w = cvt_pk_bf16(v1[2], v1[3]);
                    *(u32x4*)(rowp + bj * HALF) = w; } }
    }
};
struct EpiResid {
    static constexpr bool PERM = false;
    float* C; int ldc; float alpha;
    __device__ __forceinline__ void operator()(const f32x4 (&acc)[2][2][4][2], const Unit& u, int wr, int wc, int fr, int fq) const {
        const int row0 = u.pm * BM + wr * 64 + fr, col0 = u.pn * BM + wc * 32 + 4 * fq;
#pragma unroll
        for (int ai = 0; ai < 2; ++ai)
#pragma unroll
            for (int m = 0; m < 4; ++m) { float* rowp = C + (size_t)(row0 + ai * HALF + m * 16) * ldc + col0;
                f32x4 old[2][2];
#pragma unroll
                for (int bj = 0; bj < 2; ++bj)
#pragma unroll
                    for (int n = 0; n < 2; ++n) old[bj][n] = *(const f32x4*)(rowp + bj * HALF + n * 16);
#pragma unroll
                for (int bj = 0; bj < 2; ++bj)
#pragma unroll
                    for (int n = 0; n < 2; ++n) *(f32x4*)(rowp + bj * HALF + n * 16) = old[bj][n] * alpha + acc[ai][bj][m][n]; }
    }
};

template <class Epi, class Sched>
__device__ __forceinline__ void gemm_phase(LAS unsigned char* lds, const Gemm g, const Sched& S, const Epi& E) {
    const int tid = opaque_tid(), wid = __builtin_amdgcn_readfirstlane(tid >> 6), lane = tid & 63, wr = wid >> 2, wc = wid & 3, fr = lane & 15, fq = lane >> 4;
    const int K = g.K, nt = K / BK, lda = g.lda;
    unsigned voffA[2], voffB[2];
#pragma unroll
    for (int i = 0; i < 2; ++i) { int R, C; stage_rc(tid * 16 + i * 8192, R, C); const int Rb = Epi::PERM ? ((R & ~31) + perm32(R & 31)) : R;
        voffA[i] = (unsigned)(R * lda + C) * 2u; voffB[i] = (unsigned)(Rb * K + C) * 2u; }
    const size_t kstep = (size_t)(BK * 2);
    const size_t hstepA = (size_t)HALF * lda * 2, hstepB = (size_t)HALF * K * 2;
    const size_t tstepA = 2 * hstepA, tstepB = 2 * hstepB;
    const unsigned ldsw = (unsigned)wid * 1024u;
    const int aoff = lds_byte(wr * 64 + fr, fq * 8), boff = lds_byte(wc * 32 + fr, fq * 8);
#define PG8_SA(b, h) (((b) * 2 + (h)) * HTB)
#define PG8_SB(b, h) ((4 + (b) * 2 + (h)) * HTB)
#define PG8_STAGE(bufoff, gbase, voff) do { _Pragma("unroll") for (int _i = 0; _i < 2; ++_i) \
        __builtin_amdgcn_global_load_lds((const unsigned*)((const char*)(gbase) + (voff)[_i]), (LAS unsigned*)(lds + (bufoff) + ldsw + _i * 8192), 16, 0, 0); } while (0)
#define PG8_LDA(dst, b, h) do { _Pragma("unroll") for (int m = 0; m < 4; ++m) _Pragma("unroll") for (int k = 0; k < 2; ++k) dst[m][k] = *(const LAS bf16x8*)(lds + PG8_SA(b, h) + aoff + m * 2048 + k * 1024); } while (0)
#define PG8_LDB(dst, b, h) do { _Pragma("unroll") for (int n = 0; n < 2; ++n) _Pragma("unroll") for (int k = 0; k < 2; ++k) dst[n][k] = *(const LAS bf16x8*)(lds + PG8_SB(b, h) + boff + n * 2048 + k * 1024); } while (0)
#define PG8_MMA(ai, bj, At, Bt) do { __builtin_amdgcn_s_setprio(1); _Pragma("unroll") for (int m = 0; m < 4; ++m) _Pragma("unroll") for (int n = 0; n < 2; ++n) _Pragma("unroll") for (int k = 0; k < 2; ++k) \
        acc[ai][bj][m][n] = __builtin_amdgcn_mfma_f32_16x16x32_bf16(Bt[n][k], At[m][k], acc[ai][bj][m][n], 0, 0, 0); __builtin_amdgcn_s_setprio(0); } while (0)
#define PG8_WAIT_V(n) asm volatile("s_waitcnt vmcnt(" #n ")" ::: "memory")
#define PG8_WAIT_L(n) asm volatile("s_waitcnt lgkmcnt(" #n ")" ::: "memory")
#define PG8_BAR __builtin_amdgcn_s_barrier()
#define PG8_SCHED __builtin_amdgcn_sched_barrier(0)
    Unit cur, nxt; int ui = 0;
    if (!S.next(0, cur)) return;
    f32x4 acc[2][2][4][2];
#pragma unroll
    for (int a = 0; a < 2; ++a)
#pragma unroll
        for (int b = 0; b < 2; ++b)
#pragma unroll
            for (int m = 0; m < 4; ++m)
#pragma unroll
                for (int n = 0; n < 2; ++n) acc[a][b][m][n] = (f32x4){0.f, 0.f, 0.f, 0.f};
    bf16x8 At[4][2], B0[2][2], B1[2][2];
    const char* cA = (const char*)g.A + (size_t)cur.pm * tstepA; const char* cB = (const char*)g.Bt + (size_t)cur.pn * tstepB;
    PG8_STAGE(PG8_SB(0, 0), cB, voffB); PG8_STAGE(PG8_SA(0, 0), cA, voffA); PG8_STAGE(PG8_SB(0, 1), cB + hstepB, voffB); PG8_STAGE(PG8_SA(0, 1), cA + hstepA, voffA);
    if (wr == 1) PG8_BAR;
    PG8_WAIT_V(4); PG8_BAR;
    PG8_STAGE(PG8_SB(1, 0), cB + kstep, voffB); PG8_STAGE(PG8_SA(1, 0), cA + kstep, voffA); PG8_STAGE(PG8_SB(1, 1), cB + hstepB + kstep, voffB);
    PG8_WAIT_V(6); PG8_BAR;
    for (;;) {
        const bool has_next = S.next(ui + 1, nxt);
        const char* nA = has_next ? (const char*)g.A + (size_t)nxt.pm * tstepA : cA; const char* nB = has_next ? (const char*)g.Bt + (size_t)nxt.pn * tstepB : cB;
        for (int t = 0; t < nt; t += 2) {
            const bool last = (t == nt - 2);
            const char* a1 = cA + (size_t)(t + 1) * kstep;
            const char* a2 = last ? nA : cA + (size_t)(t + 2) * kstep; const char* b2 = last ? nB : cB + (size_t)(t + 2) * kstep;
            const char* a3 = a2 + kstep; const char* b3 = b2 + kstep;
            PG8_LDB(B0, 0, 0); PG8_SCHED; PG8_LDA(At, 0, 0); PG8_STAGE(PG8_SA(1, 1), a1 + hstepA, voffA);
            PG8_WAIT_L(8); PG8_BAR; PG8_WAIT_L(0); PG8_MMA(0, 0, At, B0); PG8_BAR; PG8_SCHED;
            PG8_LDB(B1, 0, 1); PG8_STAGE(PG8_SB(0, 0), b2, voffB);
            PG8_BAR; PG8_WAIT_L(0); PG8_MMA(0, 1, At, B1); PG8_BAR;
            PG8_LDA(At, 0, 1); PG8_STAGE(PG8_SA(0, 0), a2, voffA);
            PG8_BAR; PG8_WAIT_L(0); PG8_MMA(1, 0, At, B0); PG8_BAR; PG8_SCHED;
            PG8_STAGE(PG8_SB(0, 1), b2 + hstepB, voffB);
            PG8_WAIT_V(6); PG8_BAR; PG8_MMA(1, 1, At, B1); PG8_BAR;
            PG8_LDB(B0, 1, 0); PG8_SCHED; PG8_LDA(At, 1, 0); PG8_STAGE(PG8_SA(0, 1), a2 + hstepA, voffA);
            PG8_WAIT_L(8); PG8_BAR; PG8_WAIT_L(0); PG8_MMA(0, 0, At, B0); PG8_BAR; PG8_SCHED;
            PG8_LDB(B1, 1, 1); PG8_STAGE(PG8_SB(1, 0), b3, voffB);
            PG8_BAR; PG8_WAIT_L(0); PG8_MMA(0, 1, At, B1); PG8_BAR;
            PG8_LDA(At, 1, 1); PG8_STAGE(PG8_SA(1, 0), a3, voffA);
            PG8_BAR; PG8_WAIT_L(0); PG8_MMA(1, 0, At, B0); PG8_BAR; PG8_SCHED;
            PG8_STAGE(PG8_SB(1, 1), b3 + hstepB, voffB);
            PG8_WAIT_V(6); PG8_BAR; PG8_MMA(1, 1, At, B1); PG8_BAR;
        }
        E(acc, cur, wr, wc, fr, fq);
        if (!has_next) break;
#pragma unroll
        for (int a = 0; a < 2; ++a)
#pragma unroll
            for (int b = 0; b < 2; ++b)
#pragma unroll
                for (int m = 0; m < 4; ++m)
#pragma unroll
                    for (int n = 0; n < 2; ++n) acc[a][b][m][n] = (f32x4){0.f, 0.f, 0.f, 0.f};
        cur = nxt; cA = nA; cB = nB; ++ui;
    }
    PG8_WAIT_V(0);
    if (wr == 0) PG8_BAR;
    PG8_BAR;
#undef PG8_SA
#undef PG8_SB
#undef PG8_STAGE
#undef PG8_LDA
#undef PG8_LDB
#undef PG8_MMA
#undef PG8_WAIT_V
#undef PG8_WAIT_L
#undef PG8_BAR
#undef PG8_SCHED
}
}

__device__ __forceinline__ void transpose_item(const float* W, int Nsrc, int ksrc0, int nsrc0, bf16_t* WT, int K, int k0, int n0, LAS float* scr, int lane) {
#pragma unroll 8
    for (int i = 0; i < 32; ++i) { const int kk = 2 * i + (lane >> 5);
        scr[kk * 33 + (lane & 31)] = nsrc0 >= 0 ? W[(size_t)(ksrc0 + kk) * Nsrc + nsrc0 + (lane & 31)] : 0.f; }
    asm volatile("s_waitcnt lgkmcnt(0)" ::: "memory");
    const int c = lane & 7;
#pragma unroll
    for (int j = 0; j < 4; ++j) { const int n = (lane >> 3) + 8 * j; const LAS float* s = scr + (8 * c) * 33 + n;
        u32x4 o; o.x = pk2(s[0 * 33], s[1 * 33]); o.y = pk2(s[2 * 33], s[3 * 33]); o.z = pk2(s[4 * 33], s[5 * 33]); o.w = pk2(s[6 * 33], s[7 * 33]);
        *(u32x4*)(WT + (size_t)(n0 + n) * K + k0 + 8 * c) = o; }
    asm volatile("s_waitcnt lgkmcnt(0)" ::: "memory");
}
__device__ __forceinline__ int win_colmap(int n0) {
    if (n0 < 384) return n0;
    if (n0 < 768) return 1152 + (n0 - 384);
    if (n0 < 1152) return 384 + (n0 - 768);
    if (n0 < 1536) return 768 + (n0 - 1152);
    if (n0 < NIN) return n0;
    return -1;
}
__device__ __forceinline__ void convert_weights(const Params& p, int l, LAS unsigned char* lds, int widx, int nw) {
    const int tid_ = opaque_tid(); const int wave = tid_ >> 6, lane = tid_ & 63;
    LAS float* scr = (LAS float*)(lds + wave * 8448);
    bf16_t* win_t = (bf16_t*)(p.ws + OFF_WIN); bf16_t* wout_t = (bf16_t*)(p.ws + OFF_WOUT); bf16_t* wup_t = (bf16_t*)(p.ws + OFF_WUP); bf16_t* wdn_t = (bf16_t*)(p.ws + OFF_WDN);
    const float* w_in = p.in[5] + (size_t)l * D * NIN; const float* w_out = p.in[22] + (size_t)l * D * D;
    const float* w_up = p.in[25] + (size_t)l * D * FFN; const float* w_dn = p.in[26] + (size_t)l * FFN * D;
    constexpr int I_IN = (D / 64) * (NINP / 32), I_OUT = (D / 64) * (D / 32), I_UP = (D / 64) * (FFN / 32), I_DN = (FFN / 64) * (D / 32);
    for (int it = widx; it < I_IN + I_OUT + I_UP + I_DN; it += nw) {
        int r = it;
        if (r < I_IN) { const int nb = NINP / 32, kb = r / nb, n0 = (r % nb) * 32; transpose_item(w_in, NIN, kb * 64, win_colmap(n0), win_t, D, kb * 64, n0, scr, lane); continue; } r -= I_IN;
        if (r < I_OUT) { const int nb = D / 32, kb = r / nb, n0 = (r % nb) * 32, k0 = kb * 64; const int ks = k0 < 256 ? 768 + k0 : k0 - 256;
            transpose_item(w_out, D, ks, n0, wout_t, D, k0, n0, scr, lane); continue; } r -= I_OUT;
        if (r < I_UP) { const int nb = FFN / 32, kb = r / nb, n0 = (r % nb) * 32; transpose_item(w_up, FFN, kb * 64, n0, wup_t, D, kb * 64, n0, scr, lane); continue; } r -= I_UP;
        { const int nb = D / 32, kb = r / nb, n0 = (r % nb) * 32; transpose_item(w_dn, D, kb * 64, n0, wdn_t, FFN, kb * 64, n0, scr, lane); }
    }
}

__device__ __forceinline__ void ln_row(const float* src, float* dst32, bf16_t* dstb, const float* g, const float* b, int lane_) {
    int lane = lane_; asm volatile("" : "+v"(lane));
    const f32x4* xr = (const f32x4*)src + lane;
    f32x4 v[4]; float s = 0.f;
#pragma unroll
    for (int j = 0; j < 4; ++j) { v[j] = xr[64 * j]; s += (v[j].x + v[j].y) + (v[j].z + v[j].w); }
    const float mean = wave_sum(s) * (1.f / D); float s2 = 0.f;
#pragma unroll
    for (int j = 0; j < 4; ++j) { v[j] = v[j] - mean; s2 += (v[j].x * v[j].x + v[j].y * v[j].y) + (v[j].z * v[j].z + v[j].w * v[j].w); }
    const float rstd = rsqrtf(wave_sum(s2) * (1.f / D) + LN_EPS);
#pragma unroll
    for (int j = 0; j < 4; ++j) {
        const f32x4 gg = ((const f32x4*)g)[lane + 64 * j], bb = ((const f32x4*)b)[lane + 64 * j];
        f32x4 o = v[j] * rstd * gg + bb;
        ((f32x4*)dst32)[lane + 64 * j] = o;
        u32x2 w; w.x = pk2(o.x, o.y); w.y = pk2(o.z, o.w);
        ((u32x2*)dstb)[lane + 64 * j] = w;
    }
}

#define DSR128(dst, addr, off) asm volatile("ds_read_b128 %0, %1 offset:%2" : "=v"(dst) : "v"(addr), "n"(off))
#define DSR32(dst, addr, off) asm volatile("ds_read_b32 %0, %1 offset:%2" : "=v"(dst) : "v"(addr), "n"(off))
#define LGKM0() do { asm volatile("s_waitcnt lgkmcnt(0)" ::: "memory"); __builtin_amdgcn_sched_barrier(0); } while (0)
#define SCHEDB __builtin_amdgcn_sched_barrier(0)
__device__ __forceinline__ float xsum32(float x) { auto r = __builtin_amdgcn_permlane32_swap(__float_as_uint(x), __float_as_uint(x), false, false); return __uint_as_float(r[0]) + __uint_as_float(r[1]); }
__device__ __forceinline__ float xsum16(float x) { auto r = __builtin_amdgcn_permlane16_swap(__float_as_uint(x), __float_as_uint(x), false, false); return __uint_as_float(r[0]) + __uint_as_float(r[1]); }

constexpr int RTC = 32;
#define RW_ISSUE(BUF, bk, bv, vvn) do { \
    DSR128(BUF[0], bk, 0); DSR128(BUF[1], bk, 16); DSR128(BUF[2], bk, 32); DSR128(BUF[3], bk, 48); \
    DSR128(BUF[4], bk, 256); DSR128(BUF[5], bk, 272); DSR128(BUF[6], bk, 288); DSR128(BUF[7], bk, 304); \
    DSR128(BUF[8], bk, 512); DSR128(BUF[9], bk, 528); DSR128(BUF[10], bk, 544); DSR128(BUF[11], bk, 560); \
    DSR128(BUF[12], bk, 768); DSR128(BUF[13], bk, 784); DSR128(BUF[14], bk, 800); DSR128(BUF[15], bk, 816); \
    DSR32(vvn, bv, 1024); } while (0)
#define RW_COMPUTE(BUF) do { \
    f32x4 sacc = S4[0] * BUF[0] + S4[1] * BUF[1]; sacc += S4[2] * BUF[2] + S4[3] * BUF[3]; \
    const float sa = xsum16(xsum32((sacc.x + sacc.y) + (sacc.z + sacc.w))); \
    f32x4 oacc = (f32x4){0.f, 0.f, 0.f, 0.f}; \
    _Pragma("unroll") for (int i_ = 0; i_ < 4; ++i_) { f32x4 sv = S4[i_] + (sa * BUF[4 + i_] + vv * BUF[8 + i_]); S4[i_] = sv; oacc += sv * BUF[12 + i_]; } \
    oval = xsum16(xsum32((oacc.x + oacc.y) + (oacc.z + oacc.w))); } while (0)

__device__ __forceinline__ void rwkv_scan_wg(const Params& p, int l, int pairIdx, LAS unsigned char* lds) {
    const int tid = opaque_tid(), wave = tid >> 6, lane = tid & 63;
    const int b = pairIdx / 6, h = pairIdx % 6;
    LAS float* ring = (LAS float*)lds;
    LAS float* lam = (LAS float*)(lds + 81920);
    const int dir = wave >> 2, rq = wave & 3;
    const int c = h * 64 + lane;
    const bf16_t* proj = (const bf16_t*)(p.ws + OFF_PROJ);
    bf16_t* o_r = (bf16_t*)(p.ws + OFF_T);
    constexpr int NCH = SEQL / RTC;
    const int kp = lane >> 4, row = lane & 15, v0 = rq * 16 + row;
    f32x4 S4[4];
#pragma unroll
    for (int k = 0; k < 4; ++k) S4[k] = (f32x4){0.f, 0.f, 0.f, 0.f};
    f32x4 A[16], B[16]; float vv = 0.f, vvn = 0.f, oval = 0.f;
    const unsigned ring_addr = (unsigned)(unsigned long long)ring + (unsigned)(dir * RTC * 1280);
    const unsigned lam_addr = (unsigned)(unsigned long long)lam + (unsigned)(dir * 4 * 256) + kp * 64;
    const unsigned offk = ring_addr + kp * 64, offv = ring_addr + v0 * 4;
    bf16_t* orow = o_r + ((size_t)dir * MROWS + (size_t)b * SEQL) * RW + h * 64 + v0;
    const float w0c = p.in[8][(l * 2 + dir) * RW + c], a0c = p.in[10][(l * 2 + dir) * RW + c];
    const float kkc = p.in[13][l * RW + c], kac = p.in[14][l * RW + c];
    const float* mu0 = p.in[7] + (size_t)(l * 2 + 0) * NRW; const float* mu1 = mu0 + NRW;
    const float mr0 = mu0[c], mr1 = mu1[c], mk0 = mu0[384 + c], mk1 = mu1[384 + c], mv0 = mu0[768 + c], mv1 = mu1[768 + c];
    const int lcol = lane < 32 ? 1152 + dir * 32 + lane : 1216 + dir * 32 + (lane - 32);
    const float ml0 = mu0[lcol], ml1 = mu1[lcol];
    bf16x8 Bw[4], Ba[4];
    {   const float* wu = p.in[9] + (size_t)((l * 2 + dir) * 32) * RW + h * 64 + (lane & 15); const float* au = p.in[11] + (size_t)((l * 2 + dir) * 32) * RW + h * 64 + (lane & 15);
#pragma unroll
        for (int ct = 0; ct < 4; ++ct)
#pragma unroll
            for (int jj = 0; jj < 8; ++jj) { const int r = (lane >> 4) * 8 + jj;
                Bw[ct][jj] = (short)f2bf(wu[(size_t)r * RW + ct * 16]); Ba[ct][jj] = (short)f2bf(au[(size_t)r * RW + ct * 16]); } }
#define RW_PREFETCH(CH) do { const int s0_ = (CH) * RTC + rq * 8; const int tlo_ = dir ? SEQL - 8 - s0_ : s0_; \
    _Pragma("unroll") for (int q = 0; q < 10; ++q) { int tr = tlo_ - 1 + q; tr = tr < 0 ? 0 : (tr >= SEQL ? SEQL - 1 : tr); \
        const bf16_t* pr = proj + ((size_t)b * SEQL + tr) * PS; \
        asm volatile("global_load_ushort %0, %1, off" : "+v"(pfd) : "v"(pr + P_R + c)); asm volatile("global_load_ushort %0, %1, off" : "+v"(pfd) : "v"(pr + P_K + c)); \
        asm volatile("global_load_ushort %0, %1, off" : "+v"(pfd) : "v"(pr + P_V + c)); asm volatile("global_load_ushort %0, %1, off" : "+v"(pfd) : "v"(pr + P_RW + lcol)); } } while (0)
    unsigned pfd = 0u;
    for (int chunk = 0; chunk < NCH; ++chunk) {
        {
            const int s0 = chunk * RTC + rq * 8;
            const int tlo = dir ? SEQL - 8 - s0 : s0;
            float rr[10], rk_[10], rv[10], rl[10];
#pragma unroll
            for (int q = 0; q < 10; ++q) {
                const int tr = tlo - 1 + q; const bool ok = (tr >= 0) && (tr < SEQL);
                const bf16_t* pr = proj + ((size_t)b * SEQL + (ok ? tr : 0)) * PS; const float m = ok ? 1.f : 0.f;
                rr[q] = m * bf2f(pr[P_R + c]); rk_[q] = m * bf2f(pr[P_K + c]); rv[q] = m * bf2f(pr[P_V + c]); rl[q] = m * bf2f(pr[P_RW + lcol]);
            }
            float rs[8], ks[8], vs[8], lo[8];
#pragma unroll
            for (int i = 0; i < 8; ++i) {
                const float rc = dir ? rr[8 - i] : rr[i + 1], rp = dir ? rr[7 - i] : rr[i], rn = dir ? rr[9 - i] : rr[i + 2];
                const float kc = dir ? rk_[8 - i] : rk_[i + 1], kp_ = dir ? rk_[7 - i] : rk_[i], kn = dir ? rk_[9 - i] : rk_[i + 2];
                const float vc = dir ? rv[8 - i] : rv[i + 1], vp = dir ? rv[7 - i] : rv[i], vn = dir ? rv[9 - i] : rv[i + 2];
                const float lc = dir ? rl[8 - i] : rl[i + 1], lp = dir ? rl[7 - i] : rl[i], ln = dir ? rl[9 - i] : rl[i + 2];
                rs[i] = rc + mr0 * (rp - rc) + mr1 * (rn - rc);
                ks[i] = kc + mk0 * (kp_ - kc) + mk1 * (kn - kc);
                vs[i] = vc + mv0 * (vp - vc) + mv1 * (vn - vc);
                lo[i] = lc + ml0 * (lp - lc) + ml1 * (ln - lc);
            }
            LAS unsigned short* xs = (LAS unsigned short*)(lds + 86016 + wave * 4096);
#pragma unroll
            for (int i = 0; i < 8; ++i) {
                const float e2 = __expf(2.f * lo[i]); const float th = 1.f - 2.f / (e2 + 1.f);
                xs[i * 64 + lane] = (unsigned short)f2bf(lane < 32 ? th : lo[i]);
            }
            const bf16x8 Aw = *(const LAS bf16x8*)(xs + (lane & 15) * 64 + (lane >> 4) * 8);
            const bf16x8 Aa = *(const LAS bf16x8*)(xs + (lane & 15) * 64 + 32 + (lane >> 4) * 8);
            f32x4 Dw[4], Da[4];
#pragma unroll
            for (int ct = 0; ct < 4; ++ct) {
                Dw[ct] = __builtin_amdgcn_mfma_f32_16x16x32_bf16(Aw, Bw[ct], (f32x4){0.f, 0.f, 0.f, 0.f}, 0, 0, 0);
                Da[ct] = __builtin_amdgcn_mfma_f32_16x16x32_bf16(Aa, Ba[ct], (f32x4){0.f, 0.f, 0.f, 0.f}, 0, 0, 0);
            }
            LAS float* wsf = (LAS float*)xs;
            if (lane < 32) {
#pragma unroll
                for (int ct = 0; ct < 4; ++ct)
#pragma unroll
                    for (int jj = 0; jj < 4; ++jj) {
                        wsf[((lane >> 4) * 4 + jj) * 64 + ct * 16 + (lane & 15)] = Dw[ct][jj];
                        wsf[(8 + (lane >> 4) * 4 + jj) * 64 + ct * 16 + (lane & 15)] = Da[ct][jj];
                    }
            }
            float lamr = 0.f;
#pragma unroll
            for (int i = 0; i < 8; ++i) {
                const int sl = rq * 8 + i;
                const float wpre = w0c + wsf[i * 64 + lane], apre = a0c + wsf[(8 + i) * 64 + lane];
                const float w = -__logf(1.f + __expf(-wpre)) - 0.5f;
                const float ew = __expf(w);
                const float a = sigmoidf_(apre);
                float kk = ks[i] * kkc; const float n2 = wave_sum(kk * kk); kk = kk / fmaxf(sqrtf(n2), 1e-12f);
                const float kd = ks[i] * (1.f + (a - 1.f) * kac);
                const float Lprev = __expf(-lamr); lamr += ew; const float Lcur = __expf(-lamr), Linv = __expf(lamr);
                LAS float* o = ring + (size_t)((dir * RTC + sl) * 5) * 64;
                o[0 * 64 + lane] = -kk * Lprev; o[1 * 64 + lane] = kk * a * Linv; o[2 * 64 + lane] = kd * Linv; o[3 * 64 + lane] = rs[i] * Lcur; o[4 * 64 + lane] = vs[i];
            }
            lam[(dir * 4 + rq) * 64 + lane] = __expf(-lamr);
        }
        __syncthreads();
        if (chunk + 1 < NCH) RW_PREFETCH(chunk + 1);
        {
            RW_ISSUE(A, offk, offv, vvn);
#pragma unroll 1
            for (int sub = 0; sub < 4; ++sub) {
#pragma unroll 1
                for (int it = 0; it < 4; ++it) {
                    const int sl = sub * 8 + it * 2;
                    const unsigned bk1 = offk + (sl + 1) * 1280, bv1 = offv + (sl + 1) * 1280, bk2 = bk1 + 1280, bv2 = bv1 + 1280;
                    const int s = chunk * RTC + sl;
                    LGKM0(); vv = vvn; RW_ISSUE(B, bk1, bv1, vvn); SCHEDB; RW_COMPUTE(A); SCHEDB;
                    if (kp == 0) { const int t = dir ? SEQL - 1 - s : s; orow[(size_t)t * RW] = (bf16_t)f2bf(oval); }
                    LGKM0(); vv = vvn; RW_ISSUE(A, bk2, bv2, vvn); SCHEDB; RW_COMPUTE(B); SCHEDB;
                    if (kp == 0) { const int t = dir ? SEQL - 2 - s : s + 1; orow[(size_t)t * RW] = (bf16_t)f2bf(oval); }
                }
                {   f32x4 L0, L1, L2, L3; const unsigned la = lam_addr + sub * 256;
                    DSR128(L0, la, 0); DSR128(L1, la, 16); DSR128(L2, la, 32); DSR128(L3, la, 48);
                    LGKM0();
                    S4[0] *= L0; S4[1] *= L1; S4[2] *= L2; S4[3] *= L3; SCHEDB; }
            }
            LGKM0();
            asm volatile("s_waitcnt vmcnt(0)" : "+v"(pfd) :: "memory");
        }
        __syncthreads();
    }
}

constexpr int TC = 16;
#define HG_ISSUE(BUF, bk, Q) do { \
    DSR128(BUF[0], bk, Q); DSR128(BUF[1], bk, Q + 16); DSR128(BUF[2], bk, Q + 32); DSR128(BUF[3], bk, Q + 48); \
    DSR128(BUF[4], bk, 256 + Q); DSR128(BUF[5], bk, 256 + Q + 16); DSR128(BUF[6], bk, 256 + Q + 32); DSR128(BUF[7], bk, 256 + Q + 48); \
    DSR128(BUF[8], bk, 512 + Q); DSR128(BUF[9], bk, 512 + Q + 16); DSR128(BUF[10], bk, 512 + Q + 32); DSR128(BUF[11], bk, 512 + Q + 48); } while (0)
#define HG_HALF(BUF, J) do { _Pragma("unroll") for (int i_ = 0; i_ < 4; ++i_) { \
    f32x4 sv = S4[4 * (J) + i_] * BUF[i_] + BUF[4 + i_] * iv; S4[4 * (J) + i_] = sv; oacc += sv * BUF[8 + i_]; } } while (0)

__device__ __forceinline__ void hgrn_scan_wg(const Params& p, int l, int grp, LAS unsigned char* lds) {
    const int tid = opaque_tid(), wave = tid >> 6, lane = tid & 63;
    constexpr int HTC = 16, NCH = SEQL / HTC;
    LAS float* ring = (LAS float*)lds;
    LAS float* lbt = (LAS float*)(lds + 4 * HTC * 4 * 64 * 4);
    bf16_t* proj = (bf16_t*)(p.ws + OFF_PROJ);
    for (int i = tid; i < 2 * RW; i += 512) { const int dr = i / RW, cc = i % RW; const float* lg = p.in[4] + (size_t)dr * 5 * RW + cc;
        float e[5], mx = -1e30f;
#pragma unroll
        for (int j = 0; j < 5; ++j) { e[j] = lg[j * RW]; mx = fmaxf(mx, e[j]); }
        float sum = 0.f, cum = 0.f;
#pragma unroll
        for (int j = 0; j < 5; ++j) { e[j] = __expf(e[j] - mx); sum += e[j]; if (j <= l) cum += e[j]; }
        lbt[i] = cum / sum; }
    __syncthreads();
    const int j = wave >> 1, half = wave & 1, kp = lane >> 5, col = half * 32 + (lane & 31);
    const int cch = grp * 4 + j;
    const int cdir = cch & 1, cb = (cch >> 1) / 6, chh = (cch >> 1) % 6;
    bf16_t* orow = proj + (size_t)cb * SEQL * PS + (cdir ? P_FB : P_FF) + chh * 64 + col;
    const bf16_t* prow = proj + (size_t)cb * SEQL * PS + chh * 64 + lane;
    const float lb = lbt[cdir * RW + chh * 64 + lane];
    f32x4 S4[8];
#pragma unroll
    for (int k = 0; k < 8; ++k) S4[k] = (f32x4){0.f, 0.f, 0.f, 0.f};
    f32x4 A[12], B[12], oacc = (f32x4){0.f, 0.f, 0.f, 0.f}; float iv = 0.f, ivn = 0.f;
    const unsigned ring_addr = (unsigned)(unsigned long long)ring;
    const unsigned cbase = ring_addr + (unsigned)((j * HTC) * 1024);
    const unsigned offk = cbase + kp * 128, offv = cbase + col * 4;
    for (int chunk = 0; chunk < NCH; ++chunk) {
        {
            float qv[8], fv[8], ivv[8];
#pragma unroll
            for (int i = 0; i < 8; ++i) {
                const int sl = half * 8 + i, s = chunk * HTC + sl, t = cdir ? SEQL - 1 - s : s;
                const bf16_t* pr = prow + (size_t)t * PS;
                qv[i] = bf2f(pr[P_Q]); fv[i] = bf2f(pr[cdir ? P_FB : P_FF]); ivv[i] = bf2f(pr[P_I]);
            }
#pragma unroll
            for (int i = 0; i < 8; ++i) {
                const int sl = half * 8 + i;
                const float f = lb + (1.f - lb) * sigmoidf_(fv[i]);
                LAS float* o = ring + (size_t)((j * HTC + sl) * 4) * 64;
                o[lane] = f; o[64 + lane] = 1.f - f; o[128 + lane] = qv[i]; o[192 + lane] = ivv[i];
            }
        }
        __syncthreads();
        {
            HG_ISSUE(A, offk, 0); DSR32(ivn, offv, 768);
#pragma unroll 1
            for (int sl = 0; sl < HTC; ++sl) {
                const unsigned bk = offk + sl * 1024, nbk = bk + 1024, nbv = offv + (sl + 1) * 1024;
                LGKM0(); iv = ivn; HG_ISSUE(B, bk, 64); SCHEDB; oacc = (f32x4){0.f, 0.f, 0.f, 0.f}; HG_HALF(A, 0); SCHEDB;
                LGKM0(); HG_ISSUE(A, nbk, 0); DSR32(ivn, nbv, 768); SCHEDB; HG_HALF(B, 1); SCHEDB;
                const float oval = xsum32((oacc.x + oacc.y) + (oacc.z + oacc.w));
                const int s = chunk * HTC + sl, t = cdir ? SEQL - 1 - s : s;
                if (kp == 0) orow[(size_t)t * PS] = (bf16_t)f2bf(oval);
            }
            LGKM0();
        }
        __syncthreads();
    }
}

__device__ __forceinline__ void conv_wg(const Params& p, int l, int first, int stride, LAS unsigned char* lds) {
    const int tid = opaque_tid(), wave = tid >> 6, lane = tid & 63;
    LAS float* z = (LAS float*)lds;
    LAS float* ot = (LAS float*)(lds + 62 * 256 * 4);
    bf16_t* proj = (bf16_t*)(p.ws + OFF_PROJ);
    const int ch = tid & 255, half = tid >> 8;
    float w[31];
#pragma unroll
    for (int j = 0; j < 31; ++j) w[j] = p.in[18][(size_t)(l * 31 + j) * 256 + ch];
    const float cb = p.in[19][l * 256 + ch];
    const f32x4 lg = ((const f32x4*)(p.in[20] + l * 256))[lane], lbv = ((const f32x4*)(p.in[21] + l * 256))[lane];
    for (int tile = first; tile < MROWS / 32; tile += stride) {
        const int row0 = tile * 32, b = row0 / SEQL, t0 = row0 % SEQL;
        {
            float zv[31], zg[31];
#pragma unroll
            for (int i = 0; i < 31; ++i) { const int r = half + 2 * i, t = t0 - 15 + r; const bool ok = (t >= 0) && (t < SEQL);
                const bf16_t* pr = proj + ((size_t)b * SEQL + (ok ? t : 0)) * PS; zv[i] = ok ? bf2f(pr[P_CV + ch]) : 0.f; zg[i] = bf2f(pr[P_CG + ch]); }
#pragma unroll
            for (int i = 0; i < 31; ++i) z[(half + 2 * i) * 256 + ch] = zv[i] * sigmoidf_(zg[i]);
        }
        __syncthreads();
#pragma unroll 4
        for (int tt = 0; tt < 16; ++tt) { const int tok = half * 16 + tt; float acc = cb;
#pragma unroll
            for (int j = 0; j < 31; ++j) acc += w[j] * z[(tok + j) * 256 + ch];
            ot[tok * 256 + ch] = acc; }
        __syncthreads();
#pragma unroll
        for (int q = 0; q < 4; ++q) { const int tok = wave * 4 + q;
            f32x4 v = *(const LAS f32x4*)(ot + tok * 256 + lane * 4);
            const float mean = wave_sum((v.x + v.y) + (v.z + v.w)) * (1.f / 256.f);
            v = v - mean;
            const float var = wave_sum((v.x * v.x + v.y * v.y) + (v.z * v.z + v.w * v.w)) * (1.f / 256.f);
            const float rstd = rsqrtf(var + LN_EPS);
            f32x4 y = v * rstd * lg + lbv;
            y.x = y.x * sigmoidf_(y.x); y.y = y.y * sigmoidf_(y.y); y.z = y.z * sigmoidf_(y.z); y.w = y.w * sigmoidf_(y.w);
            u32x2 wv; wv.x = pk2(y.x, y.y); wv.y = pk2(y.z, y.w);
            *(u32x2*)(proj + (size_t)(row0 + tok) * PS + P_YC + lane * 4) = wv; }
        __syncthreads();
    }
}

__device__ __forceinline__ void combine_phase(const Params& p, int l, int widx, int nw, LAS unsigned char* lds) {
    const int tid = opaque_tid(), lane = tid & 63;
    bf16_t* proj = (bf16_t*)(p.ws + OFF_PROJ);
    const bf16_t* o_r = (const bf16_t*)(p.ws + OFF_T);
    LAS unsigned* WA = (LAS unsigned*)lds;
    LAS unsigned* WG = (LAS unsigned*)(lds + 49152);
    {
        const float* aup = p.in[11] + (size_t)(l * 2 * 32) * RW; const float* gup = p.in[12] + (size_t)(l * 64) * RW;
        for (int i = tid; i < 2 * 32 * 3 * 64; i += 512) { const int ln = i & 63, hp = (i >> 6) % 3, dr = i / 192; const float* s = aup + (size_t)dr * RW + (2 * hp) * 64 + ln; WA[i] = pk2(s[0], s[64]); }
        for (int i = tid; i < 64 * 3 * 64; i += 512) { const int ln = i & 63, hp = (i >> 6) % 3, r = i / 192; const float* s = gup + (size_t)r * RW + (2 * hp) * 64 + ln; WG[i] = pk2(s[0], s[64]); }
    }
    __syncthreads();
    const float* mu0 = p.in[7] + (size_t)(l * 2 + 0) * NRW; const float* mu1 = mu0 + NRW;
    const float mad0 = mu0[1216 + lane], mad1 = mu1[1216 + lane], mgd0 = mu0[1280 + lane], mgd1 = mu1[1280 + lane];
    for (int g4 = widx; g4 < MROWS / 2; g4 += nw) {
        const int row0 = g4 * 2;
        float adv[2], sgv[2];
#pragma unroll
        for (int tt = 0; tt < 2; ++tt) { const int row = row0 + tt, t = row % SEQL; const bf16_t* pr = proj + (size_t)row * PS;
            const bool hp = t > 0, hn = t < SEQL - 1; const bf16_t* pp = hp ? pr - PS : pr; const bf16_t* pn = hn ? pr + PS : pr; const float fp = hp ? 1.f : 0.f, fn = hn ? 1.f : 0.f;
            const float ac = bf2f(pr[P_AD + lane]), ap = fp * bf2f(pp[P_AD + lane]), an = fn * bf2f(pn[P_AD + lane]);
            const float gc = bf2f(pr[P_GD + lane]), gp = fp * bf2f(pp[P_GD + lane]), gn = fn * bf2f(pn[P_GD + lane]);
            adv[tt] = ac + mad0 * (ap - ac) + mad1 * (an - ac);
            sgv[tt] = sigmoidf_(gc + mgd0 * (gp - gc) + mgd1 * (gn - gc)); }
        float A0[2][6], A1[2][6], G[2][6];
#pragma unroll
        for (int tt = 0; tt < 2; ++tt)
#pragma unroll
            for (int h = 0; h < 6; ++h) { A0[tt][h] = 0.f; A1[tt][h] = 0.f; G[tt][h] = 0.f; }
#pragma unroll 4
        for (int r = 0; r < 32; ++r) {
            float w0[6], w1[6];
#pragma unroll
            for (int hp = 0; hp < 3; ++hp) { const unsigned u0 = WA[(r * 3 + hp) * 64 + lane], u1 = WA[((32 + r) * 3 + hp) * 64 + lane];
                w0[2 * hp] = __uint_as_float(u0 << 16); w0[2 * hp + 1] = __uint_as_float(u0 & 0xffff0000u); w1[2 * hp] = __uint_as_float(u1 << 16); w1[2 * hp + 1] = __uint_as_float(u1 & 0xffff0000u); }
#pragma unroll
            for (int tt = 0; tt < 2; ++tt) { const float s0 = rdlane(adv[tt], r), s1 = rdlane(adv[tt], 32 + r);
#pragma unroll
                for (int h = 0; h < 6; ++h) { A0[tt][h] += s0 * w0[h]; A1[tt][h] += s1 * w1[h]; } }
        }
#pragma unroll 4
        for (int r = 0; r < 64; ++r) {
            float wg[6];
#pragma unroll
            for (int hp = 0; hp < 3; ++hp) { const unsigned u = WG[(r * 3 + hp) * 64 + lane]; wg[2 * hp] = __uint_as_float(u << 16); wg[2 * hp + 1] = __uint_as_float(u & 0xffff0000u); }
#pragma unroll
            for (int tt = 0; tt < 2; ++tt) { const float s = rdlane(sgv[tt], r);
#pragma unroll
                for (int h = 0; h < 6; ++h) G[tt][h] += s * wg[h]; }
        }
#pragma unroll
        for (int h = 0; h < 6; ++h) {
            const int c = h * 64 + lane;
            const float a00 = p.in[10][(l * 2 + 0) * RW + c], a01 = p.in[10][(l * 2 + 1) * RW + c], kac = p.in[14][l * RW + c];
            const float rk = p.in[15][(l * 6 + h) * 64 + lane], gng = p.in[16][l * RW + c], gnb = p.in[17][l * RW + c], ng = p.in[6][l * RW + c];
            const float mr0 = mu0[c], mr1 = mu1[c], mk0 = mu0[384 + c], mk1 = mu1[384 + c], mv0 = mu0[768 + c], mv1 = mu1[768 + c];
#pragma unroll
            for (int tt = 0; tt < 2; ++tt) { const int row = row0 + tt, t = row % SEQL; bf16_t* pr = proj + (size_t)row * PS;
                const bool hp = t > 0, hn = t < SEQL - 1; const bf16_t* pp = hp ? pr - PS : pr; const bf16_t* pn = hn ? pr + PS : pr; const float fp = hp ? 1.f : 0.f, fn = hn ? 1.f : 0.f;
                const float rc = bf2f(pr[P_R + c]), rp = fp * bf2f(pp[P_R + c]), rn = fn * bf2f(pn[P_R + c]);
                const float kc = bf2f(pr[P_K + c]), kp = fp * bf2f(pp[P_K + c]), kn = fn * bf2f(pn[P_K + c]);
                const float vc = bf2f(pr[P_V + c]), vp = fp * bf2f(pp[P_V + c]), vn = fn * bf2f(pn[P_V + c]);
                const float rs = rc + mr0 * (rp - rc) + mr1 * (rn - rc);
                const float ks = kc + mk0 * (kp - kc) + mk1 * (kn - kc);
                const float vs = vc + mv0 * (vp - vc) + mv1 * (vn - vc);
                const float a0 = sigmoidf_(a00 + A0[tt][h]), a1 = sigmoidf_(a01 + A1[tt][h]);
                const float kh = ks * (1.f + (0.5f * (a0 + a1) - 1.f) * kac);
                const float bsum = wave_sum(rs * kh * rk);
                const float o = bf2f(o_r[(size_t)row * RW + c]) + bf2f(o_r[((size_t)MROWS + row) * RW + c]);
                const float mean = wave_sum(o) * (1.f / 64.f); const float dlt = o - mean;
                const float var = wave_sum(dlt * dlt) * (1.f / 64.f);
                const float on = dlt * rsqrtf(var + GN_EPS) * gng + gnb;
                const float yr = (on + bsum * vs) * G[tt][h];
                const float oh = bf2f(pr[P_FF + c]) + bf2f(pr[P_FB + c]);
                const float ms = wave_sum(oh * oh) * (1.f / 64.f);
                const float gh = bf2f(pr[P_G + c]);
                const float yh = oh * rsqrtf(ms + RMS_EPS) * ng * (gh * sigmoidf_(gh));
                pr[P_I + c] = (bf16_t)f2bf(yr);
                pr[P_Q + c] = (bf16_t)f2bf(yh);
            }
        }
    }
}

__global__ void __launch_bounds__(512, 2) fwd_mega(Params p) {
    extern __shared__ __attribute__((aligned(16))) unsigned char smem_raw[];
    LAS unsigned char* lds = (LAS unsigned char*)smem_raw;
    cg::grid_group grid = cg::this_grid();
    const int tid = threadIdx.x, wave = tid >> 6, lane = tid & 63;
    const int G = gridDim.x, bid = blockIdx.x;
    const int widx = bid * 8 + wave, nw = G * 8;
    bf16_t* win_t = (bf16_t*)(p.ws + OFF_WIN); bf16_t* wout_t = (bf16_t*)(p.ws + OFF_WOUT); bf16_t* wup_t = (bf16_t*)(p.ws + OFF_WUP); bf16_t* wdn_t = (bf16_t*)(p.ws + OFF_WDN);
    bf16_t* proj = (bf16_t*)(p.ws + OFF_PROJ); bf16_t* xb = (bf16_t*)(p.ws + OFF_T); bf16_t* hid = proj;
    float* x = p.out;
    volatile LAS unsigned* xst = (volatile LAS unsigned*)(lds + 131072);
    if (tid == 0) { xst[0] = 0u; xst[1] = 0u; xst[2] = 0u; xst[3] = 0u; }
    __syncthreads();
    XcdBarrier xbar = xcd_barrier_post((unsigned*)(p.ws + OFF_BAR), xst);

    convert_weights(p, 0, lds, widx, nw);
    for (int row = widx; row < MROWS; row += nw) {
        const float* src = row < 16 * SEQL ? p.in[0] + (size_t)row * D : p.in[1] + (size_t)(row - 16 * SEQL) * D;
        ln_row(src, x + (size_t)row * D, xb + (size_t)row * D, p.in[2], p.in[3], lane);
    }
    grid.sync();
    for (int l = 0; l < DEPTH; ++l) {
        {
            pg8::Gemm g{xb, win_t, MROWS, NINP, D, D}; pg8::StaticOrder S; S.init(MROWS, NINP, G, bid);
            pg8::EpiBf16<0> E{proj + 256, PS};
            for (int rep = 0; rep < REP_GIN; ++rep) pg8::gemm_phase(lds, g, S, E);
        }
        GSYNC();
        for (int rep = 0; rep < REP_SCAN; ++rep) {
            if (bid < 144) rwkv_scan_wg(p, l, bid, lds);
            else if (bid < 216) { if (rep == 0) hgrn_scan_wg(p, l, bid - 144, lds); }
            else { }
        }
        GSYNC();
        conv_wg(p, l, bid, G, lds);
        for (int rep = 0; rep < REP_COMB; ++rep) combine_phase(p, l, widx, nw, lds);
        GSYNC();
        {
            pg8::Gemm g{proj, wout_t, MROWS, D, D, PS}; pg8::StaticOrder S; S.init(MROWS, D, G, bid);
            pg8::EpiResid E{x, D, DN_ALPHA};
            pg8::gemm_phase(lds, g, S, E);
        }
        GSYNC();
        for (int row = widx; row < MROWS; row += nw)
            ln_row(x + (size_t)row * D, x + (size_t)row * D, xb + (size_t)row * D, p.in[23] + l * D, p.in[24] + l * D, lane);
        GSYNC();
        for (int third = 0; third < 3; ++third) {
            constexpr int MT = MROWS / 3;
            {   pg8::Gemm g{xb + (size_t)third * MT * D, wup_t, MT, FFN, D, D}; pg8::StaticOrder S; S.init(MT, FFN, G, bid);
                pg8::EpiBf16<1> E{hid, FFN};
                for (int rep = 0; rep < REP_UP; ++rep) pg8::gemm_phase(lds, g, S, E); }
            GSYNC();
            {   pg8::Gemm g{hid, wdn_t, MT, D, FFN, FFN}; pg8::StaticOrder S; S.init(MT, D, G, bid);
                pg8::EpiResid E{x + (size_t)third * MT * D, D, DN_ALPHA};
                pg8::gemm_phase(lds, g, S, E); }
            GSYNC();
        }
        if (l + 1 < DEPTH) convert_weights(p, l + 1, lds, widx, nw);
        for (int row = widx; row < MROWS; row += nw)
            ln_row(x + (size_t)row * D, x + (size_t)row * D, xb + (size_t)row * D, p.in[27] + l * D, p.in[28] + l * D, lane);
        GSYNC();
    }
}

extern "C" void kernel_launch(void* const* d_in, const int* in_sizes, int n_in, void* d_out, int out_size, void* d_ws, size_t ws_size, hipStream_t stream) {
    static int grid = 0;
    if (grid == 0) {
        if (n_in != 29 || out_size != MROWS * D || ws_size < WS_END) { fprintf(stderr, "kernel_launch: unexpected shapes (n_in %d out %d ws %zu need %zu)\n", n_in, out_size, ws_size, (size_t)WS_END); grid = -1; return; }
        int dev = 0, cus = 0, per_cu = 0;
        hipGetDevice(&dev);
        hipDeviceGetAttribute(&cus, hipDeviceAttributeMultiprocessorCount, dev);
        if (hipFuncSetAttribute((const void*)fwd_mega, hipFuncAttributeMaxDynamicSharedMemorySize, LDS_BYTES) != hipSuccess) { fprintf(stderr, "kernel_launch: hipFuncSetAttribute failed\n"); grid = -1; return; }
        hipOccupancyMaxActiveBlocksPerMultiprocessor(&per_cu, (const void*)fwd_mega, 512, LDS_BYTES);
        (void)hipGetLastError();
        if (per_cu < 1) per_cu = 1;
        grid = cus;
        if (grid != 256) fprintf(stderr, "kernel_launch: note: %d CUs\n", grid);
    }
    if (grid < 0) return;
    if (hipMemsetAsync((char*)d_ws + OFF_BAR, 0, SZ_BAR, stream) != hipSuccess) { fprintf(stderr, "kernel_launch: memset failed\n"); return; }
    Params p{};
    for (int i = 0; i < 29; ++i) p.in[i] = (const float*)d_in[i];
    p.out = (float*)d_out; p.ws = (unsigned char*)d_ws;
    void* args[] = {&p};
    hipError_t e = hipLaunchCooperativeKernel((const void*)fwd_mega, dim3(grid), dim3(512), args, LDS_BYTES, stream);
    if (e != hipSuccess) fprintf(stderr, "cooperative launch failed: %s (grid %d)\n", hipGetErrorString(e), grid);
}
```

```cpp
#include <hip/hip_runtime.h>
#include <hip/hip_cooperative_groups.h>
#include <cstdio>
#include <cstdint>
namespace cg = cooperative_groups;

#define LAS __attribute__((address_space(3)))
typedef unsigned short bf16_t;
typedef short bf16x8 __attribute__((ext_vector_type(8)));
typedef float f32x4 __attribute__((ext_vector_type(4)));
typedef unsigned u32x4 __attribute__((ext_vector_type(4)));
typedef unsigned u32x2 __attribute__((ext_vector_type(2)));

constexpr int D = 1024, SEQL = 2048, NSEQ = 24, MROWS = NSEQ * SEQL, DEPTH = 4, FFN = 4096;
constexpr int NIN = 3776, NINP = 3840, PS = 4096;
constexpr int RW = 384, NRW = 1344;
constexpr int P_YC = 0, P_Q = 256, P_I = 640, P_FF = 1024, P_FB = 1408, P_G = 1792;
constexpr int P_RW = 2176, P_R = P_RW, P_K = P_RW + 384, P_V = P_RW + 768, P_WD = P_RW + 1152, P_AD = P_RW + 1216, P_GD = P_RW + 1280;
constexpr int P_CV = 3520, P_CG = 3776;
constexpr float LN_EPS = 1e-5f, RMS_EPS = 1e-6f, GN_EPS = 64e-5f;
constexpr float DN_ALPHA = 1.681792830507429f;

constexpr size_t OFF_WIN = 0, SZ_WIN = (size_t)NINP * D * 2;
constexpr size_t OFF_WOUT = OFF_WIN + SZ_WIN, SZ_WOUT = (size_t)D * D * 2;
constexpr size_t OFF_WUP = OFF_WOUT + SZ_WOUT, SZ_WUP = (size_t)FFN * D * 2;
constexpr size_t OFF_WDN = OFF_WUP + SZ_WUP, SZ_WDN = (size_t)FFN * D * 2;
constexpr size_t OFF_PROJ = OFF_WDN + SZ_WDN, SZ_PROJ = (size_t)MROWS * PS * 2;
constexpr size_t OFF_T = OFF_PROJ + SZ_PROJ, SZ_T = (size_t)MROWS * D * 2;
constexpr size_t OFF_BAR = OFF_T + SZ_T, SZ_BAR = 3456 * 4;
constexpr size_t WS_END = OFF_BAR + SZ_BAR;
constexpr int LDS_BYTES = 131072 + 16;
#define REP_SCAN 1
#define REP_COMB 1
#define REP_GIN 1
#define REP_UP 1
#define REP_SYNC 1
#define GSYNC() do { for (int r_ = 0; r_ < REP_SYNC; ++r_) xcd_barrier(xbar); } while (0)

struct Params {
    const float* in[29];
    float* out;
    unsigned char* ws;
};

__device__ __forceinline__ float bf2f(bf16_t b) { return __uint_as_float(((unsigned)b) << 16); }
__device__ __forceinline__ unsigned f2bf(float f) { unsigned u = __float_as_uint(f); u += 0x7FFFu + ((u >> 16) & 1u); return u >> 16; }
__device__ __forceinline__ unsigned pk2(float lo, float hi) { return f2bf(lo) | (f2bf(hi) << 16); }
__device__ __forceinline__ float dpp_add(float v, const int ctrl_sel) {
    int r;
    switch (ctrl_sel) {
        case 0: r = __builtin_amdgcn_update_dpp(0, __float_as_int(v), 0xB1, 0xF, 0xF, true); break;
        case 1: r = __builtin_amdgcn_update_dpp(0, __float_as_int(v), 0x4E, 0xF, 0xF, true); break;
        case 2: r = __builtin_amdgcn_update_dpp(0, __float_as_int(v), 0x141, 0xF, 0xF, true); break;
        default: r = __builtin_amdgcn_update_dpp(0, __float_as_int(v), 0x140, 0xF, 0xF, true); break;
    }
    return v + __int_as_float(r);
}
__device__ __forceinline__ float wave_sum(float v) {
    v = dpp_add(v, 0); v = dpp_add(v, 1); v = dpp_add(v, 2); v = dpp_add(v, 3);
    { auto r = __builtin_amdgcn_permlane16_swap(__float_as_uint(v), __float_as_uint(v), false, false); v = __uint_as_float(r[0]) + __uint_as_float(r[1]); }
    { auto r = __builtin_amdgcn_permlane32_swap(__float_as_uint(v), __float_as_uint(v), false, false); v = __uint_as_float(r[0]) + __uint_as_float(r[1]); }
    return v;
}
__device__ __forceinline__ int opaque_tid() { int t = threadIdx.x; asm volatile("" : "+v"(t)); return t; }
__device__ __forceinline__ float sigmoidf_(float x) { return 1.0f / (1.0f + __expf(-x)); }
__device__ __forceinline__ float rdlane(float v, int l) { return __int_as_float(__builtin_amdgcn_readlane(__float_as_int(v), l)); }

#define XB_TMO      128
#define XB_XCNT(j)  (256  + 64 * (j))
#define XB_XSUB(j)  (1280 + 64 * (j))
#define XB_XGEN(j)  (2304 + 64 * (j))
#define XB_TOP      3328
#define XB_TOPGEN   3392
#define XCD_BAR_WORDS 3456
#define XB_SPIN_CAP (1u << 22)
__device__ __forceinline__ unsigned xb_ld(unsigned* p)              { return __hip_atomic_load(p, __ATOMIC_RELAXED, __HIP_MEMORY_SCOPE_AGENT); }
__device__ __forceinline__ unsigned xb_add(unsigned* p, unsigned v) { return __hip_atomic_fetch_add(p, v, __ATOMIC_RELAXED, __HIP_MEMORY_SCOPE_AGENT); }
__device__ __forceinline__ unsigned xb_xcc_id() { return (unsigned)__builtin_amdgcn_s_getreg((3 << 11) | 20) & 0xFu; }
#define XB_SPIN(cond, bar) do { unsigned _sp = 0; while (cond) { __builtin_amdgcn_s_sleep(1); \
    if ((++_sp & 255u) == 0u) { if (xb_ld(&(bar)[XB_TMO])) break; if (_sp > XB_SPIN_CAP) { atomicAdd(&(bar)[XB_TMO], 1u); break; } } } } while (0)
struct XcdBarrier { unsigned* bar; unsigned x; volatile LAS unsigned* st; };
__device__ __forceinline__ XcdBarrier xcd_barrier_post(unsigned* bar, volatile LAS unsigned* st) {
    XcdBarrier b; b.bar = bar; b.x = xb_xcc_id(); b.st = st;
    if (threadIdx.x == 0) (void)xb_add(&bar[XB_XCNT(b.x)], 1u);
    return b;
}
__device__ __forceinline__ void xcd_barrier_complete(unsigned* bar, unsigned x, unsigned& nloc, unsigned& nx) {
    const unsigned G = gridDim.x * gridDim.y * gridDim.z;
    unsigned sum, cnt, mine, sp = 0u;
    for (;;) {
        sum = 0u; cnt = 0u; mine = 0u;
#pragma unroll
        for (unsigned j = 0; j < 16; ++j) { const unsigned c = xb_ld(&bar[XB_XCNT(j)]); sum += c; cnt += (c > 0u) ? 1u : 0u; mine = (j == x) ? c : mine; }
        if (sum == G) break;
        __builtin_amdgcn_s_sleep(1);
        if ((++sp & 255u) == 0u) { if (xb_ld(&bar[XB_TMO])) break; if (sp > XB_SPIN_CAP) { atomicAdd(&bar[XB_TMO], 1u); break; } }
    }
    nloc = mine > 0u ? mine : 1u; nx = cnt > 0u ? cnt : 1u;
}
__device__ __forceinline__ void xcd_barrier(const XcdBarrier& b) {
    asm volatile("s_waitcnt vmcnt(0)" ::: "memory");
    __syncthreads();
    if (threadIdx.x == 0) {
        unsigned* bar = b.bar;
        __builtin_amdgcn_s_waitcnt(0);
        unsigned nloc = b.st[0], nx = b.st[1];
        if (nloc == 0u) { xcd_barrier_complete(bar, b.x, nloc, nx); b.st[0] = nloc; b.st[1] = nx; }
        const unsigned old = xb_add(&bar[XB_XSUB(b.x)], 1u);
        const unsigned gen = old / nloc;
        if (old + 1u == (gen + 1u) * nloc) {
            __builtin_amdgcn_fence(__ATOMIC_RELEASE, "agent");
            asm volatile("s_waitcnt vmcnt(0)" ::: "memory");
            const unsigned og = xb_add(&bar[XB_TOP], 1u);
            const unsigned tg = og / nx;
            if (og + 1u == (tg + 1u) * nx) xb_add(&bar[XB_TOPGEN], 1u);
            else XB_SPIN(xb_ld(&bar[XB_TOPGEN]) == tg, bar);
            __builtin_amdgcn_fence(__ATOMIC_ACQUIRE, "agent");
            xb_add(&bar[XB_XGEN(b.x)], 1u);
            asm volatile("s_waitcnt vmcnt(0)" ::: "memory");
        } else {
            XB_SPIN(xb_ld(&bar[XB_XGEN(b.x)]) == gen, bar);
            __builtin_amdgcn_fence(__ATOMIC_ACQUIRE, "agent");
            asm volatile("s_waitcnt vmcnt(0)" ::: "memory");
        }
    }
    __syncthreads();
}

namespace pg8 {
constexpr int BM = 256, BK = 64, HALF = 128, HTB = HALF * BK * 2, STAGE_BYTES = 8 * HTB, NXCD = 8, WGM = 8;
__device__ __forceinline__ int lds_byte(int r, int c) { const int st = (r >> 4) * 2 + (c >> 5), rr = r & 15, cc = c & 31, ob = rr * 64 + cc * 2; return st * 1024 + (ob ^ (((ob >> 9) & 1) << 5)); }
__device__ __forceinline__ void stage_rc(int b, int& R, int& C) { const int st = b / 1024, sb = b % 1024, swz = sb ^ (((sb >> 9) & 1) << 5); R = (st >> 1) * 16 + swz / 64; C = (st & 1) * 32 + (swz % 64) / 2; }
__device__ __forceinline__ int perm32(int rho) { const int n = rho >> 4, i = rho & 15; return 8 * (i >> 2) + 4 * n + (i & 3); }
struct Unit { int pm, pn; };
struct Gemm { const bf16_t* A; const bf16_t* Bt; int M, N, K, lda; };
struct StaticOrder {
    int nM, nN, nwg, G, c;
    __device__ void init(int M, int N, int G_, int c_) { nM = M / BM; nN = N / BM; nwg = nM * nN; G = G_; c = c_; }
    __device__ bool next(int i, Unit& u) const {
        const long L = (long)i * G + c; if (L >= nwg) return false;
        int wgid = (int)L; { const int q = nwg / NXCD, r = nwg % NXCD, xcd = wgid % NXCD, off = wgid / NXCD; wgid = (xcd < r ? xcd * (q + 1) : r * (q + 1) + (xcd - r) * q) + off; }
        const int nig = WGM * nN, gid = wgid / nig, fm = gid * WGM, gsz = (nM - fm) < WGM ? (nM - fm) : WGM;
        u.pm = fm + ((wgid % nig) % gsz); u.pn = (wgid % nig) / gsz; return true;
    }
};
__device__ __forceinline__ unsigned cvt_pk_bf16(float lo, float hi) { unsigned r; asm volatile("v_cvt_pk_bf16_f32 %0, %1, %2" : "=v"(r) : "v"(lo), "v"(hi)); return r; }

template <int ACT  > struct EpiBf16 {
    static constexpr bool PERM = true;
    bf16_t* O; int ldc;
    __device__ __forceinline__ void operator()(const f32x4 (&acc)[2][2][4][2], const Unit& u, int wr, int wc, int fr, int fq) const {
        const int row0 = u.pm * BM + wr * 64 + fr; const int col0 = u.pn * BM + wc * 32 + 8 * fq;
#pragma unroll
        for (int ai = 0; ai < 2; ++ai)
#pragma unroll
            for (int m = 0; m < 4; ++m) { bf16_t* rowp = O + (size_t)(row0 + ai * HALF + m * 16) * ldc + col0;
#pragma unroll
                for (int bj = 0; bj < 2; ++bj) { f32x4 v0 = acc[ai][bj][m][0], v1 = acc[ai][bj][m][1];
                    if (ACT == 1) {
#pragma unroll
                        for (int j = 0; j < 4; ++j) { float a = fmaxf(v0[j], 0.f), b = fmaxf(v1[j], 0.f); v0[j] = a * a; v1[j] = b * b; } }
                    u32x4 w; w.x = cvt_pk_bf16(v0[0], v0[1]); w.y = cvt_pk_bf16(v0[2], v0[3]); w.z = cvt_pk_bf16(v1[0], v1[1]); w.w = cvt_pk_bf16(v1[2], v1[3]);
                    *(u32x4*)(rowp + bj * HALF) = w; } }
    }
};
struct EpiResid {
    static constexpr bool PERM = false;
    float* C; int ldc; float alpha;
    __device__ __forceinline__ void operator()(const f32x4 (&acc)[2][2][4][2], const Unit& u, int wr, int wc, int fr, int fq) const {
        const int row0 = u.pm * BM + wr * 64 + fr, col0 = u.pn * BM + wc * 32 + 4 * fq;
#pragma unroll
        for (int ai = 0; ai < 2; ++ai)
#pragma unroll
            for (int m = 0; m < 4; ++m) { float* rowp = C + (size_t)(row0 + ai * HALF + m * 16) * ldc + col0;
                f32x4 old[2][2];
#pragma unroll
                for (int bj = 0; bj < 2; ++bj)
#pragma unroll
                    for (int n = 0; n < 2; ++n) old[bj][n] = *(const f32x4*)(rowp + bj * HALF + n * 16);
#pragma unroll
                for (int bj = 0; bj < 2; ++bj)
#pragma unroll
                    for (int n = 0; n < 2; ++n) *(f32x4*)(rowp + bj * HALF + n * 16) = old[bj][n] * alpha + acc[ai][bj][m][n]; }
    }
};

template <class Epi, class Sched>
__device__ __forceinline__ void gemm_phase(LAS unsigned char* lds, const Gemm g, const Sched& S, const Epi& E) {
    const int tid = opaque_tid(), wid = __builtin_amdgcn_readfirstlane(tid >> 6), lane = tid & 63, wr = wid >> 2, wc = wid & 3, fr = lane & 15, fq = lane >> 4;
    const int K = g.K, nt = K / BK, lda = g.lda;
    unsigned voffA[2], voffB[2];
#pragma unroll
    for (int i = 0; i < 2; ++i) { int R, C; stage_rc(tid * 16 + i * 8192, R, C); const int Rb = Epi::PERM ? ((R & ~31) + perm32(R & 31)) : R;
        voffA[i] = (unsigned)(R * lda + C) * 2u; voffB[i] = (unsigned)(Rb * K + C) * 2u; }
    const size_t kstep = (size_t)(BK * 2);
    const size_t hstepA = (size_t)HALF * lda * 2, hstepB = (size_t)HALF * K * 2;
    const size_t tstepA = 2 * hstepA, tstepB = 2 * hstepB;
    const unsigned ldsw = (unsigned)wid * 1024u;
    const int aoff = lds_byte(wr * 64 + fr, fq * 8), boff = lds_byte(wc * 32 + fr, fq * 8);
#define PG8_SA(b, h) (((b) * 2 + (h)) * HTB)
#define PG8_SB(b, h) ((4 + (b) * 2 + (h)) * HTB)
#define PG8_STAGE(bufoff, gbase, voff) do { _Pragma("unroll") for (int _i = 0; _i < 2; ++_i) \
        __builtin_amdgcn_global_load_lds((const unsigned*)((const char*)(gbase) + (voff)[_i]), (LAS unsigned*)(lds + (bufoff) + ldsw + _i * 8192), 16, 0, 0); } while (0)
#define PG8_LDA(dst, b, h) do { _Pragma("unroll") for (int m = 0; m < 4; ++m) _Pragma("unroll") for (int k = 0; k < 2; ++k) dst[m][k] = *(const LAS bf16x8*)(lds + PG8_SA(b, h) + aoff + m * 2048 + k * 1024); } while (0)
#define PG8_LDB(dst, b, h) do { _Pragma("unroll") for (int n = 0; n < 2; ++n) _Pragma("unroll") for (int k = 0; k < 2; ++k) dst[n][k] = *(const LAS bf16x8*)(lds + PG8_SB(b, h) + boff + n * 2048 + k * 1024); } while (0)
#define PG8_MMA(ai, bj, At, Bt) do { __builtin_amdgcn_s_setprio(1); _Pragma("unroll") for (int m = 0; m < 4; ++m) _Pragma("unroll") for (int n = 0; n < 2; ++n) _Pragma("unroll") for (int k = 0; k < 2; ++k) \
        acc[ai][bj][m][n] = __builtin_amdgcn_mfma_f32_16x16x32_bf16(Bt[n][k], At[m][k], acc[ai][bj][m][n], 0, 0, 0); __builtin_amdgcn_s_setprio(0); } while (0)
#define PG8_WAIT_V(n) asm volatile("s_waitcnt vmcnt(" #n ")" ::: "memory")
#define PG8_WAIT_L(n) asm volatile("s_waitcnt lgkmcnt(" #n ")" ::: "memory")
#define PG8_BAR __builtin_amdgcn_s_barrier()
#define PG8_SCHED __builtin_amdgcn_sched_barrier(0)
    Unit cur, nxt; int ui = 0;
    if (!S.next(0, cur)) return;
    f32x4 acc[2][2][4][2];
#pragma unroll
    for (int a = 0; a < 2; ++a)
#pragma unroll
        for (int b = 0; b < 2; ++b)
#pragma unroll
            for (int m = 0; m < 4; ++m)
#pragma unroll
                for (int n = 0; n < 2; ++n) acc[a][b][m][n] = (f32x4){0.f, 0.f, 0.f, 0.f};
    bf16x8 At[4][2], B0[2][2], B1[2][2];
    const char* cA = (const char*)g.A + (size_t)cur.pm * tstepA; const char* cB = (const char*)g.Bt + (size_t)cur.pn * tstepB;
    PG8_STAGE(PG8_SB(0, 0), cB, voffB); PG8_STAGE(PG8_SA(0, 0), cA, voffA); PG8_STAGE(PG8_SB(0, 1), cB + hstepB, voffB); PG8_STAGE(PG8_SA(0, 1), cA + hstepA, voffA);
    if (wr == 1) PG8_BAR;
    PG8_WAIT_V(4); PG8_BAR;
    PG8_STAGE(PG8_SB(1, 0), cB + kstep, voffB); PG8_STAGE(PG8_SA(1, 0), cA + kstep, voffA); PG8_STAGE(PG8_SB(1, 1), cB + hstepB + kstep, voffB);
    PG8_WAIT_V(6); PG8_BAR;
    for (;;) {
        const bool has_next = S.next(ui + 1, nxt);
        const char* nA = has_next ? (const char*)g.A + (size_t)nxt.pm * tstepA : cA; const char* nB = has_next ? (const char*)g.Bt + (size_t)nxt.pn * tstepB : cB;
        for (int t = 0; t < nt; t += 2) {
            const bool last = (t == nt - 2);
            const char* a1 = cA + (size_t)(t + 1) * kstep;
            const char* a2 = last ? nA : cA + (size_t)(t + 2) * kstep; const char* b2 = last ? nB : cB + (size_t)(t + 2) * kstep;
            const char* a3 = a2 + kstep; const char* b3 = b2 + kstep;
            PG8_LDB(B0, 0, 0); PG8_SCHED; PG8_LDA(At, 0, 0); PG8_STAGE(PG8_SA(1, 1), a1 + hstepA, voffA);
            PG8_WAIT_L(8); PG8_BAR; PG8_WAIT_L(0); PG8_MMA(0, 0, At, B0); PG8_BAR; PG8_SCHED;
            PG8_LDB(B1, 0, 1); PG8_STAGE(PG8_SB(0, 0), b2, voffB);
            PG8_BAR; PG8_WAIT_L(0); PG8_MMA(0, 1, At, B1); PG8_BAR;
            PG8_LDA(At, 0, 1); PG8_STAGE(PG8_SA(0, 0), a2, voffA);
            PG8_BAR; PG8_WAIT_L(0); PG8_MMA(1, 0, At, B0); PG8_BAR; PG8_SCHED;
            PG8_STAGE(PG8_SB(0, 1), b2 + hstepB, voffB);
            PG8_WAIT_V(6); PG8_BAR; PG8_MMA(1, 1, At, B1); PG8_BAR;
            PG8_LDB(B0, 1, 0); PG8_SCHED; PG8_LDA(At, 1, 0); PG8_STAGE(PG8_SA(0, 1), a2 + hstepA, voffA);
            PG8_WAIT_L(8); PG8_BAR; PG8_WAIT_L(0); PG8_MMA(0, 0, At, B0); PG8_BAR; PG8_SCHED;
            PG8_LDB(B1, 1, 1); PG8_STAGE(PG8_SB(1, 0), b3, voffB);
            PG8_BAR; PG8_WAIT_L(0); PG8_MMA(0, 1, At, B1); PG8_BAR;
            PG8_LDA(At, 1, 1); PG8_STAGE(PG8_SA(1, 0), a3, voffA);
            PG8_BAR; PG8_WAIT_L(0); PG8_MMA(1, 0, At, B0); PG8_BAR; PG8_SCHED;
            PG8_STAGE(PG8_SB(1, 1), b3 + hstepB, voffB);
            PG8_WAIT_V(6); PG8_BAR; PG8_MMA(1, 1, At, B1); PG8_BAR;
        }
        E(acc, cur, wr, wc, fr, fq);
        if (!has_next) break;
#pragma unroll
        for (int a = 0; a < 2; ++a)
#pragma unroll
            for (int b = 0; b < 2; ++b)
#pragma unroll
                for (int m = 0; m < 4; ++m)
#pragma unroll
                    for (int n = 0; n < 2; ++n) acc[a][b][m][n] = (f32x4){0.f, 0.f, 0.f, 0.f};
        cur = nxt; cA = nA; cB = nB; ++ui;
    }
    PG8_WAIT_V(0);
    if (wr == 0) PG8_BAR;
    PG8_BAR;
#undef PG8_SA
#undef PG8_SB
#undef PG8_STAGE
#undef PG8_LDA
#undef PG8_LDB
#undef PG8_MMA
#undef PG8_WAIT_V
#undef PG8_WAIT_L
#undef PG8_BAR
#undef PG8_SCHED
}
}

__device__ __forceinline__ void transpose_item(const float* W, int Nsrc, int ksrc0, int nsrc0, bf16_t* WT, int K, int k0, int n0, LAS float* scr, int lane) {
#pragma unroll 8
    for (int i = 0; i < 32; ++i) { const int kk = 2 * i + (lane >> 5);
        scr[kk * 33 + (lane & 31)] = nsrc0 >= 0 ? W[(size_t)(ksrc0 + kk) * Nsrc + nsrc0 + (lane & 31)] : 0.f; }
    asm volatile("s_waitcnt lgkmcnt(0)" ::: "memory");
    const int c = lane & 7;
#pragma unroll
    for (int j = 0; j < 4; ++j) { const int n = (lane >> 3) + 8 * j; const LAS float* s = scr + (8 * c) * 33 + n;
        u32x4 o; o.x = pk2(s[0 * 33], s[1 * 33]); o.y = pk2(s[2 * 33], s[3 * 33]); o.z = pk2(s[4 * 33], s[5 * 33]); o.w = pk2(s[6 * 33], s[7 * 33]);
        *(u32x4*)(WT + (size_t)(n0 + n) * K + k0 + 8 * c) = o; }
    asm volatile("s_waitcnt lgkmcnt(0)" ::: "memory");
}
__device__ __forceinline__ int win_colmap(int n0) {
    if (n0 < 384) return n0;
    if (n0 < 768) return 1152 + (n0 - 384);
    if (n0 < 1152) return 384 + (n0 - 768);
    if (n0 < 1536) return 768 + (n0 - 1152);
    if (n0 < NIN) return n0;
    return -1;
}
__device__ __forceinline__ void convert_weights(const Params& p, int l, LAS unsigned char* lds, int widx, int nw) {
    const int tid_ = opaque_tid(); const int wave = tid_ >> 6, lane = tid_ & 63;
    LAS float* scr = (LAS float*)(lds + wave * 8448);
    bf16_t* win_t = (bf16_t*)(p.ws + OFF_WIN); bf16_t* wout_t = (bf16_t*)(p.ws + OFF_WOUT); bf16_t* wup_t = (bf16_t*)(p.ws + OFF_WUP); bf16_t* wdn_t = (bf16_t*)(p.ws + OFF_WDN);
    const float* w_in = p.in[5] + (size_t)l * D * NIN; const float* w_out = p.in[22] + (size_t)l * D * D;
    const float* w_up = p.in[25] + (size_t)l * D * FFN; const float* w_dn = p.in[26] + (size_t)l * FFN * D;
    constexpr int I_IN = (D / 64) * (NINP / 32), I_OUT = (D / 64) * (D / 32), I_UP = (D / 64) * (FFN / 32), I_DN = (FFN / 64) * (D / 32);
    for (int it = widx; it < I_IN + I_OUT + I_UP + I_DN; it += nw) {
        int r = it;
        if (r < I_IN) { const int nb = NINP / 32, kb = r / nb, n0 = (r % nb) * 32; transpose_item(w_in, NIN, kb * 64, win_colmap(n0), win_t, D, kb * 64, n0, scr, lane); continue; } r -= I_IN;
        if (r < I_OUT) { const int nb = D / 32, kb = r / nb, n0 = (r % nb) * 32, k0 = kb * 64; const int ks = k0 < 256 ? 768 + k0 : k0 - 256;
            transpose_item(w_out, D, ks, n0, wout_t, D, k0, n0, scr, lane); continue; } r -= I_OUT;
        if (r < I_UP) { const int nb = FFN / 32, kb = r / nb, n0 = (r % nb) * 32; transpose_item(w_up, FFN, kb * 64, n0, wup_t, D, kb * 64, n0, scr, lane); continue; } r -= I_UP;
        { const int nb = D / 32, kb = r / nb, n0 = (r % nb) * 32; transpose_item(w_dn, D, kb * 64, n0, wdn_t, FFN, kb * 64, n0, scr, lane); }
    }
}

__device__ __forceinline__ void ln_row(const float* src, float* dst32, bf16_t* dstb, const float* g, const float* b, int lane_) {
    int lane = lane_; asm volatile("" : "+v"(lane));
    const f32x4* xr = (const f32x4*)src + lane;
    f32x4 v[4]; float s = 0.f;
#pragma unroll
    for (int j = 0; j < 4; ++j) { v[j] = xr[64 * j]; s += (v[j].x + v[j].y) + (v[j].z + v[j].w); }
    const float mean = wave_sum(s) * (1.f / D); float s2 = 0.f;
#pragma unroll
    for (int j = 0; j < 4; ++j) { v[j] = v[j] - mean; s2 += (v[j].x * v[j].x + v[j].y * v[j].y) + (v[j].z * v[j].z + v[j].w * v[j].w); }
    const float rstd = rsqrtf(wave_sum(s2) * (1.f / D) + LN_EPS);
#pragma unroll
    for (int j = 0; j < 4; ++j) {
        const f32x4 gg = ((const f32x4*)g)[lane + 64 * j], bb = ((const f32x4*)b)[lane + 64 * j];
        f32x4 o = v[j] * rstd * gg + bb;
        ((f32x4*)dst32)[lane + 64 * j] = o;
        u32x2 w; w.x = pk2(o.x, o.y); w.y = pk2(o.z, o.w);
        ((u32x2*)dstb)[lane + 64 * j] = w;
    }
}

__device__ __forceinline__ void ln_row2(const float* src0, const float* src1, float* d0, float* d1, bf16_t* b0, bf16_t* b1, const float* g, const float* b, int lane_) {
    int lane = lane_; asm volatile("" : "+v"(lane));
    const f32x4* x0 = (const f32x4*)src0 + lane; const f32x4* x1 = (const f32x4*)src1 + lane;
    f32x4 v[4], u[4]; float s = 0.f, t = 0.f;
#pragma unroll
    for (int j = 0; j < 4; ++j) { v[j] = x0[64 * j]; u[j] = x1[64 * j]; }
#pragma unroll
    for (int j = 0; j < 4; ++j) { s += (v[j].x + v[j].y) + (v[j].z + v[j].w); t += (u[j].x + u[j].y) + (u[j].z + u[j].w); }
    const float m0 = wave_sum(s) * (1.f / D), m1 = wave_sum(t) * (1.f / D); float s2 = 0.f, t2 = 0.f;
#pragma unroll
    for (int j = 0; j < 4; ++j) { v[j] = v[j] - m0; u[j] = u[j] - m1; s2 += (v[j].x * v[j].x + v[j].y * v[j].y) + (v[j].z * v[j].z + v[j].w * v[j].w); t2 += (u[j].x * u[j].x + u[j].y * u[j].y) + (u[j].z * u[j].z + u[j].w * u[j].w); }
    const float r0 = rsqrtf(wave_sum(s2) * (1.f / D) + LN_EPS), r1 = rsqrtf(wave_sum(t2) * (1.f / D) + LN_EPS);
#pragma unroll
    for (int j = 0; j < 4; ++j) {
        const f32x4 gg = ((const f32x4*)g)[lane + 64 * j], bb = ((const f32x4*)b)[lane + 64 * j];
        const f32x4 o0 = v[j] * r0 * gg + bb, o1 = u[j] * r1 * gg + bb;
        ((f32x4*)d0)[lane + 64 * j] = o0; ((f32x4*)d1)[lane + 64 * j] = o1;
        u32x2 w0, w1; w0.x = pk2(o0.x, o0.y); w0.y = pk2(o0.z, o0.w); w1.x = pk2(o1.x, o1.y); w1.y = pk2(o1.z, o1.w);
        ((u32x2*)b0)[lane + 64 * j] = w0; ((u32x2*)b1)[lane + 64 * j] = w1;
    }
}

#define DSR128(dst, addr, off) asm volatile("ds_read_b128 %0, %1 offset:%2" : "=v"(dst) : "v"(addr), "n"(off))
#define DSR32(dst, addr, off) asm volatile("ds_read_b32 %0, %1 offset:%2" : "=v"(dst) : "v"(addr), "n"(off))
#define LGKM0() do { asm volatile("s_waitcnt lgkmcnt(0)" ::: "memory"); __builtin_amdgcn_sched_barrier(0); } while (0)
#define SCHEDB __builtin_amdgcn_sched_barrier(0)
__device__ __forceinline__ float xsum32(float x) { auto r = __builtin_amdgcn_permlane32_swap(__float_as_uint(x), __float_as_uint(x), false, false); return __uint_as_float(r[0]) + __uint_as_float(r[1]); }
__device__ __forceinline__ float xsum16(float x) { auto r = __builtin_amdgcn_permlane16_swap(__float_as_uint(x), __float_as_uint(x), false, false); return __uint_as_float(r[0]) + __uint_as_float(r[1]); }

constexpr int RTC = 32;
#define RW_ISSUE(BUF, bk, bv, vvn) do { \
    DSR128(BUF[0], bk, 0); DSR128(BUF[1], bk, 16); DSR128(BUF[2], bk, 32); DSR128(BUF[3], bk, 48); \
    DSR128(BUF[4], bk, 256); DSR128(BUF[5], bk, 272); DSR128(BUF[6], bk, 288); DSR128(BUF[7], bk, 304); \
    DSR128(BUF[8], bk, 512); DSR128(BUF[9], bk, 528); DSR128(BUF[10], bk, 544); DSR128(BUF[11], bk, 560); \
    DSR128(BUF[12], bk, 768); DSR128(BUF[13], bk, 784); DSR128(BUF[14], bk, 800); DSR128(BUF[15], bk, 816); \
    DSR32(vvn, bv, 1024); } while (0)
#define RW_COMPUTE(BUF) do { \
    f32x4 sacc = S4[0] * BUF[0] + S4[1] * BUF[1]; sacc += S4[2] * BUF[2] + S4[3] * BUF[3]; \
    const float sa = xsum16(xsum32((sacc.x + sacc.y) + (sacc.z + sacc.w))); \
    f32x4 oacc = (f32x4){0.f, 0.f, 0.f, 0.f}; \
    _Pragma("unroll") for (int i_ = 0; i_ < 4; ++i_) { f32x4 sv = S4[i_] + (sa * BUF[4 + i_] + vv * BUF[8 + i_]); S4[i_] = sv; oacc += sv * BUF[12 + i_]; } \
    oval = xsum16(xsum32((oacc.x + oacc.y) + (oacc.z + oacc.w))); } while (0)

__device__ __forceinline__ void rwkv_scan_wg(const Params& p, int l, int pairIdx, LAS unsigned char* lds) {
    const int tid = opaque_tid(), wave = tid >> 6, lane = tid & 63;
    const int b = pairIdx / 6, h = pairIdx % 6;
    LAS float* ring = (LAS float*)lds;
    LAS float* lam = (LAS float*)(lds + 81920);
    const int dir = wave >> 2, rq = wave & 3;
    const int c = h * 64 + lane;
    const bf16_t* proj = (const bf16_t*)(p.ws + OFF_PROJ);
    bf16_t* o_r = (bf16_t*)(p.ws + OFF_T);
    constexpr int NCH = SEQL / RTC;
    const int kp = lane >> 4, row = lane & 15, v0 = rq * 16 + row;
    f32x4 S4[4];
#pragma unroll
    for (int k = 0; k < 4; ++k) S4[k] = (f32x4){0.f, 0.f, 0.f, 0.f};
    f32x4 A[16], B[16]; float vv = 0.f, vvn = 0.f, oval = 0.f;
    const unsigned ring_addr = (unsigned)(unsigned long long)ring + (unsigned)(dir * RTC * 1280);
    const unsigned lam_addr = (unsigned)(unsigned long long)lam + (unsigned)(dir * 4 * 256) + kp * 64;
    const unsigned offk = ring_addr + kp * 64, offv = ring_addr + v0 * 4;
    bf16_t* orow = o_r + ((size_t)dir * MROWS + (size_t)b * SEQL) * RW + h * 64 + v0;
    const float w0c = p.in[8][(l * 2 + dir) * RW + c], a0c = p.in[10][(l * 2 + dir) * RW + c];
    const float kkc = p.in[13][l * RW + c], kac = p.in[14][l * RW + c];
    const float* mu0 = p.in[7] + (size_t)(l * 2 + 0) * NRW; const float* mu1 = mu0 + NRW;
    const float mr0 = mu0[c], mr1 = mu1[c], mk0 = mu0[384 + c], mk1 = mu1[384 + c], mv0 = mu0[768 + c], mv1 = mu1[768 + c];
    const int lcol = lane < 32 ? 1152 + dir * 32 + lane : 1216 + dir * 32 + (lane - 32);
    const float ml0 = mu0[lcol], ml1 = mu1[lcol];
    bf16x8 Bw[4], Ba[4];
    {   const float* wu = p.in[9] + (size_t)((l * 2 + dir) * 32) * RW + h * 64 + (lane & 15); const float* au = p.in[11] + (size_t)((l * 2 + dir) * 32) * RW + h * 64 + (lane & 15);
#pragma unroll
        for (int ct = 0; ct < 4; ++ct)
#pragma unroll
            for (int jj = 0; jj < 8; ++jj) { const int r = (lane >> 4) * 8 + jj;
                Bw[ct][jj] = (short)f2bf(wu[(size_t)r * RW + ct * 16]); Ba[ct][jj] = (short)f2bf(au[(size_t)r * RW + ct * 16]); } }
#define RW_PREFETCH(CH) do { const int s0_ = (CH) * RTC + rq * 8; const int tlo_ = dir ? SEQL - 8 - s0_ : s0_; \
    _Pragma("unroll") for (int q = 0; q < 10; ++q) { int tr = tlo_ - 1 + q; tr = tr < 0 ? 0 : (tr >= SEQL ? SEQL - 1 : tr); \
        const bf16_t* pr = proj + ((size_t)b * SEQL + tr) * PS; \
        asm volatile("global_load_ushort %0, %1, off" : "+v"(pfd) : "v"(pr + P_R + c)); asm volatile("global_load_ushort %0, %1, off" : "+v"(pfd) : "v"(pr + P_K + c)); \
        asm volatile("global_load_ushort %0, %1, off" : "+v"(pfd) : "v"(pr + P_V + c)); asm volatile("global_load_ushort %0, %1, off" : "+v"(pfd) : "v"(pr + P_RW + lcol)); } } while (0)
    unsigned pfd = 0u;
    for (int chunk = 0; chunk < NCH; ++chunk) {
        {
            const int s0 = chunk * RTC + rq * 8;
            const int tlo = dir ? SEQL - 8 - s0 : s0;
            float rr[10], rk_[10], rv[10], rl[10];
#pragma unroll
            for (int q = 0; q < 10; ++q) {
                const int tr = tlo - 1 + q; const bool ok = (tr >= 0) && (tr < SEQL);
                const bf16_t* pr = proj + ((size_t)b * SEQL + (ok ? tr : 0)) * PS; const float m = ok ? 1.f : 0.f;
                rr[q] = m * bf2f(pr[P_R + c]); rk_[q] = m * bf2f(pr[P_K + c]); rv[q] = m * bf2f(pr[P_V + c]); rl[q] = m * bf2f(pr[P_RW + lcol]);
            }
            float rs[8], ks[8], vs[8], lo[8];
#pragma unroll
            for (int i = 0; i < 8; ++i) {
                const float rc = dir ? rr[8 - i] : rr[i + 1], rp = dir ? rr[7 - i] : rr[i], rn = dir ? rr[9 - i] : rr[i + 2];
                const float kc = dir ? rk_[8 - i] : rk_[i + 1], kp_ = dir ? rk_[7 - i] : rk_[i], kn = dir ? rk_[9 - i] : rk_[i + 2];
                const float vc = dir ? rv[8 - i] : rv[i + 1], vp = dir ? rv[7 - i] : rv[i], vn = dir ? rv[9 - i] : rv[i + 2];
                const float lc = dir ? rl[8 - i] : rl[i + 1], lp = dir ? rl[7 - i] : rl[i], ln = dir ? rl[9 - i] : rl[i + 2];
                rs[i] = rc + mr0 * (rp - rc) + mr1 * (rn - rc);
                ks[i] = kc + mk0 * (kp_ - kc) + mk1 * (kn - kc);
                vs[i] = vc + mv0 * (vp - vc) + mv1 * (vn - vc);
                lo[i] = lc + ml0 * (lp - lc) + ml1 * (ln - lc);
            }
            LAS unsigned short* xs = (LAS unsigned short*)(lds + 86016 + wave * 4096);
#pragma unroll
            for (int i = 0; i < 8; ++i) {
                const float e2 = __expf(2.f * lo[i]); const float th = 1.f - 2.f / (e2 + 1.f);
                xs[i * 64 + lane] = (unsigned short)f2bf(lane < 32 ? th : lo[i]);
            }
            const bf16x8 Aw = *(const LAS bf16x8*)(xs + (lane & 15) * 64 + (lane >> 4) * 8);
            const bf16x8 Aa = *(const LAS bf16x8*)(xs + (lane & 15) * 64 + 32 + (lane >> 4) * 8);
            f32x4 Dw[4], Da[4];
#pragma unroll
            for (int ct = 0; ct < 4; ++ct) {
                Dw[ct] = __builtin_amdgcn_mfma_f32_16x16x32_bf16(Aw, Bw[ct], (f32x4){0.f, 0.f, 0.f, 0.f}, 0, 0, 0);
                Da[ct] = __builtin_amdgcn_mfma_f32_16x16x32_bf16(Aa, Ba[ct], (f32x4){0.f, 0.f, 0.f, 0.f}, 0, 0, 0);
            }
            LAS float* wsf = (LAS float*)xs;
            if (lane < 32) {
#pragma unroll
                for (int ct = 0; ct < 4; ++ct)
#pragma unroll
                    for (int jj = 0; jj < 4; ++jj) {
                        wsf[((lane >> 4) * 4 + jj) * 64 + ct * 16 + (lane & 15)] = Dw[ct][jj];
                        wsf[(8 + (lane >> 4) * 4 + jj) * 64 + ct * 16 + (lane & 15)] = Da[ct][jj];
                    }
            }
            float lamr = 0.f;
#pragma unroll
            for (int i = 0; i < 8; ++i) {
                const int sl = rq * 8 + i;
                const float wpre = w0c + wsf[i * 64 + lane], apre = a0c + wsf[(8 + i) * 64 + lane];
                const float w = -__logf(1.f + __expf(-wpre)) - 0.5f;
                const float ew = __expf(w);
                const float a = sigmoidf_(apre);
                float kk = ks[i] * kkc; const float n2 = wave_sum(kk * kk); kk = kk / fmaxf(sqrtf(n2), 1e-12f);
                const float kd = ks[i] * (1.f + (a - 1.f) * kac);
                const float Lprev = __expf(-lamr); lamr += ew; const float Lcur = __expf(-lamr), Linv = __expf(lamr);
                LAS float* o = ring + (size_t)((dir * RTC + sl) * 5) * 64;
                o[0 * 64 + lane] = -kk * Lprev; o[1 * 64 + lane] = kk * a * Linv; o[2 * 64 + lane] = kd * Linv; o[3 * 64 + lane] = rs[i] * Lcur; o[4 * 64 + lane] = vs[i];
            }
            lam[(dir * 4 + rq) * 64 + lane] = __expf(-lamr);
        }
        __syncthreads();
        if (chunk + 1 < NCH) RW_PREFETCH(chunk + 1);
        {
            RW_ISSUE(A, offk, offv, vvn);
#pragma unroll 1
            for (int sub = 0; sub < 4; ++sub) {
#pragma unroll 1
                for (int it = 0; it < 4; ++it) {
                    const int sl = sub * 8 + it * 2;
                    const unsigned bk1 = offk + (sl + 1) * 1280, bv1 = offv + (sl + 1) * 1280, bk2 = bk1 + 1280, bv2 = bv1 + 1280;
                    const int s = chunk * RTC + sl;
                    LGKM0(); vv = vvn; RW_ISSUE(B, bk1, bv1, vvn); SCHEDB; RW_COMPUTE(A); SCHEDB;
                    if (kp == 0) { const int t = dir ? SEQL - 1 - s : s; orow[(size_t)t * RW] = (bf16_t)f2bf(oval); }
                    LGKM0(); vv = vvn; RW_ISSUE(A, bk2, bv2, vvn); SCHEDB; RW_COMPUTE(B); SCHEDB;
                    if (kp == 0) { const int t = dir ? SEQL - 2 - s : s + 1; orow[(size_t)t * RW] = (bf16_t)f2bf(oval); }
                }
                {   f32x4 L0, L1, L2, L3; const unsigned la = lam_addr + sub * 256;
                    DSR128(L0, la, 0); DSR128(L1, la, 16); DSR128(L2, la, 32); DSR128(L3, la, 48);
                    LGKM0();
                    S4[0] *= L0; S4[1] *= L1; S4[2] *= L2; S4[3] *= L3; SCHEDB; }
            }
            LGKM0();
            asm volatile("s_waitcnt vmcnt(0)" : "+v"(pfd) :: "memory");
        }
        __syncthreads();
    }
}

constexpr int TC = 16;
#define HG_ISSUE(BUF, bk, Q) do { \
    DSR128(BUF[0], bk, Q); DSR128(BUF[1], bk, Q + 16); DSR128(BUF[2], bk, Q + 32); DSR128(BUF[3], bk, Q + 48); \
    DSR128(BUF[4], bk, 256 + Q); DSR128(BUF[5], bk, 256 + Q + 16); DSR128(BUF[6], bk, 256 + Q + 32); DSR128(BUF[7], bk, 256 + Q + 48); \
    DSR128(BUF[8], bk, 512 + Q); DSR128(BUF[9], bk, 512 + Q + 16); DSR128(BUF[10], bk, 512 + Q + 32); DSR128(BUF[11], bk, 512 + Q + 48); } while (0)
#define HG_HALF(BUF, J) do { _Pragma("unroll") for (int i_ = 0; i_ < 4; ++i_) { \
    f32x4 sv = S4[4 * (J) + i_] * BUF[i_] + BUF[4 + i_] * iv; S4[4 * (J) + i_] = sv; oacc += sv * BUF[8 + i_]; } } while (0)

__device__ __forceinline__ void hgrn_scan_wg(const Params& p, int l, int grp, LAS unsigned char* lds) {
    const int tid = opaque_tid(), wave = tid >> 6, lane = tid & 63;
    constexpr int HTC = 16, NCH = SEQL / HTC;
    LAS float* ring = (LAS float*)lds;
    LAS float* lbt = (LAS float*)(lds + 4 * HTC * 4 * 64 * 4);
    bf16_t* proj = (bf16_t*)(p.ws + OFF_PROJ);
    for (int i = tid; i < 2 * RW; i += 512) { const int dr = i / RW, cc = i % RW; const float* lg = p.in[4] + (size_t)dr * 5 * RW + cc;
        float e[5], mx = -1e30f;
#pragma unroll
        for (int j = 0; j < 5; ++j) { e[j] = lg[j * RW]; mx = fmaxf(mx, e[j]); }
        float sum = 0.f, cum = 0.f;
#pragma unroll
        for (int j = 0; j < 5; ++j) { e[j] = __expf(e[j] - mx); sum += e[j]; if (j <= l) cum += e[j]; }
        lbt[i] = cum / sum; }
    __syncthreads();
    const int j = wave >> 1, half = wave & 1, kp = lane >> 5, col = half * 32 + (lane & 31);
    const int cch = grp * 4 + j;
    const int cdir = cch & 1, cb = (cch >> 1) / 6, chh = (cch >> 1) % 6;
    bf16_t* orow = proj + (size_t)cb * SEQL * PS + (cdir ? P_FB : P_FF) + chh * 64 + col;
    const bf16_t* prow = proj + (size_t)cb * SEQL * PS + chh * 64 + lane;
    const float lb = lbt[cdir * RW + chh * 64 + lane];
    f32x4 S4[8];
#pragma unroll
    for (int k = 0; k < 8; ++k) S4[k] = (f32x4){0.f, 0.f, 0.f, 0.f};
    f32x4 A[12], B[12], oacc = (f32x4){0.f, 0.f, 0.f, 0.f}; float iv = 0.f, ivn = 0.f;
    const unsigned ring_addr = (unsigned)(unsigned long long)ring;
    const unsigned cbase = ring_addr + (unsigned)((j * HTC) * 1024);
    const unsigned offk = cbase + kp * 128, offv = cbase + col * 4;
    for (int chunk = 0; chunk < NCH; ++chunk) {
        {
            float qv[8], fv[8], ivv[8];
#pragma unroll
            for (int i = 0; i < 8; ++i) {
                const int sl = half * 8 + i, s = chunk * HTC + sl, t = cdir ? SEQL - 1 - s : s;
                const bf16_t* pr = prow + (size_t)t * PS;
                qv[i] = bf2f(pr[P_Q]); fv[i] = bf2f(pr[cdir ? P_FB : P_FF]); ivv[i] = bf2f(pr[P_I]);
            }
#pragma unroll
            for (int i = 0; i < 8; ++i) {
                const int sl = half * 8 + i;
                const float f = lb + (1.f - lb) * sigmoidf_(fv[i]);
                LAS float* o = ring + (size_t)((j * HTC + sl) * 4) * 64;
                o[lane] = f; o[64 + lane] = 1.f - f; o[128 + lane] = qv[i]; o[192 + lane] = ivv[i];
            }
        }
        __syncthreads();
        {
            HG_ISSUE(A, offk, 0); DSR32(ivn, offv, 768);
#pragma unroll 1
            for (int sl = 0; sl < HTC; ++sl) {
                const unsigned bk = offk + sl * 1024, nbk = bk + 1024, nbv = offv + (sl + 1) * 1024;
                LGKM0(); iv = ivn; HG_ISSUE(B, bk, 64); SCHEDB; oacc = (f32x4){0.f, 0.f, 0.f, 0.f}; HG_HALF(A, 0); SCHEDB;
                LGKM0(); HG_ISSUE(A, nbk, 0); DSR32(ivn, nbv, 768); SCHEDB; HG_HALF(B, 1); SCHEDB;
                const float oval = xsum32((oacc.x + oacc.y) + (oacc.z + oacc.w));
                const int s = chunk * HTC + sl, t = cdir ? SEQL - 1 - s : s;
                if (kp == 0) orow[(size_t)t * PS] = (bf16_t)f2bf(oval);
            }
            LGKM0();
        }
        __syncthreads();
    }
}

__device__ __forceinline__ void conv_wg(const Params& p, int l, int first, int stride, LAS unsigned char* lds) {
    const int tid = opaque_tid(), wave = tid >> 6, lane = tid & 63;
    LAS float* z = (LAS float*)lds;
    LAS float* ot = (LAS float*)(lds + 62 * 256 * 4);
    bf16_t* proj = (bf16_t*)(p.ws + OFF_PROJ);
    const int ch = tid & 255, half = tid >> 8;
    float w[31];
#pragma unroll
    for (int j = 0; j < 31; ++j) w[j] = p.in[18][(size_t)(l * 31 + j) * 256 + ch];
    const float cb = p.in[19][l * 256 + ch];
    const f32x4 lg = ((const f32x4*)(p.in[20] + l * 256))[lane], lbv = ((const f32x4*)(p.in[21] + l * 256))[lane];
    for (int tile = first; tile < MROWS / 32; tile += stride) {
        const int row0 = tile * 32, b = row0 / SEQL, t0 = row0 % SEQL;
        {
            float zv[31], zg[31];
#pragma unroll
            for (int i = 0; i < 31; ++i) { const int r = half + 2 * i, t = t0 - 15 + r; const bool ok = (t >= 0) && (t < SEQL);
                const bf16_t* pr = proj + ((size_t)b * SEQL + (ok ? t : 0)) * PS; zv[i] = ok ? bf2f(pr[P_CV + ch]) : 0.f; zg[i] = bf2f(pr[P_CG + ch]); }
#pragma unroll
            for (int i = 0; i < 31; ++i) z[(half + 2 * i) * 256 + ch] = zv[i] * sigmoidf_(zg[i]);
        }
        __syncthreads();
#pragma unroll 4
        for (int tt = 0; tt < 16; ++tt) { const int tok = half * 16 + tt; float acc = cb;
#pragma unroll
            for (int j = 0; j < 31; ++j) acc += w[j] * z[(tok + j) * 256 + ch];
            ot[tok * 256 + ch] = acc; }
        __syncthreads();
#pragma unroll
        for (int q = 0; q < 4; ++q) { const int tok = wave * 4 + q;
            f32x4 v = *(const LAS f32x4*)(ot + tok * 256 + lane * 4);
            const float mean = wave_sum((v.x + v.y) + (v.z + v.w)) * (1.f / 256.f);
            v = v - mean;
            const float var = wave_sum((v.x * v.x + v.y * v.y) + (v.z * v.z + v.w * v.w)) * (1.f / 256.f);
            const float rstd = rsqrtf(var + LN_EPS);
            f32x4 y = v * rstd * lg + lbv;
            y.x = y.x * sigmoidf_(y.x); y.y = y.y * sigmoidf_(y.y); y.z = y.z * sigmoidf_(y.z); y.w = y.w * sigmoidf_(y.w);
            u32x2 wv; wv.x = pk2(y.x, y.y); wv.y = pk2(y.z, y.w);
            *(u32x2*)(proj + (size_t)(row0 + tok) * PS + P_YC + lane * 4) = wv; }
        __syncthreads();
    }
}

__device__ __forceinline__ void combine_phase(const Params& p, int l, int widx, int nw, LAS unsigned char* lds) {
    const int tid = opaque_tid(), lane = tid & 63;
    bf16_t* proj = (bf16_t*)(p.ws + OFF_PROJ);
    const bf16_t* o_r = (const bf16_t*)(p.ws + OFF_T);
    LAS unsigned* WA = (LAS unsigned*)lds;
    LAS unsigned* WG = (LAS unsigned*)(lds + 49152);
    {
        const float* aup = p.in[11] + (size_t)(l * 2 * 32) * RW; const float* gup = p.in[12] + (size_t)(l * 64) * RW;
        for (int i = tid; i < 2 * 32 * 3 * 64; i += 512) { const int ln = i & 63, hp = (i >> 6) % 3, dr = i / 192; const float* s = aup + (size_t)dr * RW + (2 * hp) * 64 + ln; WA[i] = pk2(s[0], s[64]); }
        for (int i = tid; i < 64 * 3 * 64; i += 512) { const int ln = i & 63, hp = (i >> 6) % 3, r = i / 192; const float* s = gup + (size_t)r * RW + (2 * hp) * 64 + ln; WG[i] = pk2(s[0], s[64]); }
    }
    __syncthreads();
    const float* mu0 = p.in[7] + (size_t)(l * 2 + 0) * NRW; const float* mu1 = mu0 + NRW;
    const float mad0 = mu0[1216 + lane], mad1 = mu1[1216 + lane], mgd0 = mu0[1280 + lane], mgd1 = mu1[1280 + lane];
    for (int g4 = widx; g4 < MROWS / 2; g4 += nw) {
        const int row0 = g4 * 2;
        float adv[2], sgv[2];
#pragma unroll
        for (int tt = 0; tt < 2; ++tt) { const int row = row0 + tt, t = row % SEQL; const bf16_t* pr = proj + (size_t)row * PS;
            const bool hp = t > 0, hn = t < SEQL - 1; const bf16_t* pp = hp ? pr - PS : pr; const bf16_t* pn = hn ? pr + PS : pr; const float fp = hp ? 1.f : 0.f, fn = hn ? 1.f : 0.f;
            const float ac = bf2f(pr[P_AD + lane]), ap = fp * bf2f(pp[P_AD + lane]), an = fn * bf2f(pn[P_AD + lane]);
            const float gc = bf2f(pr[P_GD + lane]), gp = fp * bf2f(pp[P_GD + lane]), gn = fn * bf2f(pn[P_GD + lane]);
            adv[tt] = ac + mad0 * (ap - ac) + mad1 * (an - ac);
            sgv[tt] = sigmoidf_(gc + mgd0 * (gp - gc) + mgd1 * (gn - gc)); }
        float A0[2][6], A1[2][6], G[2][6];
#pragma unroll
        for (int tt = 0; tt < 2; ++tt)
#pragma unroll
            for (int h = 0; h < 6; ++h) { A0[tt][h] = 0.f; A1[tt][h] = 0.f; G[tt][h] = 0.f; }
#pragma unroll 4
        for (int r = 0; r < 32; ++r) {
            float w0[6], w1[6];
#pragma unroll
            for (int hp = 0; hp < 3; ++hp) { const unsigned u0 = WA[(r * 3 + hp) * 64 + lane], u1 = WA[((32 + r) * 3 + hp) * 64 + lane];
                w0[2 * hp] = __uint_as_float(u0 << 16); w0[2 * hp + 1] = __uint_as_float(u0 & 0xffff0000u); w1[2 * hp] = __uint_as_float(u1 << 16); w1[2 * hp + 1] = __uint_as_float(u1 & 0xffff0000u); }
#pragma unroll
            for (int tt = 0; tt < 2; ++tt) { const float s0 = rdlane(adv[tt], r), s1 = rdlane(adv[tt], 32 + r);
#pragma unroll
                for (int h = 0; h < 6; ++h) { A0[tt][h] += s0 * w0[h]; A1[tt][h] += s1 * w1[h]; } }
        }
#pragma unroll 4
        for (int r = 0; r < 64; ++r) {
            float wg[6];
#pragma unroll
            for (int hp = 0; hp < 3; ++hp) { const unsigned u = WG[(r * 3 + hp) * 64 + lane]; wg[2 * hp] = __uint_as_float(u << 16); wg[2 * hp + 1] = __uint_as_float(u & 0xffff0000u); }
#pragma unroll
            for (int tt = 0; tt < 2; ++tt) { const float s = rdlane(sgv[tt], r);
#pragma unroll
                for (int h = 0; h < 6; ++h) G[tt][h] += s * wg[h]; }
        }
#pragma unroll
        for (int h = 0; h < 6; ++h) {
            const int c = h * 64 + lane;
            const float a00 = p.in[10][(l * 2 + 0) * RW + c], a01 = p.in[10][(l * 2 + 1) * RW + c], kac = p.in[14][l * RW + c];
            const float rk = p.in[15][(l * 6 + h) * 64 + lane], gng = p.in[16][l * RW + c], gnb = p.in[17][l * RW + c], ng = p.in[6][l * RW + c];
            const float mr0 = mu0[c], mr1 = mu1[c], mk0 = mu0[384 + c], mk1 = mu1[384 + c], mv0 = mu0[768 + c], mv1 = mu1[768 + c];
#pragma unroll
            for (int tt = 0; tt < 2; ++tt) { const int row = row0 + tt, t = row % SEQL; bf16_t* pr = proj + (size_t)row * PS;
                const bool hp = t > 0, hn = t < SEQL - 1; const bf16_t* pp = hp ? pr - PS : pr; const bf16_t* pn = hn ? pr + PS : pr; const float fp = hp ? 1.f : 0.f, fn = hn ? 1.f : 0.f;
                const float rc = bf2f(pr[P_R + c]), rp = fp * bf2f(pp[P_R + c]), rn = fn * bf2f(pn[P_R + c]);
                const float kc = bf2f(pr[P_K + c]), kp = fp * bf2f(pp[P_K + c]), kn = fn * bf2f(pn[P_K + c]);
                const float vc = bf2f(pr[P_V + c]), vp = fp * bf2f(pp[P_V + c]), vn = fn * bf2f(pn[P_V + c]);
                const float rs = rc + mr0 * (rp - rc) + mr1 * (rn - rc);
                const float ks = kc + mk0 * (kp - kc) + mk1 * (kn - kc);
                const float vs = vc + mv0 * (vp - vc) + mv1 * (vn - vc);
                const float a0 = sigmoidf_(a00 + A0[tt][h]), a1 = sigmoidf_(a01 + A1[tt][h]);
                const float kh = ks * (1.f + (0.5f * (a0 + a1) - 1.f) * kac);
                const float bsum = wave_sum(rs * kh * rk);
                const float o = bf2f(o_r[(size_t)row * RW + c]) + bf2f(o_r[((size_t)MROWS + row) * RW + c]);
                const float mean = wave_sum(o) * (1.f / 64.f); const float dlt = o - mean;
                const float var = wave_sum(dlt * dlt) * (1.f / 64.f);
                const float on = dlt * rsqrtf(var + GN_EPS) * gng + gnb;
                const float yr = (on + bsum * vs) * G[tt][h];
                const float oh = bf2f(pr[P_FF + c]) + bf2f(pr[P_FB + c]);
                const float ms = wave_sum(oh * oh) * (1.f / 64.f);
                const float gh = bf2f(pr[P_G + c]);
                const float yh = oh * rsqrtf(ms + RMS_EPS) * ng * (gh * sigmoidf_(gh));
                pr[P_I + c] = (bf16_t)f2bf(yr);
                pr[P_Q + c] = (bf16_t)f2bf(yh);
            }
        }
    }
}

__global__ void __launch_bounds__(512, 2) fwd_mega(Params p) {
    extern __shared__ __attribute__((aligned(16))) unsigned char smem_raw[];
    LAS unsigned char* lds = (LAS unsigned char*)smem_raw;
    cg::grid_group grid = cg::this_grid();
    const int tid = threadIdx.x, wave = tid >> 6, lane = tid & 63;
    const int G = gridDim.x, bid = blockIdx.x;
    const int widx = bid * 8 + wave, nw = G * 8;
    bf16_t* win_t = (bf16_t*)(p.ws + OFF_WIN); bf16_t* wout_t = (bf16_t*)(p.ws + OFF_WOUT); bf16_t* wup_t = (bf16_t*)(p.ws + OFF_WUP); bf16_t* wdn_t = (bf16_t*)(p.ws + OFF_WDN);
    bf16_t* proj = (bf16_t*)(p.ws + OFF_PROJ); bf16_t* xb = (bf16_t*)(p.ws + OFF_T); bf16_t* hid = proj;
    float* x = p.out;
    volatile LAS unsigned* xst = (volatile LAS unsigned*)(lds + 131072);
    if (tid == 0) { xst[0] = 0u; xst[1] = 0u; xst[2] = 0u; xst[3] = 0u; }
    __syncthreads();
    XcdBarrier xbar = xcd_barrier_post((unsigned*)(p.ws + OFF_BAR), xst);

    convert_weights(p, 0, lds, widx, nw);
    for (int row = widx; row < MROWS; row += nw) {
        const float* src = row < 16 * SEQL ? p.in[0] + (size_t)row * D : p.in[1] + (size_t)(row - 16 * SEQL) * D;
        ln_row(src, x + (size_t)row * D, xb + (size_t)row * D, p.in[2], p.in[3], lane);
    }
    grid.sync();
    for (int l = 0; l < DEPTH; ++l) {
        {
            pg8::Gemm g{xb, win_t, MROWS, NINP, D, D}; pg8::StaticOrder S; S.init(MROWS, NINP, G, bid);
            pg8::EpiBf16<0> E{proj + 256, PS};
            for (int rep = 0; rep < REP_GIN; ++rep) pg8::gemm_phase(lds, g, S, E);
        }
        GSYNC();
        for (int rep = 0; rep < REP_SCAN; ++rep) {
            if (bid < 144) rwkv_scan_wg(p, l, bid, lds);
            else if (bid < 216) { if (rep == 0) hgrn_scan_wg(p, l, bid - 144, lds); }
            else { }
        }
        GSYNC();
        conv_wg(p, l, bid, G, lds);
        for (int rep = 0; rep < REP_COMB; ++rep) combine_phase(p, l, widx, nw, lds);
        GSYNC();
        {
            pg8::Gemm g{proj, wout_t, MROWS, D, D, PS}; pg8::StaticOrder S; S.init(MROWS, D, G, bid);
            pg8::EpiResid E{x, D, DN_ALPHA};
            pg8::gemm_phase(lds, g, S, E);
        }
        GSYNC();
        for (int row = widx; row < MROWS; row += 2 * nw) {
            const int r1 = row + nw;
            if (r1 < MROWS) ln_row2(x + (size_t)row * D, x + (size_t)r1 * D, x + (size_t)row * D, x + (size_t)r1 * D, xb + (size_t)row * D, xb + (size_t)r1 * D, p.in[23] + l * D, p.in[24] + l * D, lane);
            else ln_row(x + (size_t)row * D, x + (size_t)row * D, xb + (size_t)row * D, p.in[23] + l * D, p.in[24] + l * D, lane); }
        GSYNC();
        for (int third = 0; third < 3; ++third) {
            constexpr int MT = MROWS / 3;
            {   pg8::Gemm g{xb + (size_t)third * MT * D, wup_t, MT, FFN, D, D}; pg8::StaticOrder S; S.init(MT, FFN, G, bid);
                pg8::EpiBf16<1> E{hid, FFN};
                for (int rep = 0; rep < REP_UP; ++rep) pg8::gemm_phase(lds, g, S, E); }
            GSYNC();
            {   pg8::Gemm g{hid, wdn_t, MT, D, FFN, FFN}; pg8::StaticOrder S; S.init(MT, D, G, bid);
                pg8::EpiResid E{x + (size_t)third * MT * D, D, DN_ALPHA};
                pg8::gemm_phase(lds, g, S, E); }
            GSYNC();
        }
        if (l + 1 < DEPTH) convert_weights(p, l + 1, lds, widx, nw);
        for (int row = widx; row < MROWS; row += 2 * nw) {
            const int r1 = row + nw;
            if (r1 < MROWS) ln_row2(x + (size_t)row * D, x + (size_t)r1 * D, x + (size_t)row * D, x + (size_t)r1 * D, xb + (size_t)row * D, xb + (size_t)r1 * D, p.in[27] + l * D, p.in[28] + l * D, lane);
            else ln_row(x + (size_t)row * D, x + (size_t)row * D, xb + (size_t)row * D, p.in[27] + l * D, p.in[28] + l * D, lane); }
        GSYNC();
    }
}

extern "C" void kernel_launch(void* const* d_in, const int* in_sizes, int n_in, void* d_out, int out_size, void* d_ws, size_t ws_size, hipStream_t stream) {
    static int grid = 0;
    if (grid == 0) {
        if (n_in != 29 || out_size != MROWS * D || ws_size < WS_END) { fprintf(stderr, "kernel_launch: unexpected shapes (n_in %d out %d ws %zu need %zu)\n", n_in, out_size, ws_size, (size_t)WS_END); grid = -1; return; }
        int dev = 0, cus = 0, per_cu = 0;
        hipGetDevice(&dev);
        hipDeviceGetAttribute(&cus, hipDeviceAttributeMultiprocessorCount, dev);
        if (hipFuncSetAttribute((const void*)fwd_mega, hipFuncAttributeMaxDynamicSharedMemorySize, LDS_BYTES) != hipSuccess) { fprintf(stderr, "kernel_launch: hipFuncSetAttribute failed\n"); grid = -1; return; }
        hipOccupancyMaxActiveBlocksPerMultiprocessor(&per_cu, (const void*)fwd_mega, 512, LDS_BYTES);
        (void)hipGetLastError();
        if (per_cu < 1) per_cu = 1;
        grid = cus;
        if (grid != 256) fprintf(stderr, "kernel_launch: note: %d CUs\n", grid);
    }
    if (grid < 0) return;
    if (hipMemsetAsync((char*)d_ws + OFF_BAR, 0, SZ_BAR, stream) != hipSuccess) { fprintf(stderr, "kernel_launch: memset failed\n"); return; }
    Params p{};
    for (int i = 0; i < 29; ++i) p.in[i] = (const float*)d_in[i];
    p.out = (float*)d_out; p.ws = (unsigned char*)d_ws;
    void* args[] = {&p};
    hipError_t e = hipLaunchCooperativeKernel((const void*)fwd_mega, dim3(grid), dim3(512), args, LDS_BYTES, stream);
    if (e != hipSuccess) fprintf(stderr, "cooperative launch failed: %s (grid %d)\n", hipGetErrorString(e), grid);
}
```

```cpp
#include <hip/hip_runtime.h>
#include <hip/hip_cooperative_groups.h>
#include <cstdio>
#include <cstdint>
namespace cg = cooperative_groups;

#define LAS __attribute__((address_space(3)))
typedef unsigned short bf16_t;
typedef short bf16x8 __attribute__((ext_vector_type(8)));
typedef float f32x4 __attribute__((ext_vector_type(4)));
typedef unsigned u32x4 __attribute__((ext_vector_type(4)));
typedef unsigned u32x2 __attribute__((ext_vector_type(2)));

constexpr int D = 1024, SEQL = 2048, NSEQ = 24, MROWS = NSEQ * SEQL, DEPTH = 4, FFN = 4096;
constexpr int NIN = 3776, NINP = 3840, PS = 4096;
constexpr int RW = 384, NRW = 1344;
constexpr int P_YC = 0, P_Q = 256, P_I = 640, P_FF = 1024, P_FB = 1408, P_G = 1792;
constexpr int P_RW = 2176, P_R = P_RW, P_K = P_RW + 384, P_V = P_RW + 768, P_WD = P_RW + 1152, P_AD = P_RW + 1216, P_GD = P_RW + 1280;
constexpr int P_CV = 3520, P_CG = 3776;
constexpr float LN_EPS = 1e-5f, RMS_EPS = 1e-6f, GN_EPS = 64e-5f;
constexpr float DN_ALPHA = 1.681792830507429f;

constexpr size_t OFF_WIN = 0, SZ_WIN = (size_t)NINP * D * 2;
constexpr size_t OFF_WOUT = OFF_WIN + SZ_WIN, SZ_WOUT = (size_t)D * D * 2;
constexpr size_t OFF_WUP = OFF_WOUT + SZ_WOUT, SZ_WUP = (size_t)FFN * D * 2;
constexpr size_t OFF_WDN = OFF_WUP + SZ_WUP, SZ_WDN = (size_t)FFN * D * 2;
constexpr size_t OFF_PROJ = OFF_WDN + SZ_WDN, SZ_PROJ = (size_t)MROWS * PS * 2;
constexpr size_t OFF_T = OFF_PROJ + SZ_PROJ, SZ_T = (size_t)MROWS * D * 2;
constexpr size_t OFF_BAR = OFF_T + SZ_T, SZ_BAR = 3456 * 4;
constexpr size_t WS_END = OFF_BAR + SZ_BAR;
constexpr int LDS_BYTES = 131072 + 16;
#define REP_SCAN 1
#define REP_COMB 1
#define REP_GIN 1
#define REP_UP 1
#define REP_SYNC 1
#define GSYNC() do { for (int r_ = 0; r_ < REP_SYNC; ++r_) xcd_barrier(xbar); } while (0)

struct Params {
    const float* in[29];
    float* out;
    unsigned char* ws;
};

__device__ __forceinline__ float bf2f(bf16_t b) { return __uint_as_float(((unsigned)b) << 16); }
__device__ __forceinline__ unsigned f2bf(float f) { unsigned u = __float_as_uint(f); u += 0x7FFFu + ((u >> 16) & 1u); return u >> 16; }
__device__ __forceinline__ unsigned pk2(float lo, float hi) { return f2bf(lo) | (f2bf(hi) << 16); }
__device__ __forceinline__ float dpp_add(float v, const int ctrl_sel) {
    int r;
    switch (ctrl_sel) {
        case 0: r = __builtin_amdgcn_update_dpp(0, __float_as_int(v), 0xB1, 0xF, 0xF, true); break;
        case 1: r = __builtin_amdgcn_update_dpp(0, __float_as_int(v), 0x4E, 0xF, 0xF, true); break;
        case 2: r = __builtin_amdgcn_update_dpp(0, __float_as_int(v), 0x141, 0xF, 0xF, true); break;
        default: r = __builtin_amdgcn_update_dpp(0, __float_as_int(v), 0x140, 0xF, 0xF, true); break;
    }
    return v + __int_as_float(r);
}
__device__ __forceinline__ float wave_sum(float v) {
    v = dpp_add(v, 0); v = dpp_add(v, 1); v = dpp_add(v, 2); v = dpp_add(v, 3);
    { auto r = __builtin_amdgcn_permlane16_swap(__float_as_uint(v), __float_as_uint(v), false, false); v = __uint_as_float(r[0]) + __uint_as_float(r[1]); }
    { auto r = __builtin_amdgcn_permlane32_swap(__float_as_uint(v), __float_as_uint(v), false, false); v = __uint_as_float(r[0]) + __uint_as_float(r[1]); }
    return v;
}
__device__ __forceinline__ int opaque_tid() { int t = threadIdx.x; asm volatile("" : "+v"(t)); return t; }
__device__ __forceinline__ float sigmoidf_(float x) { return 1.0f / (1.0f + __expf(-x)); }
__device__ __forceinline__ float rdlane(float v, int l) { return __int_as_float(__builtin_amdgcn_readlane(__float_as_int(v), l)); }

#define XB_TMO      128
#define XB_XCNT(j)  (256  + 64 * (j))
#define XB_XSUB(j)  (1280 + 64 * (j))
#define XB_XGEN(j)  (2304 + 64 * (j))
#define XB_TOP      3328
#define XB_TOPGEN   3392
#define XCD_BAR_WORDS 3456
#define XB_SPIN_CAP (1u << 22)
__device__ __forceinline__ unsigned xb_ld(unsigned* p)              { return __hip_atomic_load(p, __ATOMIC_RELAXED, __HIP_MEMORY_SCOPE_AGENT); }
__device__ __forceinline__ unsigned xb_add(unsigned* p, unsigned v) { return __hip_atomic_fetch_add(p, v, __ATOMIC_RELAXED, __HIP_MEMORY_SCOPE_AGENT); }
__device__ __forceinline__ unsigned xb_xcc_id() { return (unsigned)__builtin_amdgcn_s_getreg((3 << 11) | 20) & 0xFu; }
#define XB_SPIN(cond, bar) do { unsigned _sp = 0; while (cond) { __builtin_amdgcn_s_sleep(1); \
    if ((++_sp & 255u) == 0u) { if (xb_ld(&(bar)[XB_TMO])) break; if (_sp > XB_SPIN_CAP) { atomicAdd(&(bar)[XB_TMO], 1u); break; } } } } while (0)
struct XcdBarrier { unsigned* bar; unsigned x; volatile LAS unsigned* st; };
__device__ __forceinline__ XcdBarrier xcd_barrier_post(unsigned* bar, volatile LAS unsigned* st) {
    XcdBarrier b; b.bar = bar; b.x = xb_xcc_id(); b.st = st;
    if (threadIdx.x == 0) (void)xb_add(&bar[XB_XCNT(b.x)], 1u);
    return b;
}
__device__ __forceinline__ void xcd_barrier_complete(unsigned* bar, unsigned x, unsigned& nloc, unsigned& nx) {
    const unsigned G = gridDim.x * gridDim.y * gridDim.z;
    unsigned sum, cnt, mine, sp = 0u;
    for (;;) {
        sum = 0u; cnt = 0u; mine = 0u;
#pragma unroll
        for (unsigned j = 0; j < 16; ++j) { const unsigned c = xb_ld(&bar[XB_XCNT(j)]); sum += c; cnt += (c > 0u) ? 1u : 0u; mine = (j == x) ? c : mine; }
        if (sum == G) break;
        __builtin_amdgcn_s_sleep(1);
        if ((++sp & 255u) == 0u) { if (xb_ld(&bar[XB_TMO])) break; if (sp > XB_SPIN_CAP) { atomicAdd(&bar[XB_TMO], 1u); break; } }
    }
    nloc = mine > 0u ? mine : 1u; nx = cnt > 0u ? cnt : 1u;
}
__device__ __forceinline__ void xcd_barrier(const XcdBarrier& b) {
    asm volatile("s_waitcnt vmcnt(0)" ::: "memory");
    __syncthreads();
    if (threadIdx.x == 0) {
        unsigned* bar = b.bar;
        __builtin_amdgcn_s_waitcnt(0);
        unsigned nloc = b.st[0], nx = b.st[1];
        if (nloc == 0u) { xcd_barrier_complete(bar, b.x, nloc, nx); b.st[0] = nloc; b.st[1] = nx; }
        const unsigned old = xb_add(&bar[XB_XSUB(b.x)], 1u);
        const unsigned gen = old / nloc;
        if (old + 1u == (gen + 1u) * nloc) {
            __builtin_amdgcn_fence(__ATOMIC_RELEASE, "agent");
            asm volatile("s_waitcnt vmcnt(0)" ::: "memory");
            const unsigned og = xb_add(&bar[XB_TOP], 1u);
            const unsigned tg = og / nx;
            if (og + 1u == (tg + 1u) * nx) xb_add(&bar[XB_TOPGEN], 1u);
            else XB_SPIN(xb_ld(&bar[XB_TOPGEN]) == tg, bar);
            __builtin_amdgcn_fence(__ATOMIC_ACQUIRE, "agent");
            xb_add(&bar[XB_XGEN(b.x)], 1u);
            asm volatile("s_waitcnt vmcnt(0)" ::: "memory");
        } else {
            XB_SPIN(xb_ld(&bar[XB_XGEN(b.x)]) == gen, bar);
            __builtin_amdgcn_fence(__ATOMIC_ACQUIRE, "agent");
            asm volatile("s_waitcnt vmcnt(0)" ::: "memory");
        }
    }
    __syncthreads();
}

namespace pg8 {
constexpr int BM = 256, BK = 64, HALF = 128, HTB = HALF * BK * 2, STAGE_BYTES = 8 * HTB, NXCD = 8, WGM = 8;
__device__ __forceinline__ int lds_byte(int r, int c) { const int st = (r >> 4) * 2 + (c >> 5), rr = r & 15, cc = c & 31, ob = rr * 64 + cc * 2; return st * 1024 + (ob ^ (((ob >> 9) & 1) << 5)); }
__device__ __forceinline__ void stage_rc(int b, int& R, int& C) { const int st = b / 1024, sb = b % 1024, swz = sb ^ (((sb >> 9) & 1) << 5); R = (st >> 1) * 16 + swz / 64; C = (st & 1) * 32 + (swz % 64) / 2; }
__device__ __forceinline__ int perm32(int rho) { const int n = rho >> 4, i = rho & 15; return 8 * (i >> 2) + 4 * n + (i & 3); }
struct Unit { int pm, pn; };
struct Gemm { const bf16_t* A; const bf16_t* Bt; int M, N, K, lda; };
struct StaticOrder {
    int nM, nN, nwg, G, c;
    __device__ void init(int M, int N, int G_, int c_) { nM = M / BM; nN = N / BM; nwg = nM * nN; G = G_; c = c_; }
    __device__ bool next(int i, Unit& u) const {
        const long L = (long)i * G + c; if (L >= nwg) return false;
        int wgid = (int)L; { const int q = nwg / NXCD, r = nwg % NXCD, xcd = wgid % NXCD, off = wgid / NXCD; wgid = (xcd < r ? xcd * (q + 1) : r * (q + 1) + (xcd - r) * q) + off; }
        const int nig = WGM * nN, gid = wgid / nig, fm = gid * WGM, gsz = (nM - fm) < WGM ? (nM - fm) : WGM;
        u.pm = fm + ((wgid % nig) % gsz); u.pn = (wgid % nig) / gsz; return true;
    }
};
__device__ __forceinline__ unsigned cvt_pk_bf16(float lo, float hi) { unsigned r; asm volatile("v_cvt_pk_bf16_f32 %0, %1, %2" : "=v"(r) : "v"(lo), "v"(hi)); return r; }

template <int ACT  > struct EpiBf16 {
    static constexpr bool PERM = true;
    bf16_t* O; int ldc;
    __device__ __forceinline__ void operator()(const f32x4 (&acc)[2][2][4][2], const Unit& u, int wr, int wc, int fr, int fq) const {
        const int row0 = u.pm * BM + wr * 64 + fr; const int col0 = u.pn * BM + wc * 32 + 8 * fq;
#pragma unroll
        for (int ai = 0; ai < 2; ++ai)
#pragma unroll
            for (int m = 0; m < 4; ++m) { bf16_t* rowp = O + (size_t)(row0 + ai * HALF + m * 16) * ldc + col0;
#pragma unroll
                for (int bj = 0; bj < 2; ++bj) { f32x4 v0 = acc[ai][bj][m][0], v1 = acc[ai][bj][m][1];
                    if (ACT == 1) {
#pragma unroll
                        for (int j = 0; j < 4; ++j) { float a = fmaxf(v0[j], 0.f), b = fmaxf(v1[j], 0.f); v0[j] = a * a; v1[j] = b * b; } }
                    u32x4 w; w.x = cvt_pk_bf16(v0[0], v0[1]); w.y = cvt_pk_bf16(v0[2], v0[3]); w.z = cvt_pk_bf16(v1[0], v1[1]); w.w = cvt_pk_bf16(v1[2], v1[3]);
                    *(u32x4*)(rowp + bj * HALF) = w; } }
    }
};
struct EpiResid {
    static constexpr bool PERM = false;
    float* C; int ldc; float alpha;
    __device__ __forceinline__ void operator()(const f32x4 (&acc)[2][2][4][2], const Unit& u, int wr, int wc, int fr, int fq) const {
        const int row0 = u.pm * BM + wr * 64 + fr, col0 = u.pn * BM + wc * 32 + 4 * fq;
#pragma unroll
        for (int ai = 0; ai < 2; ++ai)
#pragma unroll
            for (int m = 0; m < 4; ++m) { float* rowp = C + (size_t)(row0 + ai * HALF + m * 16) * ldc + col0;
                f32x4 old[2][2];
#pragma unroll
                for (int bj = 0; bj < 2; ++bj)
#pragma unroll
                    for (int n = 0; n < 2; ++n) old[bj][n] = *(const f32x4*)(rowp + bj * HALF + n * 16);
#pragma unroll
                for (int bj = 0; bj < 2; ++bj)
#pragma unroll
                    for (int n = 0; n < 2; ++n) *(f32x4*)(rowp + bj * HALF + n * 16) = old[bj][n] * alpha + acc[ai][bj][m][n]; }
    }
};

template <class Epi, class Sched>
__device__ __forceinline__ void gemm_phase(LAS unsigned char* lds, const Gemm g, const Sched& S, const Epi& E) {
    const int tid = opaque_tid(), wid = __builtin_amdgcn_readfirstlane(tid >> 6), lane = tid & 63, wr = wid >> 2, wc = wid & 3, fr = lane & 15, fq = lane >> 4;
    const int K = g.K, nt = K / BK, lda = g.lda;
    unsigned voffA[2], voffB[2];
#pragma unroll
    for (int i = 0; i < 2; ++i) { int R, C; stage_rc(tid * 16 + i * 8192, R, C); const int Rb = Epi::PERM ? ((R & ~31) + perm32(R & 31)) : R;
        voffA[i] = (unsigned)(R * lda + C) * 2u; voffB[i] = (unsigned)(Rb * K + C) * 2u; }
    const size_t kstep = (size_t)(BK * 2);
    const size_t hstepA = (size_t)HALF * lda * 2, hstepB = (size_t)HALF * K * 2;
    const size_t tstepA = 2 * hstepA, tstepB = 2 * hstepB;
    const unsigned ldsw = (unsigned)wid * 1024u;
    const int aoff = lds_byte(wr * 64 + fr, fq * 8), boff = lds_byte(wc * 32 + fr, fq * 8);
#define PG8_SA(b, h) (((b) * 2 + (h)) * HTB)
#define PG8_SB(b, h) ((4 + (b) * 2 + (h)) * HTB)
#define PG8_STAGE(bufoff, gbase, voff) do { _Pragma("unroll") for (int _i = 0; _i < 2; ++_i) \
        __builtin_amdgcn_global_load_lds((const unsigned*)((const char*)(gbase) + (voff)[_i]), (LAS unsigned*)(lds + (bufoff) + ldsw + _i * 8192), 16, 0, 0); } while (0)
#define PG8_LDA(dst, b, h) do { _Pragma("unroll") for (int m = 0; m < 4; ++m) _Pragma("unroll") for (int k = 0; k < 2; ++k) dst[m][k] = *(const LAS bf16x8*)(lds + PG8_SA(b, h) + aoff + m * 2048 + k * 1024); } while (0)
#define PG8_LDB(dst, b, h) do { _Pragma("unroll") for (int n = 0; n < 2; ++n) _Pragma("unroll") for (int k = 0; k < 2; ++k) dst[n][k] = *(const LAS bf16x8*)(lds + PG8_SB(b, h) + boff + n * 2048 + k * 1024); } while (0)
#define PG8_MMA(ai, bj, At, Bt) do { __builtin_amdgcn_s_setprio(1); _Pragma("unroll") for (int m = 0; m < 4; ++m) _Pragma("unroll") for (int n = 0; n < 2; ++n) _Pragma("unroll") for (int k = 0; k < 2; ++k) \
        acc[ai][bj][m][n] = __builtin_amdgcn_mfma_f32_16x16x32_bf16(Bt[n][k], At[m][k], acc[ai][bj][m][n], 0, 0, 0); __builtin_amdgcn_s_setprio(0); } while (0)
#define PG8_WAIT_V(n) asm volatile("s_waitcnt vmcnt(" #n ")" ::: "memory")
#define PG8_WAIT_L(n) asm volatile("s_waitcnt lgkmcnt(" #n ")" ::: "memory")
#define PG8_BAR __builtin_amdgcn_s_barrier()
#define PG8_SCHED __builtin_amdgcn_sched_barrier(0)
    Unit cur, nxt; int ui = 0;
    if (!S.next(0, cur)) return;
    f32x4 acc[2][2][4][2];
#pragma unroll
    for (int a = 0; a < 2; ++a)
#pragma unroll
        for (int b = 0; b < 2; ++b)
#pragma unroll
            for (int m = 0; m < 4; ++m)
#pragma unroll
                for (int n = 0; n < 2; ++n) acc[a][b][m][n] = (f32x4){0.f, 0.f, 0.f, 0.f};
    bf16x8 At[4][2], B0[2][2], B1[2][2];
    const char* cA = (const char*)g.A + (size_t)cur.pm * tstepA; const char* cB = (const char*)g.Bt + (size_t)cur.pn * tstepB;
    PG8_STAGE(PG8_SB(0, 0), cB, voffB); PG8_STAGE(PG8_SB(0, 1), cB + hstepB, voffB); PG8_STAGE(PG8_SA(0, 0), cA, voffA); PG8_STAGE(PG8_SA(0, 1), cA + hstepA, voffA);
    if (wr == 1) PG8_BAR;
    PG8_WAIT_V(2); PG8_BAR;
    PG8_STAGE(PG8_SB(1, 0), cB + kstep, voffB); PG8_STAGE(PG8_SA(1, 0), cA + kstep, voffA); PG8_STAGE(PG8_SB(1, 1), cB + hstepB + kstep, voffB);
    PG8_WAIT_V(6); PG8_BAR;
    for (;;) {
        const bool has_next = S.next(ui + 1, nxt);
        const char* nA = has_next ? (const char*)g.A + (size_t)nxt.pm * tstepA : cA; const char* nB = has_next ? (const char*)g.Bt + (size_t)nxt.pn * tstepB : cB;
        for (int t = 0; t < nt; t += 2) {
            const bool last = (t == nt - 2);
            const char* a1 = cA + (size_t)(t + 1) * kstep;
            const char* a2 = last ? nA : cA + (size_t)(t + 2) * kstep; const char* b2 = last ? nB : cB + (size_t)(t + 2) * kstep;
            const char* a3 = a2 + kstep; const char* b3 = b2 + kstep;
            PG8_LDB(B0, 0, 0); PG8_LDB(B1, 0, 1); PG8_SCHED; PG8_LDA(At, 0, 0); PG8_STAGE(PG8_SA(1, 1), a1 + hstepA, voffA);
            PG8_WAIT_V(8); PG8_WAIT_L(0); PG8_BAR; PG8_MMA(0, 0, At, B0); PG8_MMA(0, 1, At, B1); PG8_BAR; PG8_SCHED;
            PG8_LDA(At, 0, 1); PG8_STAGE(PG8_SB(0, 0), b2, voffB); PG8_STAGE(PG8_SB(0, 1), b2 + hstepB, voffB); PG8_STAGE(PG8_SA(0, 0), a2, voffA);
            PG8_WAIT_V(8); PG8_WAIT_L(0); PG8_BAR; PG8_MMA(1, 0, At, B0); PG8_MMA(1, 1, At, B1); PG8_BAR; PG8_SCHED;
            PG8_LDB(B0, 1, 0); PG8_LDB(B1, 1, 1); PG8_SCHED; PG8_LDA(At, 1, 0); PG8_STAGE(PG8_SA(0, 1), a2 + hstepA, voffA);
            PG8_WAIT_V(8); PG8_WAIT_L(0); PG8_BAR; PG8_MMA(0, 0, At, B0); PG8_MMA(0, 1, At, B1); PG8_BAR; PG8_SCHED;
            PG8_LDA(At, 1, 1); PG8_STAGE(PG8_SB(1, 0), b3, voffB); PG8_STAGE(PG8_SB(1, 1), b3 + hstepB, voffB); PG8_STAGE(PG8_SA(1, 0), a3, voffA);
            PG8_WAIT_V(8); PG8_WAIT_L(0); PG8_BAR; PG8_MMA(1, 0, At, B0); PG8_MMA(1, 1, At, B1); PG8_BAR; PG8_SCHED;
        }
        if (wr == 0) PG8_BAR;
        E(acc, cur, wr, wc, fr, fq);
        if (!has_next) break;
#pragma unroll
        for (int a = 0; a < 2; ++a)
#pragma unroll
            for (int b = 0; b < 2; ++b)
#pragma unroll
                for (int m = 0; m < 4; ++m)
#pragma unroll
                    for (int n = 0; n < 2; ++n) acc[a][b][m][n] = (f32x4){0.f, 0.f, 0.f, 0.f};
        cur = nxt; cA = nA; cB = nB; ++ui;
        if (wr == 1) PG8_BAR;
    }
    PG8_WAIT_V(0);
    PG8_BAR;
#undef PG8_SA
#undef PG8_SB
#undef PG8_STAGE
#undef PG8_LDA
#undef PG8_LDB
#undef PG8_MMA
#undef PG8_WAIT_V
#undef PG8_WAIT_L
#undef PG8_BAR
#undef PG8_SCHED
}
}

__device__ __forceinline__ void transpose_item(const float* W, int Nsrc, int ksrc0, int nsrc0, bf16_t* WT, int K, int k0, int n0, LAS float* scr, int lane) {
#pragma unroll 8
    for (int i = 0; i < 32; ++i) { const int kk = 2 * i + (lane >> 5);
        scr[kk * 33 + (lane & 31)] = nsrc0 >= 0 ? W[(size_t)(ksrc0 + kk) * Nsrc + nsrc0 + (lane & 31)] : 0.f; }
    asm volatile("s_waitcnt lgkmcnt(0)" ::: "memory");
    const int c = lane & 7;
#pragma unroll
    for (int j = 0; j < 4; ++j) { const int n = (lane >> 3) + 8 * j; const LAS float* s = scr + (8 * c) * 33 + n;
        u32x4 o; o.x = pk2(s[0 * 33], s[1 * 33]); o.y = pk2(s[2 * 33], s[3 * 33]); o.z = pk2(s[4 * 33], s[5 * 33]); o.w = pk2(s[6 * 33], s[7 * 33]);
        *(u32x4*)(WT + (size_t)(n0 + n) * K + k0 + 8 * c) = o; }
    asm volatile("s_waitcnt lgkmcnt(0)" ::: "memory");
}
__device__ __forceinline__ int win_colmap(int n0) {
    if (n0 < 384) return n0;
    if (n0 < 768) return 1152 + (n0 - 384);
    if (n0 < 1152) return 384 + (n0 - 768);
    if (n0 < 1536) return 768 + (n0 - 1152);
    if (n0 < NIN) return n0;
    return -1;
}
__device__ __forceinline__ void convert_weights(const Params& p, int l, LAS unsigned char* lds, int widx, int nw) {
    const int tid_ = opaque_tid(); const int wave = tid_ >> 6, lane = tid_ & 63;
    LAS float* scr = (LAS float*)(lds + wave * 8448);
    bf16_t* win_t = (bf16_t*)(p.ws + OFF_WIN); bf16_t* wout_t = (bf16_t*)(p.ws + OFF_WOUT); bf16_t* wup_t = (bf16_t*)(p.ws + OFF_WUP); bf16_t* wdn_t = (bf16_t*)(p.ws + OFF_WDN);
    const float* w_in = p.in[5] + (size_t)l * D * NIN; const float* w_out = p.in[22] + (size_t)l * D * D;
    const float* w_up = p.in[25] + (size_t)l * D * FFN; const float* w_dn = p.in[26] + (size_t)l * FFN * D;
    constexpr int I_IN = (D / 64) * (NINP / 32), I_OUT = (D / 64) * (D / 32), I_UP = (D / 64) * (FFN / 32), I_DN = (FFN / 64) * (D / 32);
    for (int it = widx; it < I_IN + I_OUT + I_UP + I_DN; it += nw) {
        int r = it;
        if (r < I_IN) { const int nb = NINP / 32, kb = r / nb, n0 = (r % nb) * 32; transpose_item(w_in, NIN, kb * 64, win_colmap(n0), win_t, D, kb * 64, n0, scr, lane); continue; } r -= I_IN;
        if (r < I_OUT) { const int nb = D / 32, kb = r / nb, n0 = (r % nb) * 32, k0 = kb * 64; const int ks = k0 < 256 ? 768 + k0 : k0 - 256;
            transpose_item(w_out, D, ks, n0, wout_t, D, k0, n0, scr, lane); continue; } r -= I_OUT;
        if (r < I_UP) { const int nb = FFN / 32, kb = r / nb, n0 = (r % nb) * 32; transpose_item(w_up, FFN, kb * 64, n0, wup_t, D, kb * 64, n0, scr, lane); continue; } r -= I_UP;
        { const int nb = D / 32, kb = r / nb, n0 = (r % nb) * 32; transpose_item(w_dn, D, kb * 64, n0, wdn_t, FFN, kb * 64, n0, scr, lane); }
    }
}

__device__ __forceinline__ void ln_row(const float* src, float* dst32, bf16_t* dstb, const float* g, const float* b, int lane_) {
    int lane = lane_; asm volatile("" : "+v"(lane));
    const f32x4* xr = (const f32x4*)src + lane;
    f32x4 v[4]; float s = 0.f;
#pragma unroll
    for (int j = 0; j < 4; ++j) { v[j] = xr[64 * j]; s += (v[j].x + v[j].y) + (v[j].z + v[j].w); }
    const float mean = wave_sum(s) * (1.f / D); float s2 = 0.f;
#pragma unroll
    for (int j = 0; j < 4; ++j) { v[j] = v[j] - mean; s2 += (v[j].x * v[j].x + v[j].y * v[j].y) + (v[j].z * v[j].z + v[j].w * v[j].w); }
    const float rstd = rsqrtf(wave_sum(s2) * (1.f / D) + LN_EPS);
#pragma unroll
    for (int j = 0; j < 4; ++j) {
        const f32x4 gg = ((const f32x4*)g)[lane + 64 * j], bb = ((const f32x4*)b)[lane + 64 * j];
        f32x4 o = v[j] * rstd * gg + bb;
        ((f32x4*)dst32)[lane + 64 * j] = o;
        u32x2 w; w.x = pk2(o.x, o.y); w.y = pk2(o.z, o.w);
        ((u32x2*)dstb)[lane + 64 * j] = w;
    }
}

__device__ __forceinline__ void ln_row2(const float* src0, const float* src1, float* d0, float* d1, bf16_t* b0, bf16_t* b1, const float* g, const float* b, int lane_) {
    int lane = lane_; asm volatile("" : "+v"(lane));
    const f32x4* x0 = (const f32x4*)src0 + lane; const f32x4* x1 = (const f32x4*)src1 + lane;
    f32x4 v[4], u[4]; float s = 0.f, t = 0.f;
#pragma unroll
    for (int j = 0; j < 4; ++j) { v[j] = x0[64 * j]; u[j] = x1[64 * j]; }
#pragma unroll
    for (int j = 0; j < 4; ++j) { s += (v[j].x + v[j].y) + (v[j].z + v[j].w); t += (u[j].x + u[j].y) + (u[j].z + u[j].w); }
    const float m0 = wave_sum(s) * (1.f / D), m1 = wave_sum(t) * (1.f / D); float s2 = 0.f, t2 = 0.f;
#pragma unroll
    for (int j = 0; j < 4; ++j) { v[j] = v[j] - m0; u[j] = u[j] - m1; s2 += (v[j].x * v[j].x + v[j].y * v[j].y) + (v[j].z * v[j].z + v[j].w * v[j].w); t2 += (u[j].x * u[j].x + u[j].y * u[j].y) + (u[j].z * u[j].z + u[j].w * u[j].w); }
    const float r0 = rsqrtf(wave_sum(s2) * (1.f / D) + LN_EPS), r1 = rsqrtf(wave_sum(t2) * (1.f / D) + LN_EPS);
#pragma unroll
    for (int j = 0; j < 4; ++j) {
        const f32x4 gg = ((const f32x4*)g)[lane + 64 * j], bb = ((const f32x4*)b)[lane + 64 * j];
        const f32x4 o0 = v[j] * r0 * gg + bb, o1 = u[j] * r1 * gg + bb;
        ((f32x4*)d0)[lane + 64 * j] = o0; ((f32x4*)d1)[lane + 64 * j] = o1;
        u32x2 w0, w1; w0.x = pk2(o0.x, o0.y); w0.y = pk2(o0.z, o0.w); w1.x = pk2(o1.x, o1.y); w1.y = pk2(o1.z, o1.w);
        ((u32x2*)b0)[lane + 64 * j] = w0; ((u32x2*)b1)[lane + 64 * j] = w1;
    }
}

#define DSR128(dst, addr, off) asm volatile("ds_read_b128 %0, %1 offset:%2" : "=v"(dst) : "v"(addr), "n"(off))
#define DSR32(dst, addr, off) asm volatile("ds_read_b32 %0, %1 offset:%2" : "=v"(dst) : "v"(addr), "n"(off))
#define LGKM0() do { asm volatile("s_waitcnt lgkmcnt(0)" ::: "memory"); __builtin_amdgcn_sched_barrier(0); } while (0)
#define SCHEDB __builtin_amdgcn_sched_barrier(0)
#define WAVE_FENCE() do { __builtin_amdgcn_fence(__ATOMIC_RELEASE, "wavefront"); __builtin_amdgcn_wave_barrier(); __builtin_amdgcn_fence(__ATOMIC_ACQUIRE, "wavefront"); } while (0)
__device__ __forceinline__ float xsum32(float x) { auto r = __builtin_amdgcn_permlane32_swap(__float_as_uint(x), __float_as_uint(x), false, false); return __uint_as_float(r[0]) + __uint_as_float(r[1]); }
__device__ __forceinline__ float xsum16(float x) { auto r = __builtin_amdgcn_permlane16_swap(__float_as_uint(x), __float_as_uint(x), false, false); return __uint_as_float(r[0]) + __uint_as_float(r[1]); }

constexpr int RTC = 32;
#define RW_ISSUE(BUF, bk, bv, vvn) do { \
    DSR128(BUF[0], bk, 0); DSR128(BUF[1], bk, 16); DSR128(BUF[2], bk, 32); DSR128(BUF[3], bk, 48); \
    DSR128(BUF[4], bk, 256); DSR128(BUF[5], bk, 272); DSR128(BUF[6], bk, 288); DSR128(BUF[7], bk, 304); \
    DSR128(BUF[8], bk, 512); DSR128(BUF[9], bk, 528); DSR128(BUF[10], bk, 544); DSR128(BUF[11], bk, 560); \
    DSR128(BUF[12], bk, 768); DSR128(BUF[13], bk, 784); DSR128(BUF[14], bk, 800); DSR128(BUF[15], bk, 816); \
    DSR32(vvn, bv, 1024); } while (0)
#define RW_COMPUTE(BUF) do { \
    f32x4 sacc = S4[0] * BUF[0] + S4[1] * BUF[1]; sacc += S4[2] * BUF[2] + S4[3] * BUF[3]; \
    const float sa = xsum16(xsum32((sacc.x + sacc.y) + (sacc.z + sacc.w))); \
    f32x4 oacc = (f32x4){0.f, 0.f, 0.f, 0.f}; \
    _Pragma("unroll") for (int i_ = 0; i_ < 4; ++i_) { f32x4 sv = S4[i_] + (sa * BUF[4 + i_] + vv * BUF[8 + i_]); S4[i_] = sv; oacc += sv * BUF[12 + i_]; } \
    oval = xsum16(xsum32((oacc.x + oacc.y) + (oacc.z + oacc.w))); } while (0)

__device__ __forceinline__ void rwkv_scan_wg(const Params& p, int l, int pairIdx, LAS unsigned char* lds) {
    const int tid = opaque_tid(), wave = tid >> 6, lane = tid & 63;
    const int b = pairIdx / 6, h = pairIdx % 6;
    LAS float* ring = (LAS float*)lds;
    LAS float* lam = (LAS float*)(lds + 81920);
    const int dir = wave >> 2, rq = wave & 3;
    const int c = h * 64 + lane;
    const bf16_t* proj = (const bf16_t*)(p.ws + OFF_PROJ);
    bf16_t* o_r = (bf16_t*)(p.ws + OFF_T);
    constexpr int NCH = SEQL / RTC;
    const int kp = lane >> 4, row = lane & 15, v0 = rq * 16 + row;
    f32x4 S4[4];
#pragma unroll
    for (int k = 0; k < 4; ++k) S4[k] = (f32x4){0.f, 0.f, 0.f, 0.f};
    f32x4 A[16], B[16]; float vv = 0.f, vvn = 0.f, oval = 0.f;
    const unsigned ring_addr = (unsigned)(unsigned long long)ring + (unsigned)(dir * RTC * 1280);
    const unsigned lam_addr = (unsigned)(unsigned long long)lam + (unsigned)(dir * 4 * 256) + kp * 64;
    const unsigned offk = ring_addr + kp * 64, offv = ring_addr + v0 * 4;
    bf16_t* orow = o_r + ((size_t)dir * MROWS + (size_t)b * SEQL) * RW + h * 64 + v0;
    const float w0c = p.in[8][(l * 2 + dir) * RW + c], a0c = p.in[10][(l * 2 + dir) * RW + c];
    const float kkc = p.in[13][l * RW + c], kac = p.in[14][l * RW + c];
    const float* mu0 = p.in[7] + (size_t)(l * 2 + 0) * NRW; const float* mu1 = mu0 + NRW;
    const float mr0 = mu0[c], mr1 = mu1[c], mk0 = mu0[384 + c], mk1 = mu1[384 + c], mv0 = mu0[768 + c], mv1 = mu1[768 + c];
    const int lcol = lane < 32 ? 1152 + dir * 32 + lane : 1216 + dir * 32 + (lane - 32);
    const float ml0 = mu0[lcol], ml1 = mu1[lcol];
    bf16x8 Bw[4], Ba[4];
    {   const float* wu = p.in[9] + (size_t)((l * 2 + dir) * 32) * RW + h * 64 + (lane & 15); const float* au = p.in[11] + (size_t)((l * 2 + dir) * 32) * RW + h * 64 + (lane & 15);
#pragma unroll
        for (int ct = 0; ct < 4; ++ct)
#pragma unroll
            for (int jj = 0; jj < 8; ++jj) { const int r = (lane >> 4) * 8 + jj;
                Bw[ct][jj] = (short)f2bf(wu[(size_t)r * RW + ct * 16]); Ba[ct][jj] = (short)f2bf(au[(size_t)r * RW + ct * 16]); } }
#define RW_PREFETCH(CH) do { const int s0_ = (CH) * RTC + rq * 8; const int tlo_ = dir ? SEQL - 8 - s0_ : s0_; \
    _Pragma("unroll") for (int q = 0; q < 10; ++q) { int tr = tlo_ - 1 + q; tr = tr < 0 ? 0 : (tr >= SEQL ? SEQL - 1 : tr); \
        const bf16_t* pr = proj + ((size_t)b * SEQL + tr) * PS; \
        asm volatile("global_load_ushort %0, %1, off" : "+v"(pfd) : "v"(pr + P_R + c)); asm volatile("global_load_ushort %0, %1, off" : "+v"(pfd) : "v"(pr + P_K + c)); \
        asm volatile("global_load_ushort %0, %1, off" : "+v"(pfd) : "v"(pr + P_V + c)); asm volatile("global_load_ushort %0, %1, off" : "+v"(pfd) : "v"(pr + P_RW + lcol)); } } while (0)
    unsigned pfd = 0u;
    for (int chunk = 0; chunk < NCH; ++chunk) {
        {
            const int s0 = chunk * RTC + rq * 8;
            const int tlo = dir ? SEQL - 8 - s0 : s0;
            float rr[10], rk_[10], rv[10], rl[10];
#pragma unroll
            for (int q = 0; q < 10; ++q) {
                const int tr = tlo - 1 + q; const bool ok = (tr >= 0) && (tr < SEQL);
                const bf16_t* pr = proj + ((size_t)b * SEQL + (ok ? tr : 0)) * PS; const float m = ok ? 1.f : 0.f;
                rr[q] = m * bf2f(pr[P_R + c]); rk_[q] = m * bf2f(pr[P_K + c]); rv[q] = m * bf2f(pr[P_V + c]); rl[q] = m * bf2f(pr[P_RW + lcol]);
            }
            float rs[8], ks[8], vs[8], lo[8];
#pragma unroll
            for (int i = 0; i < 8; ++i) {
                const float rc = dir ? rr[8 - i] : rr[i + 1], rp = dir ? rr[7 - i] : rr[i], rn = dir ? rr[9 - i] : rr[i + 2];
                const float kc = dir ? rk_[8 - i] : rk_[i + 1], kp_ = dir ? rk_[7 - i] : rk_[i], kn = dir ? rk_[9 - i] : rk_[i + 2];
                const float vc = dir ? rv[8 - i] : rv[i + 1], vp = dir ? rv[7 - i] : rv[i], vn = dir ? rv[9 - i] : rv[i + 2];
                const float lc = dir ? rl[8 - i] : rl[i + 1], lp = dir ? rl[7 - i] : rl[i], ln = dir ? rl[9 - i] : rl[i + 2];
                rs[i] = rc + mr0 * (rp - rc) + mr1 * (rn - rc);
                ks[i] = kc + mk0 * (kp_ - kc) + mk1 * (kn - kc);
                vs[i] = vc + mv0 * (vp - vc) + mv1 * (vn - vc);
                lo[i] = lc + ml0 * (lp - lc) + ml1 * (ln - lc);
            }
            LAS unsigned short* xs = (LAS unsigned short*)(lds + 86016 + wave * 4096);
#pragma unroll
            for (int i = 0; i < 8; ++i) {
                const float e2 = __expf(2.f * lo[i]); const float th = 1.f - 2.f / (e2 + 1.f);
                xs[i * 64 + lane] = (unsigned short)f2bf(lane < 32 ? th : lo[i]);
            }
            WAVE_FENCE();
            const bf16x8 Aw = *(const LAS bf16x8*)(xs + (lane & 15) * 64 + (lane >> 4) * 8);
            const bf16x8 Aa = *(const LAS bf16x8*)(xs + (lane & 15) * 64 + 32 + (lane >> 4) * 8);
            f32x4 Dw[4], Da[4];
#pragma unroll
            for (int ct = 0; ct < 4; ++ct) {
                Dw[ct] = __builtin_amdgcn_mfma_f32_16x16x32_bf16(Aw, Bw[ct], (f32x4){0.f, 0.f, 0.f, 0.f}, 0, 0, 0);
                Da[ct] = __builtin_amdgcn_mfma_f32_16x16x32_bf16(Aa, Ba[ct], (f32x4){0.f, 0.f, 0.f, 0.f}, 0, 0, 0);
            }
            LAS float* wsf = (LAS float*)xs;
            WAVE_FENCE();
            if (lane < 32) {
#pragma unroll
                for (int ct = 0; ct < 4; ++ct)
#pragma unroll
                    for (int jj = 0; jj < 4; ++jj) {
                        wsf[((lane >> 4) * 4 + jj) * 64 + ct * 16 + (lane & 15)] = Dw[ct][jj];
                        wsf[(8 + (lane >> 4) * 4 + jj) * 64 + ct * 16 + (lane & 15)] = Da[ct][jj];
                    }
            }
            WAVE_FENCE();
            float lamr = 0.f;
#pragma unroll
            for (int i = 0; i < 8; ++i) {
                const int sl = rq * 8 + i;
                const float wpre = w0c + wsf[i * 64 + lane], apre = a0c + wsf[(8 + i) * 64 + lane];
                const float w = -__logf(1.f + __expf(-wpre)) - 0.5f;
                const float ew = __expf(w);
                const float a = sigmoidf_(apre);
                float kk = ks[i] * kkc; const float n2 = wave_sum(kk * kk); kk = kk / fmaxf(sqrtf(n2), 1e-12f);
                const float kd = ks[i] * (1.f + (a - 1.f) * kac);
                const float Lprev = __expf(-lamr); lamr += ew; const float Lcur = __expf(-lamr), Linv = __expf(lamr);
                LAS float* o = ring + (size_t)((dir * RTC + sl) * 5) * 64;
                o[0 * 64 + lane] = -kk * Lprev; o[1 * 64 + lane] = kk * a * Linv; o[2 * 64 + lane] = kd * Linv; o[3 * 64 + lane] = rs[i] * Lcur; o[4 * 64 + lane] = vs[i];
            }
            lam[(dir * 4 + rq) * 64 + lane] = __expf(-lamr);
        }
        __syncthreads();
        if (chunk + 1 < NCH) RW_PREFETCH(chunk + 1);
        {
            RW_ISSUE(A, offk, offv, vvn);
#pragma unroll 1
            for (int sub = 0; sub < 4; ++sub) {
#pragma unroll 1
                for (int it = 0; it < 4; ++it) {
                    const int sl = sub * 8 + it * 2;
                    const unsigned bk1 = offk + (sl + 1) * 1280, bv1 = offv + (sl + 1) * 1280, bk2 = bk1 + 1280, bv2 = bv1 + 1280;
                    const int s = chunk * RTC + sl;
                    LGKM0(); vv = vvn; RW_ISSUE(B, bk1, bv1, vvn); SCHEDB; RW_COMPUTE(A); SCHEDB;
                    if (kp == 0) { const int t = dir ? SEQL - 1 - s : s; orow[(size_t)t * RW] = (bf16_t)f2bf(oval); }
                    LGKM0(); vv = vvn; RW_ISSUE(A, bk2, bv2, vvn); SCHEDB; RW_COMPUTE(B); SCHEDB;
                    if (kp == 0) { const int t = dir ? SEQL - 2 - s : s + 1; orow[(size_t)t * RW] = (bf16_t)f2bf(oval); }
                }
                {   f32x4 L0, L1, L2, L3; const unsigned la = lam_addr + sub * 256;
                    DSR128(L0, la, 0); DSR128(L1, la, 16); DSR128(L2, la, 32); DSR128(L3, la, 48);
                    LGKM0();
                    S4[0] *= L0; S4[1] *= L1; S4[2] *= L2; S4[3] *= L3; SCHEDB; }
            }
            LGKM0();
            asm volatile("s_waitcnt vmcnt(0)" : "+v"(pfd) :: "memory");
        }
        __syncthreads();
    }
}

constexpr int TC = 16;
#define HG_ISSUE(BUF, bk, Q) do { \
    DSR128(BUF[0], bk, Q); DSR128(BUF[1], bk, Q + 16); DSR128(BUF[2], bk, Q + 32); DSR128(BUF[3], bk, Q + 48); \
    DSR128(BUF[4], bk, 256 + Q); DSR128(BUF[5], bk, 256 + Q + 16); DSR128(BUF[6], bk, 256 + Q + 32); DSR128(BUF[7], bk, 256 + Q + 48); \
    DSR128(BUF[8], bk, 512 + Q); DSR128(BUF[9], bk, 512 + Q + 16); DSR128(BUF[10], bk, 512 + Q + 32); DSR128(BUF[11], bk, 512 + Q + 48); } while (0)
#define HG_HALF(BUF, J) do { _Pragma("unroll") for (int i_ = 0; i_ < 4; ++i_) { \
    f32x4 sv = S4[4 * (J) + i_] * BUF[i_] + BUF[4 + i_] * iv; S4[4 * (J) + i_] = sv; oacc += sv * BUF[8 + i_]; } } while (0)

__device__ __forceinline__ void hgrn_scan_wg(const Params& p, int l, int grp, LAS unsigned char* lds) {
    const int tid = opaque_tid(), wave = tid >> 6, lane = tid & 63;
    constexpr int HTC = 16, NCH = SEQL / HTC;
    LAS float* ring = (LAS float*)lds;
    LAS float* lbt = (LAS float*)(lds + 4 * HTC * 4 * 64 * 4);
    bf16_t* proj = (bf16_t*)(p.ws + OFF_PROJ);
    for (int i = tid; i < 2 * RW; i += 512) { const int dr = i / RW, cc = i % RW; const float* lg = p.in[4] + (size_t)dr * 5 * RW + cc;
        float e[5], mx = -1e30f;
#pragma unroll
        for (int j = 0; j < 5; ++j) { e[j] = lg[j * RW]; mx = fmaxf(mx, e[j]); }
        float sum = 0.f, cum = 0.f;
#pragma unroll
        for (int j = 0; j < 5; ++j) { e[j] = __expf(e[j] - mx); sum += e[j]; if (j <= l) cum += e[j]; }
        lbt[i] = cum / sum; }
    __syncthreads();
    const int j = wave >> 1, half = wave & 1, kp = lane >> 5, col = half * 32 + (lane & 31);
    const int cch = grp * 4 + j;
    const int cdir = cch & 1, cb = (cch >> 1) / 6, chh = (cch >> 1) % 6;
    bf16_t* orow = proj + (size_t)cb * SEQL * PS + (cdir ? P_FB : P_FF) + chh * 64 + col;
    const bf16_t* prow = proj + (size_t)cb * SEQL * PS + chh * 64 + lane;
    const float lb = lbt[cdir * RW + chh * 64 + lane];
    f32x4 S4[8];
#pragma unroll
    for (int k = 0; k < 8; ++k) S4[k] = (f32x4){0.f, 0.f, 0.f, 0.f};
    f32x4 A[12], B[12], oacc = (f32x4){0.f, 0.f, 0.f, 0.f}; float iv = 0.f, ivn = 0.f;
    const unsigned ring_addr = (unsigned)(unsigned long long)ring;
    const unsigned cbase = ring_addr + (unsigned)((j * HTC) * 1024);
    const unsigned offk = cbase + kp * 128, offv = cbase + col * 4;
    for (int chunk = 0; chunk < NCH; ++chunk) {
        {
            float qv[8], fv[8], ivv[8];
#pragma unroll
            for (int i = 0; i < 8; ++i) {
                const int sl = half * 8 + i, s = chunk * HTC + sl, t = cdir ? SEQL - 1 - s : s;
                const bf16_t* pr = prow + (size_t)t * PS;
                qv[i] = bf2f(pr[P_Q]); fv[i] = bf2f(pr[cdir ? P_FB : P_FF]); ivv[i] = bf2f(pr[P_I]);
            }
#pragma unroll
            for (int i = 0; i < 8; ++i) {
                const int sl = half * 8 + i;
                const float f = lb + (1.f - lb) * sigmoidf_(fv[i]);
                LAS float* o = ring + (size_t)((j * HTC + sl) * 4) * 64;
                o[lane] = f; o[64 + lane] = 1.f - f; o[128 + lane] = qv[i]; o[192 + lane] = ivv[i];
            }
        }
        __syncthreads();
        {
            HG_ISSUE(A, offk, 0); DSR32(ivn, offv, 768);
#pragma unroll 1
            for (int sl = 0; sl < HTC; ++sl) {
                const unsigned bk = offk + sl * 1024, nbk = bk + 1024, nbv = offv + (sl + 1) * 1024;
                LGKM0(); iv = ivn; HG_ISSUE(B, bk, 64); SCHEDB; oacc = (f32x4){0.f, 0.f, 0.f, 0.f}; HG_HALF(A, 0); SCHEDB;
                LGKM0(); HG_ISSUE(A, nbk, 0); DSR32(ivn, nbv, 768); SCHEDB; HG_HALF(B, 1); SCHEDB;
                const float oval = xsum32((oacc.x + oacc.y) + (oacc.z + oacc.w));
                const int s = chunk * HTC + sl, t = cdir ? SEQL - 1 - s : s;
                if (kp == 0) orow[(size_t)t * PS] = (bf16_t)f2bf(oval);
            }
            LGKM0();
        }
        __syncthreads();
    }
}

__device__ __forceinline__ void conv_wg(const Params& p, int l, int first, int stride, LAS unsigned char* lds) {
    const int tid = opaque_tid(), wave = tid >> 6, lane = tid & 63;
    LAS float* z = (LAS float*)lds;
    LAS float* ot = (LAS float*)(lds + 62 * 256 * 4);
    bf16_t* proj = (bf16_t*)(p.ws + OFF_PROJ);
    const int ch = tid & 255, half = tid >> 8;
    float w[31];
#pragma unroll
    for (int j = 0; j < 31; ++j) w[j] = p.in[18][(size_t)(l * 31 + j) * 256 + ch];
    const float cb = p.in[19][l * 256 + ch];
    const f32x4 lg = ((const f32x4*)(p.in[20] + l * 256))[lane], lbv = ((const f32x4*)(p.in[21] + l * 256))[lane];
    for (int tile = first; tile < MROWS / 32; tile += stride) {
        const int row0 = tile * 32, b = row0 / SEQL, t0 = row0 % SEQL;
        {
            float zv[31], zg[31];
#pragma unroll
            for (int i = 0; i < 31; ++i) { const int r = half + 2 * i, t = t0 - 15 + r; const bool ok = (t >= 0) && (t < SEQL);
                const bf16_t* pr = proj + ((size_t)b * SEQL + (ok ? t : 0)) * PS; zv[i] = ok ? bf2f(pr[P_CV + ch]) : 0.f; zg[i] = bf2f(pr[P_CG + ch]); }
#pragma unroll
            for (int i = 0; i < 31; ++i) z[(half + 2 * i) * 256 + ch] = zv[i] * sigmoidf_(zg[i]);
        }
        __syncthreads();
#pragma unroll 4
        for (int tt = 0; tt < 16; ++tt) { const int tok = half * 16 + tt; float acc = cb;
#pragma unroll
            for (int j = 0; j < 31; ++j) acc += w[j] * z[(tok + j) * 256 + ch];
            ot[tok * 256 + ch] = acc; }
        __syncthreads();
#pragma unroll
        for (int q = 0; q < 4; ++q) { const int tok = wave * 4 + q;
            f32x4 v = *(const LAS f32x4*)(ot + tok * 256 + lane * 4);
            const float mean = wave_sum((v.x + v.y) + (v.z + v.w)) * (1.f / 256.f);
            v = v - mean;
            const float var = wave_sum((v.x * v.x + v.y * v.y) + (v.z * v.z + v.w * v.w)) * (1.f / 256.f);
            const float rstd = rsqrtf(var + LN_EPS);
            f32x4 y = v * rstd * lg + lbv;
            y.x = y.x * sigmoidf_(y.x); y.y = y.y * sigmoidf_(y.y); y.z = y.z * sigmoidf_(y.z); y.w = y.w * sigmoidf_(y.w);
            u32x2 wv; wv.x = pk2(y.x, y.y); wv.y = pk2(y.z, y.w);
            *(u32x2*)(proj + (size_t)(row0 + tok) * PS + P_YC + lane * 4) = wv; }
        __syncthreads();
    }
}

__device__ __forceinline__ void combine_phase(const Params& p, int l, int widx, int nw, LAS unsigned char* lds) {
    const int tid = opaque_tid(), lane = tid & 63;
    bf16_t* proj = (bf16_t*)(p.ws + OFF_PROJ);
    const bf16_t* o_r = (const bf16_t*)(p.ws + OFF_T);
    LAS unsigned* WA = (LAS unsigned*)lds;
    LAS unsigned* WG = (LAS unsigned*)(lds + 49152);
    {
        const float* aup = p.in[11] + (size_t)(l * 2 * 32) * RW; const float* gup = p.in[12] + (size_t)(l * 64) * RW;
        for (int i = tid; i < 2 * 32 * 3 * 64; i += 512) { const int ln = i & 63, hp = (i >> 6) % 3, dr = i / 192; const float* s = aup + (size_t)dr * RW + (2 * hp) * 64 + ln; WA[i] = pk2(s[0], s[64]); }
        for (int i = tid; i < 64 * 3 * 64; i += 512) { const int ln = i & 63, hp = (i >> 6) % 3, r = i / 192; const float* s = gup + (size_t)r * RW + (2 * hp) * 64 + ln; WG[i] = pk2(s[0], s[64]); }
    }
    __syncthreads();
    const float* mu0 = p.in[7] + (size_t)(l * 2 + 0) * NRW; const float* mu1 = mu0 + NRW;
    const float mad0 = mu0[1216 + lane], mad1 = mu1[1216 + lane], mgd0 = mu0[1280 + lane], mgd1 = mu1[1280 + lane];
    for (int g4 = widx; g4 < MROWS / 2; g4 += nw) {
        const int row0 = g4 * 2;
        float adv[2], sgv[2];
#pragma unroll
        for (int tt = 0; tt < 2; ++tt) { const int row = row0 + tt, t = row % SEQL; const bf16_t* pr = proj + (size_t)row * PS;
            const bool hp = t > 0, hn = t < SEQL - 1; const bf16_t* pp = hp ? pr - PS : pr; const bf16_t* pn = hn ? pr + PS : pr; const float fp = hp ? 1.f : 0.f, fn = hn ? 1.f : 0.f;
            const float ac = bf2f(pr[P_AD + lane]), ap = fp * bf2f(pp[P_AD + lane]), an = fn * bf2f(pn[P_AD + lane]);
            const float gc = bf2f(pr[P_GD + lane]), gp = fp * bf2f(pp[P_GD + lane]), gn = fn * bf2f(pn[P_GD + lane]);
            adv[tt] = ac + mad0 * (ap - ac) + mad1 * (an - ac);
            sgv[tt] = sigmoidf_(gc + mgd0 * (gp - gc) + mgd1 * (gn - gc)); }
        float A0[2][6], A1[2][6], G[2][6];
#pragma unroll
        for (int tt = 0; tt < 2; ++tt)
#pragma unroll
            for (int h = 0; h < 6; ++h) { A0[tt][h] = 0.f; A1[tt][h] = 0.f; G[tt][h] = 0.f; }
#pragma unroll 4
        for (int r = 0; r < 32; ++r) {
            float w0[6], w1[6];
#pragma unroll
            for (int hp = 0; hp < 3; ++hp) { const unsigned u0 = WA[(r * 3 + hp) * 64 + lane], u1 = WA[((32 + r) * 3 + hp) * 64 + lane];
                w0[2 * hp] = __uint_as_float(u0 << 16); w0[2 * hp + 1] = __uint_as_float(u0 & 0xffff0000u); w1[2 * hp] = __uint_as_float(u1 << 16); w1[2 * hp + 1] = __uint_as_float(u1 & 0xffff0000u); }
#pragma unroll
            for (int tt = 0; tt < 2; ++tt) { const float s0 = rdlane(adv[tt], r), s1 = rdlane(adv[tt], 32 + r);
#pragma unroll
                for (int h = 0; h < 6; ++h) { A0[tt][h] += s0 * w0[h]; A1[tt][h] += s1 * w1[h]; } }
        }
#pragma unroll 4
        for (int r = 0; r < 64; ++r) {
            float wg[6];
#pragma unroll
            for (int hp = 0; hp < 3; ++hp) { const unsigned u = WG[(r * 3 + hp) * 64 + lane]; wg[2 * hp] = __uint_as_float(u << 16); wg[2 * hp + 1] = __uint_as_float(u & 0xffff0000u); }
#pragma unroll
            for (int tt = 0; tt < 2; ++tt) { const float s = rdlane(sgv[tt], r);
#pragma unroll
                for (int h = 0; h < 6; ++h) G[tt][h] += s * wg[h]; }
        }
#pragma unroll
        for (int h = 0; h < 6; ++h) {
            const int c = h * 64 + lane;
            const float a00 = p.in[10][(l * 2 + 0) * RW + c], a01 = p.in[10][(l * 2 + 1) * RW + c], kac = p.in[14][l * RW + c];
            const float rk = p.in[15][(l * 6 + h) * 64 + lane], gng = p.in[16][l * RW + c], gnb = p.in[17][l * RW + c], ng = p.in[6][l * RW + c];
            const float mr0 = mu0[c], mr1 = mu1[c], mk0 = mu0[384 + c], mk1 = mu1[384 + c], mv0 = mu0[768 + c], mv1 = mu1[768 + c];
#pragma unroll
            for (int tt = 0; tt < 2; ++tt) { const int row = row0 + tt, t = row % SEQL; bf16_t* pr = proj + (size_t)row * PS;
                const bool hp = t > 0, hn = t < SEQL - 1; const bf16_t* pp = hp ? pr - PS : pr; const bf16_t* pn = hn ? pr + PS : pr; const float fp = hp ? 1.f : 0.f, fn = hn ? 1.f : 0.f;
                const float rc = bf2f(pr[P_R + c]), rp = fp * bf2f(pp[P_R + c]), rn = fn * bf2f(pn[P_R + c]);
                const float kc = bf2f(pr[P_K + c]), kp = fp * bf2f(pp[P_K + c]), kn = fn * bf2f(pn[P_K + c]);
                const float vc = bf2f(pr[P_V + c]), vp = fp * bf2f(pp[P_V + c]), vn = fn * bf2f(pn[P_V + c]);
                const float rs = rc + mr0 * (rp - rc) + mr1 * (rn - rc);
                const float ks = kc + mk0 * (kp - kc) + mk1 * (kn - kc);
                const float vs = vc + mv0 * (vp - vc) + mv1 * (vn - vc);
                const float a0 = sigmoidf_(a00 + A0[tt][h]), a1 = sigmoidf_(a01 + A1[tt][h]);
                const float kh = ks * (1.f + (0.5f * (a0 + a1) - 1.f) * kac);
                const float bsum = wave_sum(rs * kh * rk);
                const float o = bf2f(o_r[(size_t)row * RW + c]) + bf2f(o_r[((size_t)MROWS + row) * RW + c]);
                const float mean = wave_sum(o) * (1.f / 64.f); const float dlt = o - mean;
                const float var = wave_sum(dlt * dlt) * (1.f / 64.f);
                const float on = dlt * rsqrtf(var + GN_EPS) * gng + gnb;
                const float yr = (on + bsum * vs) * G[tt][h];
                const float oh = bf2f(pr[P_FF + c]) + bf2f(pr[P_FB + c]);
                const float ms = wave_sum(oh * oh) * (1.f / 64.f);
                const float gh = bf2f(pr[P_G + c]);
                const float yh = oh * rsqrtf(ms + RMS_EPS) * ng * (gh * sigmoidf_(gh));
                pr[P_I + c] = (bf16_t)f2bf(yr);
                pr[P_Q + c] = (bf16_t)f2bf(yh);
            }
        }
    }
}

__global__ void __launch_bounds__(512, 2) fwd_mega(Params p) {
    extern __shared__ __attribute__((aligned(16))) unsigned char smem_raw[];
    LAS unsigned char* lds = (LAS unsigned char*)smem_raw;
    cg::grid_group grid = cg::this_grid();
    const int tid = threadIdx.x, wave = tid >> 6, lane = tid & 63;
    const int G = gridDim.x, bid = blockIdx.x;
    const int widx = bid * 8 + wave, nw = G * 8;
    bf16_t* win_t = (bf16_t*)(p.ws + OFF_WIN); bf16_t* wout_t = (bf16_t*)(p.ws + OFF_WOUT); bf16_t* wup_t = (bf16_t*)(p.ws + OFF_WUP); bf16_t* wdn_t = (bf16_t*)(p.ws + OFF_WDN);
    bf16_t* proj = (bf16_t*)(p.ws + OFF_PROJ); bf16_t* xb = (bf16_t*)(p.ws + OFF_T); bf16_t* hid = proj;
    float* x = p.out;
    volatile LAS unsigned* xst = (volatile LAS unsigned*)(lds + 131072);
    if (tid == 0) { xst[0] = 0u; xst[1] = 0u; xst[2] = 0u; xst[3] = 0u; }
    __syncthreads();
    XcdBarrier xbar = xcd_barrier_post((unsigned*)(p.ws + OFF_BAR), xst);

    convert_weights(p, 0, lds, widx, nw);
    for (int row = widx; row < MROWS; row += nw) {
        const float* src = row < 16 * SEQL ? p.in[0] + (size_t)row * D : p.in[1] + (size_t)(row - 16 * SEQL) * D;
        ln_row(src, x + (size_t)row * D, xb + (size_t)row * D, p.in[2], p.in[3], lane);
    }
    grid.sync();
    for (int l = 0; l < DEPTH; ++l) {
        {
            pg8::Gemm g{xb, win_t, MROWS, NINP, D, D}; pg8::StaticOrder S; S.init(MROWS, NINP, G, bid);
            pg8::EpiBf16<0> E{proj + 256, PS};
            for (int rep = 0; rep < REP_GIN; ++rep) pg8::gemm_phase(lds, g, S, E);
        }
        GSYNC();
        for (int rep = 0; rep < REP_SCAN; ++rep) {
            if (bid < 144) rwkv_scan_wg(p, l, bid, lds);
            else if (bid < 216) { if (rep == 0) hgrn_scan_wg(p, l, bid - 144, lds); }
            else { }
        }
        GSYNC();
        conv_wg(p, l, bid, G, lds);
        for (int rep = 0; rep < REP_COMB; ++rep) combine_phase(p, l, widx, nw, lds);
        GSYNC();
        {
            pg8::Gemm g{proj, wout_t, MROWS, D, D, PS}; pg8::StaticOrder S; S.init(MROWS, D, G, bid);
            pg8::EpiResid E{x, D, DN_ALPHA};
            pg8::gemm_phase(lds, g, S, E);
        }
        GSYNC();
        for (int row = widx; row < MROWS; row += 2 * nw) {
            const int r1 = row + nw;
            if (r1 < MROWS) ln_row2(x + (size_t)row * D, x + (size_t)r1 * D, x + (size_t)row * D, x + (size_t)r1 * D, xb + (size_t)row * D, xb + (size_t)r1 * D, p.in[23] + l * D, p.in[24] + l * D, lane);
            else ln_row(x + (size_t)row * D, x + (size_t)row * D, xb + (size_t)row * D, p.in[23] + l * D, p.in[24] + l * D, lane); }
        GSYNC();
        for (int third = 0; third < 3; ++third) {
            constexpr int MT = MROWS / 3;
            {   pg8::Gemm g{xb + (size_t)third * MT * D, wup_t, MT, FFN, D, D}; pg8::StaticOrder S; S.init(MT, FFN, G, bid);
                pg8::EpiBf16<1> E{hid, FFN};
                for (int rep = 0; rep < REP_UP; ++rep) pg8::gemm_phase(lds, g, S, E); }
            GSYNC();
            {   pg8::Gemm g{hid, wdn_t, MT, D, FFN, FFN}; pg8::StaticOrder S; S.init(MT, D, G, bid);
                pg8::EpiResid E{x + (size_t)third * MT * D, D, DN_ALPHA};
                pg8::gemm_phase(lds, g, S, E); }
            GSYNC();
        }
        if (l + 1 < DEPTH) convert_weights(p, l + 1, lds, widx, nw);
        for (int row = widx; row < MROWS; row += 2 * nw) {
            const int r1 = row + nw;
            if (r1 < MROWS) ln_row2(x + (size_t)row * D, x + (size_t)r1 * D, x + (size_t)row * D, x + (size_t)r1 * D, xb + (size_t)row * D, xb + (size_t)r1 * D, p.in[27] + l * D, p.in[28] + l * D, lane);
            else ln_row(x + (size_t)row * D, x + (size_t)row * D, xb + (size_t)row * D, p.in[27] + l * D, p.in[28] + l * D, lane); }
        GSYNC();
    }
}

extern "C" void kernel_launch(void* const* d_in, const int* in_sizes, int n_in, void* d_out, int out_size, void* d_ws, size_t ws_size, hipStream_t stream) {
    static int grid = 0;
    if (grid == 0) {
        if (n_in != 29 || out_size != MROWS * D || ws_size < WS_END) { fprintf(stderr, "kernel_launch: unexpected shapes (n_in %d out %d ws %zu need %zu)\n", n_in, out_size, ws_size, (size_t)WS_END); grid = -1; return; }
        int dev = 0, cus = 0, per_cu = 0;
        hipGetDevice(&dev);
        hipDeviceGetAttribute(&cus, hipDeviceAttributeMultiprocessorCount, dev);
        if (hipFuncSetAttribute((const void*)fwd_mega, hipFuncAttributeMaxDynamicSharedMemorySize, LDS_BYTES) != hipSuccess) { fprintf(stderr, "kernel_launch: hipFuncSetAttribute failed\n"); grid = -1; return; }
        hipOccupancyMaxActiveBlocksPerMultiprocessor(&per_cu, (const void*)fwd_mega, 512, LDS_BYTES);
        (void)hipGetLastError();
        if (per_cu < 1) per_cu = 1;
        grid = cus;
        if (grid != 256) fprintf(stderr, "kernel_launch: note: %d CUs\n", grid);
    }
    if (grid < 0) return;
    if (hipMemsetAsync((char*)d_ws + OFF_BAR, 0, SZ_BAR, stream) != hipSuccess) { fprintf(stderr, "kernel_launch: memset failed\n"); return; }
    Params p{};
    for (int i = 0; i < 29; ++i) p.in[i] = (const float*)d_in[i];
    p.out = (float*)d_out; p.ws = (unsigned char*)d_ws;
    void* args[] = {&p};
    hipError_t e = hipLaunchCooperativeKernel((const void*)fwd_mega, dim3(grid), dim3(512), args, LDS_BYTES, stream);
    if (e != hipSuccess) fprintf(stderr, "cooperative launch failed: %s (grid %d)\n", hipGetErrorString(e), grid);
}
```

```cpp
#include <hip/hip_runtime.h>
#include <hip/hip_cooperative_groups.h>
#include <cstdio>
#include <cstdint>
namespace cg = cooperative_groups;

#define LAS __attribute__((address_space(3)))
typedef unsigned short bf16_t;
typedef short bf16x8 __attribute__((ext_vector_type(8)));
typedef float f32x4 __attribute__((ext_vector_type(4)));
typedef unsigned u32x4 __attribute__((ext_vector_type(4)));
typedef unsigned u32x2 __attribute__((ext_vector_type(2)));

constexpr int D = 1024, SEQL = 2048, NSEQ = 24, MROWS = NSEQ * SEQL, DEPTH = 4, FFN = 4096;
constexpr int NIN = 3776, NINP = 3840, PS = 4096;
constexpr int RW = 384, NRW = 1344;
constexpr int P_YC = 0, P_Q = 256, P_I = 640, P_FF = 1024, P_FB = 1408, P_G = 1792;
constexpr int P_RW = 2176, P_R = P_RW, P_K = P_RW + 384, P_V = P_RW + 768, P_WD = P_RW + 1152, P_AD = P_RW + 1216, P_GD = P_RW + 1280;
constexpr int P_CV = 3520, P_CG = 3776;
constexpr float LN_EPS = 1e-5f, RMS_EPS = 1e-6f, GN_EPS = 64e-5f;
constexpr float DN_ALPHA = 1.681792830507429f;

constexpr size_t OFF_WIN = 0, SZ_WIN = (size_t)NINP * D * 2;
constexpr size_t OFF_WOUT = OFF_WIN + SZ_WIN, SZ_WOUT = (size_t)D * D * 2;
constexpr size_t OFF_WUP = OFF_WOUT + SZ_WOUT, SZ_WUP = (size_t)FFN * D * 2;
constexpr size_t OFF_WDN = OFF_WUP + SZ_WUP, SZ_WDN = (size_t)FFN * D * 2;
constexpr size_t OFF_PROJ = OFF_WDN + SZ_WDN, SZ_PROJ = (size_t)MROWS * PS * 2;
constexpr size_t OFF_T = OFF_PROJ + SZ_PROJ, SZ_T = (size_t)MROWS * D * 2;
constexpr size_t OFF_BAR = OFF_T + SZ_T, SZ_BAR = 3456 * 4;
constexpr size_t WS_END = OFF_BAR + SZ_BAR;
constexpr int LDS_BYTES = 131072 + 16;
#define REP_SCAN 1
#define REP_COMB 1
#define REP_GIN 1
#define REP_UP 1
#define REP_SYNC 1
#define GSYNC() do { for (int r_ = 0; r_ < REP_SYNC; ++r_) xcd_barrier(xbar); } while (0)

struct Params {
    const float* in[29];
    float* out;
    unsigned char* ws;
};

__device__ __forceinline__ float bf2f(bf16_t b) { return __uint_as_float(((unsigned)b) << 16); }
__device__ __forceinline__ unsigned f2bf(float f) { unsigned u = __float_as_uint(f); u += 0x7FFFu + ((u >> 16) & 1u); return u >> 16; }
__device__ __forceinline__ unsigned pk2(float lo, float hi) { return f2bf(lo) | (f2bf(hi) << 16); }
__device__ __forceinline__ float dpp_add(float v, const int ctrl_sel) {
    int r;
    switch (ctrl_sel) {
        case 0: r = __builtin_amdgcn_update_dpp(0, __float_as_int(v), 0xB1, 0xF, 0xF, true); break;
        case 1: r = __builtin_amdgcn_update_dpp(0, __float_as_int(v), 0x4E, 0xF, 0xF, true); break;
        case 2: r = __builtin_amdgcn_update_dpp(0, __float_as_int(v), 0x141, 0xF, 0xF, true); break;
        default: r = __builtin_amdgcn_update_dpp(0, __float_as_int(v), 0x140, 0xF, 0xF, true); break;
    }
    return v + __int_as_float(r);
}
__device__ __forceinline__ float wave_sum(float v) {
    v = dpp_add(v, 0); v = dpp_add(v, 1); v = dpp_add(v, 2); v = dpp_add(v, 3);
    { auto r = __builtin_amdgcn_permlane16_swap(__float_as_uint(v), __float_as_uint(v), false, false); v = __uint_as_float(r[0]) + __uint_as_float(r[1]); }
    { auto r = __builtin_amdgcn_permlane32_swap(__float_as_uint(v), __float_as_uint(v), false, false); v = __uint_as_float(r[0]) + __uint_as_float(r[1]); }
    return v;
}
__device__ __forceinline__ int opaque_tid() { int t = threadIdx.x; asm volatile("" : "+v"(t)); return t; }
__device__ __forceinline__ float sigmoidf_(float x) { return 1.0f / (1.0f + __expf(-x)); }
__device__ __forceinline__ float rdlane(float v, int l) { return __int_as_float(__builtin_amdgcn_readlane(__float_as_int(v), l)); }

#define XB_TMO      128
#define XB_XCNT(j)  (256  + 64 * (j))
#define XB_XSUB(j)  (1280 + 64 * (j))
#define XB_XGEN(j)  (2304 + 64 * (j))
#define XB_TOP      3328
#define XB_TOPGEN   3392
#define XCD_BAR_WORDS 3456
#define XB_SPIN_CAP (1u << 22)
__device__ __forceinline__ unsigned xb_ld(unsigned* p)              { return __hip_atomic_load(p, __ATOMIC_RELAXED, __HIP_MEMORY_SCOPE_AGENT); }
__device__ __forceinline__ unsigned xb_add(unsigned* p, unsigned v) { return __hip_atomic_fetch_add(p, v, __ATOMIC_RELAXED, __HIP_MEMORY_SCOPE_AGENT); }
__device__ __forceinline__ unsigned xb_xcc_id() { return (unsigned)__builtin_amdgcn_s_getreg((3 << 11) | 20) & 0xFu; }
#define XB_SPIN(cond, bar) do { unsigned _sp = 0; while (cond) { __builtin_amdgcn_s_sleep(1); \
    if ((++_sp & 255u) == 0u) { if (xb_ld(&(bar)[XB_TMO])) break; if (_sp > XB_SPIN_CAP) { atomicAdd(&(bar)[XB_TMO], 1u); break; } } } } while (0)
struct XcdBarrier { unsigned* bar; unsigned x; volatile LAS unsigned* st; };
__device__ __forceinline__ XcdBarrier xcd_barrier_post(unsigned* bar, volatile LAS unsigned* st) {
    XcdBarrier b; b.bar = bar; b.x = xb_xcc_id(); b.st = st;
    if (threadIdx.x == 0) (void)xb_add(&bar[XB_XCNT(b.x)], 1u);
    return b;
}
__device__ __forceinline__ void xcd_barrier_complete(unsigned* bar, unsigned x, unsigned& nloc, unsigned& nx) {
    const unsigned G = gridDim.x * gridDim.y * gridDim.z;
    unsigned sum, cnt, mine, sp = 0u;
    for (;;) {
        sum = 0u; cnt = 0u; mine = 0u;
#pragma unroll
        for (unsigned j = 0; j < 16; ++j) { const unsigned c = xb_ld(&bar[XB_XCNT(j)]); sum += c; cnt += (c > 0u) ? 1u : 0u; mine = (j == x) ? c : mine; }
        if (sum == G) break;
        __builtin_amdgcn_s_sleep(1);
        if ((++sp & 255u) == 0u) { if (xb_ld(&bar[XB_TMO])) break; if (sp > XB_SPIN_CAP) { atomicAdd(&bar[XB_TMO], 1u); break; } }
    }
    nloc = mine > 0u ? mine : 1u; nx = cnt > 0u ? cnt : 1u;
}
__device__ __forceinline__ void xcd_barrier(const XcdBarrier& b) {
    asm volatile("s_waitcnt vmcnt(0)" ::: "memory");
    __syncthreads();
    if (threadIdx.x == 0) {
        unsigned* bar = b.bar;
        __builtin_amdgcn_s_waitcnt(0);
        unsigned nloc = b.st[0], nx = b.st[1];
        if (nloc == 0u) { xcd_barrier_complete(bar, b.x, nloc, nx); b.st[0] = nloc; b.st[1] = nx; }
        const unsigned old = xb_add(&bar[XB_XSUB(b.x)], 1u);
        const unsigned gen = old / nloc;
        if (old + 1u == (gen + 1u) * nloc) {
            __builtin_amdgcn_fence(__ATOMIC_RELEASE, "agent");
            asm volatile("s_waitcnt vmcnt(0)" ::: "memory");
            const unsigned og = xb_add(&bar[XB_TOP], 1u);
            const unsigned tg = og / nx;
            if (og + 1u == (tg + 1u) * nx) xb_add(&bar[XB_TOPGEN], 1u);
            else XB_SPIN(xb_ld(&bar[XB_TOPGEN]) == tg, bar);
            __builtin_amdgcn_fence(__ATOMIC_ACQUIRE, "agent");
            xb_add(&bar[XB_XGEN(b.x)], 1u);
            asm volatile("s_waitcnt vmcnt(0)" ::: "memory");
        } else {
            XB_SPIN(xb_ld(&bar[XB_XGEN(b.x)]) == gen, bar);
            __builtin_amdgcn_fence(__ATOMIC_ACQUIRE, "agent");
            asm volatile("s_waitcnt vmcnt(0)" ::: "memory");
        }
    }
    __syncthreads();
}

namespace pg8 {
constexpr int BM = 256, BK = 64, HALF = 128, HTB = HALF * BK * 2, STAGE_BYTES = 8 * HTB, NXCD = 8, WGM = 8;
__device__ __forceinline__ int lds_byte(int r, int c) { const int st = (r >> 4) * 2 + (c >> 5), rr = r & 15, cc = c & 31, ob = rr * 64 + cc * 2; return st * 1024 + (ob ^ (((ob >> 9) & 1) << 5)); }
__device__ __forceinline__ void stage_rc(int b, int& R, int& C) { const int st = b / 1024, sb = b % 1024, swz = sb ^ (((sb >> 9) & 1) << 5); R = (st >> 1) * 16 + swz / 64; C = (st & 1) * 32 + (swz % 64) / 2; }
__device__ __forceinline__ int perm32(int rho) { const int n = rho >> 4, i = rho & 15; return 8 * (i >> 2) + 4 * n + (i & 3); }
struct Unit { int pm, pn; };
struct Gemm { const bf16_t* A; const bf16_t* Bt; int M, N, K, lda; };
struct StaticOrder {
    int nM, nN, nwg, G, c;
    __device__ void init(int M, int N, int G_, int c_) { nM = M / BM; nN = N / BM; nwg = nM * nN; G = G_; c = c_; }
    __device__ bool next(int i, Unit& u) const {
        const long L = (long)i * G + c; if (L >= nwg) return false;
        int wgid = (int)L; { const int q = nwg / NXCD, r = nwg % NXCD, xcd = wgid % NXCD, off = wgid / NXCD; wgid = (xcd < r ? xcd * (q + 1) : r * (q + 1) + (xcd - r) * q) + off; }
        const int nig = WGM * nN, gid = wgid / nig, fm = gid * WGM, gsz = (nM - fm) < WGM ? (nM - fm) : WGM;
        u.pm = fm + ((wgid % nig) % gsz); u.pn = (wgid % nig) / gsz; return true;
    }
};
__device__ __forceinline__ unsigned cvt_pk_bf16(float lo, float hi) { unsigned r; asm volatile("v_cvt_pk_bf16_f32 %0, %1, %2" : "=v"(r) : "v"(lo), "v"(hi)); return r; }

template <int ACT  > struct EpiBf16 {
    static constexpr bool PERM = true;
    bf16_t* O; int ldc;
    __device__ __forceinline__ void operator()(const f32x4 (&acc)[2][2][4][2], const Unit& u, int wr, int wc, int fr, int fq) const {
        const int row0 = u.pm * BM + wr * 64 + fr; const int col0 = u.pn * BM + wc * 32 + 8 * fq;
#pragma unroll
        for (int ai = 0; ai < 2; ++ai)
#pragma unroll
            for (int m = 0; m < 4; ++m) { bf16_t* rowp = O + (size_t)(row0 + ai * HALF + m * 16) * ldc + col0;
#pragma unroll
                for (int bj = 0; bj < 2; ++bj) { f32x4 v0 = acc[ai][bj][m][0], v1 = acc[ai][bj][m][1];
                    if (ACT == 1) {
#pragma unroll
                        for (int j = 0; j < 4; ++j) { float a = fmaxf(v0[j], 0.f), b = fmaxf(v1[j], 0.f); v0[j] = a * a; v1[j] = b * b; } }
                    u32x4 w; w.x = cvt_pk_bf16(v0[0], v0[1]); w.y = cvt_pk_bf16(v0[2], v0[3]); w.z = cvt_pk_bf16(v1[0], v1[1]); w.w = cvt_pk_bf16(v1[2], v1[3]);
                    *(u32x4*)(rowp + bj * HALF) = w; } }
    }
};
struct EpiResid {
    static constexpr bool PERM = false;
    float* C; int ldc; float alpha;
    __device__ __forceinline__ void operator()(const f32x4 (&acc)[2][2][4][2], const Unit& u, int wr, int wc, int fr, int fq) const {
        const int row0 = u.pm * BM + wr * 64 + fr, col0 = u.pn * BM + wc * 32 + 4 * fq;
#pragma unroll
        for (int ai = 0; ai < 2; ++ai)
#pragma unroll
            for (int m = 0; m < 4; ++m) { float* rowp = C + (size_t)(row0 + ai * HALF + m * 16) * ldc + col0;
                f32x4 old[2][2];
#pragma unroll
                for (int bj = 0; bj < 2; ++bj)
#pragma unroll
                    for (int n = 0; n < 2; ++n) old[bj][n] = *(const f32x4*)(rowp + bj * HALF + n * 16);
#pragma unroll
                for (int bj = 0; bj < 2; ++bj)
#pragma unroll
                    for (int n = 0; n < 2; ++n) *(f32x4*)(rowp + bj * HALF + n * 16) = old[bj][n] * alpha + acc[ai][bj][m][n]; }
    }
};

template <class Epi, class Sched>
__device__ __forceinline__ void gemm_phase(LAS unsigned char* lds, const Gemm g, const Sched& S, const Epi& E) {
    const int tid = opaque_tid(), wid = __builtin_amdgcn_readfirstlane(tid >> 6), lane = tid & 63, wr = wid >> 2, wc = wid & 3, fr = lane & 15, fq = lane >> 4;
    const int K = g.K, nt = K / BK, lda = g.lda;
    unsigned voffA[2], voffB[2];
#pragma unroll
    for (int i = 0; i < 2; ++i) { int R, C; stage_rc(tid * 16 + i * 8192, R, C); const int Rb = Epi::PERM ? ((R & ~31) + perm32(R & 31)) : R;
        voffA[i] = (unsigned)(R * lda + C) * 2u; voffB[i] = (unsigned)(Rb * K + C) * 2u; }
    const size_t kstep = (size_t)(BK * 2);
    const size_t hstepA = (size_t)HALF * lda * 2, hstepB = (size_t)HALF * K * 2;
    const size_t tstepA = 2 * hstepA, tstepB = 2 * hstepB;
    const unsigned ldsw = (unsigned)wid * 1024u;
    const int aoff = lds_byte(wr * 64 + fr, fq * 8), boff = lds_byte(wc * 32 + fr, fq * 8);
#define PG8_SA(b, h) (((b) * 2 + (h)) * HTB)
#define PG8_SB(b, h) ((4 + (b) * 2 + (h)) * HTB)
#define PG8_STAGE(bufoff, gbase, voff) do { _Pragma("unroll") for (int _i = 0; _i < 2; ++_i) \
        __builtin_amdgcn_global_load_lds((const unsigned*)((const char*)(gbase) + (voff)[_i]), (LAS unsigned*)(lds + (bufoff) + ldsw + _i * 8192), 16, 0, 0); } while (0)
#define PG8_LDA(dst, b, h) do { _Pragma("unroll") for (int m = 0; m < 4; ++m) _Pragma("unroll") for (int k = 0; k < 2; ++k) dst[m][k] = *(const LAS bf16x8*)(lds + PG8_SA(b, h) + aoff + m * 2048 + k * 1024); } while (0)
#define PG8_LDB(dst, b, h) do { _Pragma("unroll") for (int n = 0; n < 2; ++n) _Pragma("unroll") for (int k = 0; k < 2; ++k) dst[n][k] = *(const LAS bf16x8*)(lds + PG8_SB(b, h) + boff + n * 2048 + k * 1024); } while (0)
#define PG8_MMA(ai, bj, At, Bt) do { __builtin_amdgcn_s_setprio(1); _Pragma("unroll") for (int m = 0; m < 4; ++m) _Pragma("unroll") for (int n = 0; n < 2; ++n) _Pragma("unroll") for (int k = 0; k < 2; ++k) \
        acc[ai][bj][m][n] = __builtin_amdgcn_mfma_f32_16x16x32_bf16(Bt[n][k], At[m][k], acc[ai][bj][m][n], 0, 0, 0); __builtin_amdgcn_s_setprio(0); } while (0)
#define PG8_WAIT_V(n) asm volatile("s_waitcnt vmcnt(" #n ")" ::: "memory")
#define PG8_WAIT_L(n) asm volatile("s_waitcnt lgkmcnt(" #n ")" ::: "memory")
#define PG8_BAR __builtin_amdgcn_s_barrier()
#define PG8_SCHED __builtin_amdgcn_sched_barrier(0)
    Unit cur, nxt; int ui = 0;
    if (!S.next(0, cur)) return;
    f32x4 acc[2][2][4][2];
#pragma unroll
    for (int a = 0; a < 2; ++a)
#pragma unroll
        for (int b = 0; b < 2; ++b)
#pragma unroll
            for (int m = 0; m < 4; ++m)
#pragma unroll
                for (int n = 0; n < 2; ++n) acc[a][b][m][n] = (f32x4){0.f, 0.f, 0.f, 0.f};
    bf16x8 At[4][2], B0[2][2], B1[2][2];
    const char* cA = (const char*)g.A + (size_t)cur.pm * tstepA; const char* cB = (const char*)g.Bt + (size_t)cur.pn * tstepB;
    PG8_STAGE(PG8_SB(0, 0), cB, voffB); PG8_STAGE(PG8_SB(0, 1), cB + hstepB, voffB); PG8_STAGE(PG8_SA(0, 0), cA, voffA); PG8_STAGE(PG8_SA(0, 1), cA + hstepA, voffA);
    if (wr == 1) PG8_BAR;
    PG8_WAIT_V(2); PG8_BAR;
    PG8_STAGE(PG8_SB(1, 0), cB + kstep, voffB); PG8_STAGE(PG8_SA(1, 0), cA + kstep, voffA); PG8_STAGE(PG8_SB(1, 1), cB + hstepB + kstep, voffB);
    PG8_WAIT_V(6); PG8_BAR;
    for (;;) {
        const bool has_next = S.next(ui + 1, nxt);
        const char* nA = has_next ? (const char*)g.A + (size_t)nxt.pm * tstepA : cA; const char* nB = has_next ? (const char*)g.Bt + (size_t)nxt.pn * tstepB : cB;
        for (int t = 0; t < nt; t += 2) {
            const bool last = (t == nt - 2);
            const char* a1 = cA + (size_t)(t + 1) * kstep;
            const char* a2 = last ? nA : cA + (size_t)(t + 2) * kstep; const char* b2 = last ? nB : cB + (size_t)(t + 2) * kstep;
            const char* a3 = a2 + kstep; const char* b3 = b2 + kstep;
            PG8_LDB(B0, 0, 0); PG8_LDB(B1, 0, 1); PG8_SCHED; PG8_LDA(At, 0, 0); PG8_STAGE(PG8_SA(1, 1), a1 + hstepA, voffA);
            PG8_WAIT_V(8); PG8_WAIT_L(0); PG8_BAR; PG8_MMA(0, 0, At, B0); PG8_MMA(0, 1, At, B1); PG8_BAR; PG8_SCHED;
            PG8_LDA(At, 0, 1); PG8_STAGE(PG8_SB(0, 0), b2, voffB); PG8_STAGE(PG8_SB(0, 1), b2 + hstepB, voffB); PG8_STAGE(PG8_SA(0, 0), a2, voffA);
            PG8_WAIT_V(8); PG8_WAIT_L(0); PG8_BAR; PG8_MMA(1, 0, At, B0); PG8_MMA(1, 1, At, B1); PG8_BAR; PG8_SCHED;
            PG8_LDB(B0, 1, 0); PG8_LDB(B1, 1, 1); PG8_SCHED; PG8_LDA(At, 1, 0); PG8_STAGE(PG8_SA(0, 1), a2 + hstepA, voffA);
            PG8_WAIT_V(8); PG8_WAIT_L(0); PG8_BAR; PG8_MMA(0, 0, At, B0); PG8_MMA(0, 1, At, B1); PG8_BAR; PG8_SCHED;
            PG8_LDA(At, 1, 1); PG8_STAGE(PG8_SB(1, 0), b3, voffB); PG8_STAGE(PG8_SB(1, 1), b3 + hstepB, voffB); PG8_STAGE(PG8_SA(1, 0), a3, voffA);
            PG8_WAIT_V(8); PG8_WAIT_L(0); PG8_BAR; PG8_MMA(1, 0, At, B0); PG8_MMA(1, 1, At, B1); PG8_BAR; PG8_SCHED;
        }
        if (wr == 0) PG8_BAR;
        E(acc, cur, wr, wc, fr, fq);
        if (!has_next) break;
#pragma unroll
        for (int a = 0; a < 2; ++a)
#pragma unroll
            for (int b = 0; b < 2; ++b)
#pragma unroll
                for (int m = 0; m < 4; ++m)
#pragma unroll
                    for (int n = 0; n < 2; ++n) acc[a][b][m][n] = (f32x4){0.f, 0.f, 0.f, 0.f};
        cur = nxt; cA = nA; cB = nB; ++ui;
        if (wr == 1) PG8_BAR;
    }
    PG8_WAIT_V(0);
    PG8_BAR;
#undef PG8_SA
#undef PG8_SB
#undef PG8_STAGE
#undef PG8_LDA
#undef PG8_LDB
#undef PG8_MMA
#undef PG8_WAIT_V
#undef PG8_WAIT_L
#undef PG8_BAR
#undef PG8_SCHED
}
}

__device__ __forceinline__ void transpose_item(const float* W, int Nsrc, int ksrc0, int nsrc0, bf16_t* WT, int K, int k0, int n0, LAS float* scr, int lane) {
#pragma unroll 8
    for (int i = 0; i < 32; ++i) { const int kk = 2 * i + (lane >> 5);
        scr[kk * 33 + (lane & 31)] = nsrc0 >= 0 ? W[(size_t)(ksrc0 + kk) * Nsrc + nsrc0 + (lane & 31)] : 0.f; }
    asm volatile("s_waitcnt lgkmcnt(0)" ::: "memory");
    const int c = lane & 7;
#pragma unroll
    for (int j = 0; j < 4; ++j) { const int n = (lane >> 3) + 8 * j; const LAS float* s = scr + (8 * c) * 33 + n;
        u32x4 o; o.x = pk2(s[0 * 33], s[1 * 33]); o.y = pk2(s[2 * 33], s[3 * 33]); o.z = pk2(s[4 * 33], s[5 * 33]); o.w = pk2(s[6 * 33], s[7 * 33]);
        *(u32x4*)(WT + (size_t)(n0 + n) * K + k0 + 8 * c) = o; }
    asm volatile("s_waitcnt lgkmcnt(0)" ::: "memory");
}
__device__ __forceinline__ int win_colmap(int n0) {
    if (n0 < 384) return n0;
    if (n0 < 768) return 1152 + (n0 - 384);
    if (n0 < 1152) return 384 + (n0 - 768);
    if (n0 < 1536) return 768 + (n0 - 1152);
    if (n0 < NIN) return n0;
    return -1;
}
__device__ __forceinline__ void convert_weights(const Params& p, int l, LAS unsigned char* lds, int widx, int nw) {
    const int tid_ = opaque_tid(); const int wave = tid_ >> 6, lane = tid_ & 63;
    LAS float* scr = (LAS float*)(lds + wave * 8448);
    bf16_t* win_t = (bf16_t*)(p.ws + OFF_WIN); bf16_t* wout_t = (bf16_t*)(p.ws + OFF_WOUT); bf16_t* wup_t = (bf16_t*)(p.ws + OFF_WUP); bf16_t* wdn_t = (bf16_t*)(p.ws + OFF_WDN);
    const float* w_in = p.in[5] + (size_t)l * D * NIN; const float* w_out = p.in[22] + (size_t)l * D * D;
    const float* w_up = p.in[25] + (size_t)l * D * FFN; const float* w_dn = p.in[26] + (size_t)l * FFN * D;
    constexpr int I_IN = (D / 64) * (NINP / 32), I_OUT = (D / 64) * (D / 32), I_UP = (D / 64) * (FFN / 32), I_DN = (FFN / 64) * (D / 32);
    for (int it = widx; it < I_IN + I_OUT + I_UP + I_DN; it += nw) {
        int r = it;
        if (r < I_IN) { const int nb = NINP / 32, kb = r / nb, n0 = (r % nb) * 32; transpose_item(w_in, NIN, kb * 64, win_colmap(n0), win_t, D, kb * 64, n0, scr, lane); continue; } r -= I_IN;
        if (r < I_OUT) { const int nb = D / 32, kb = r / nb, n0 = (r % nb) * 32, k0 = kb * 64; const int ks = k0 < 256 ? 768 + k0 : k0 - 256;
            transpose_item(w_out, D, ks, n0, wout_t, D, k0, n0, scr, lane); continue; } r -= I_OUT;
        if (r < I_UP) { const int nb = FFN / 32, kb = r / nb, n0 = (r % nb) * 32; transpose_item(w_up, FFN, kb * 64, n0, wup_t, D, kb * 64, n0, scr, lane); continue; } r -= I_UP;
        { const int nb = D / 32, kb = r / nb, n0 = (r % nb) * 32; transpose_item(w_dn, D, kb * 64, n0, wdn_t, FFN, kb * 64, n0, scr, lane); }
    }
}

__device__ __forceinline__ void ln_row(const float* src, float* dst32, bf16_t* dstb, const float* g, const float* b, int lane_) {
    int lane = lane_; asm volatile("" : "+v"(lane));
    const f32x4* xr = (const f32x4*)src + lane;
    f32x4 v[4]; float s = 0.f;
#pragma unroll
    for (int j = 0; j < 4; ++j) { v[j] = xr[64 * j]; s += (v[j].x + v[j].y) + (v[j].z + v[j].w); }
    const float mean = wave_sum(s) * (1.f / D); float s2 = 0.f;
#pragma unroll
    for (int j = 0; j < 4; ++j) { v[j] = v[j] - mean; s2 += (v[j].x * v[j].x + v[j].y * v[j].y) + (v[j].z * v[j].z + v[j].w * v[j].w); }
    const float rstd = rsqrtf(wave_sum(s2) * (1.f / D) + LN_EPS);
#pragma unroll
    for (int j = 0; j < 4; ++j) {
        const f32x4 gg = ((const f32x4*)g)[lane + 64 * j], bb = ((const f32x4*)b)[lane + 64 * j];
        f32x4 o = v[j] * rstd * gg + bb;
        ((f32x4*)dst32)[lane + 64 * j] = o;
        u32x2 w; w.x = pk2(o.x, o.y); w.y = pk2(o.z, o.w);
        ((u32x2*)dstb)[lane + 64 * j] = w;
    }
}

__device__ __forceinline__ void ln_row2(const float* src0, const float* src1, float* d0, float* d1, bf16_t* b0, bf16_t* b1, const float* g, const float* b, int lane_) {
    int lane = lane_; asm volatile("" : "+v"(lane));
    const f32x4* x0 = (const f32x4*)src0 + lane; const f32x4* x1 = (const f32x4*)src1 + lane;
    f32x4 v[4], u[4]; float s = 0.f, t = 0.f;
#pragma unroll
    for (int j = 0; j < 4; ++j) { v[j] = x0[64 * j]; u[j] = x1[64 * j]; }
#pragma unroll
    for (int j = 0; j < 4; ++j) { s += (v[j].x + v[j].y) + (v[j].z + v[j].w); t += (u[j].x + u[j].y) + (u[j].z + u[j].w); }
    const float m0 = wave_sum(s) * (1.f / D), m1 = wave_sum(t) * (1.f / D); float s2 = 0.f, t2 = 0.f;
#pragma unroll
    for (int j = 0; j < 4; ++j) { v[j] = v[j] - m0; u[j] = u[j] - m1; s2 += (v[j].x * v[j].x + v[j].y * v[j].y) + (v[j].z * v[j].z + v[j].w * v[j].w); t2 += (u[j].x * u[j].x + u[j].y * u[j].y) + (u[j].z * u[j].z + u[j].w * u[j].w); }
    const float r0 = rsqrtf(wave_sum(s2) * (1.f / D) + LN_EPS), r1 = rsqrtf(wave_sum(t2) * (1.f / D) + LN_EPS);
#pragma unroll
    for (int j = 0; j < 4; ++j) {
        const f32x4 gg = ((const f32x4*)g)[lane + 64 * j], bb = ((const f32x4*)b)[lane + 64 * j];
        const f32x4 o0 = v[j] * r0 * gg + bb, o1 = u[j] * r1 * gg + bb;
        ((f32x4*)d0)[lane + 64 * j] = o0; ((f32x4*)d1)[lane + 64 * j] = o1;
        u32x2 w0, w1; w0.x = pk2(o0.x, o0.y); w0.y = pk2(o0.z, o0.w); w1.x = pk2(o1.x, o1.y); w1.y = pk2(o1.z, o1.w);
        ((u32x2*)b0)[lane + 64 * j] = w0; ((u32x2*)b1)[lane + 64 * j] = w1;
    }
}

#define DSR128(dst, addr, off) asm volatile("ds_read_b128 %0, %1 offset:%2" : "=v"(dst) : "v"(addr), "n"(off))
#define DSR32(dst, addr, off) asm volatile("ds_read_b32 %0, %1 offset:%2" : "=v"(dst) : "v"(addr), "n"(off))
#define LGKM0() do { asm volatile("s_waitcnt lgkmcnt(0)" ::: "memory"); __builtin_amdgcn_sched_barrier(0); } while (0)
#define SCHEDB __builtin_amdgcn_sched_barrier(0)
#define WAVE_FENCE() do { __builtin_amdgcn_fence(__ATOMIC_RELEASE, "wavefront"); __builtin_amdgcn_wave_barrier(); __builtin_amdgcn_fence(__ATOMIC_ACQUIRE, "wavefront"); } while (0)
__device__ __forceinline__ float xsum32(float x) { auto r = __builtin_amdgcn_permlane32_swap(__float_as_uint(x), __float_as_uint(x), false, false); return __uint_as_float(r[0]) + __uint_as_float(r[1]); }
__device__ __forceinline__ float xsum16(float x) { auto r = __builtin_amdgcn_permlane16_swap(__float_as_uint(x), __float_as_uint(x), false, false); return __uint_as_float(r[0]) + __uint_as_float(r[1]); }

constexpr int RTC = 32;
#define RW_ISSUE(BUF, bk, bv, vvn) do { \
    DSR128(BUF[0], bk, 0); DSR128(BUF[1], bk, 16); DSR128(BUF[2], bk, 32); DSR128(BUF[3], bk, 48); \
    DSR128(BUF[4], bk, 256); DSR128(BUF[5], bk, 272); DSR128(BUF[6], bk, 288); DSR128(BUF[7], bk, 304); \
    DSR128(BUF[8], bk, 512); DSR128(BUF[9], bk, 528); DSR128(BUF[10], bk, 544); DSR128(BUF[11], bk, 560); \
    DSR128(BUF[12], bk, 768); DSR128(BUF[13], bk, 784); DSR128(BUF[14], bk, 800); DSR128(BUF[15], bk, 816); \
    DSR32(vvn, bv, 1024); } while (0)
#define RW_COMPUTE(BUF) do { \
    f32x4 sacc = S4[0] * BUF[0] + S4[1] * BUF[1]; sacc += S4[2] * BUF[2] + S4[3] * BUF[3]; \
    const float sa = xsum16(xsum32((sacc.x + sacc.y) + (sacc.z + sacc.w))); \
    f32x4 oacc = (f32x4){0.f, 0.f, 0.f, 0.f}; \
    _Pragma("unroll") for (int i_ = 0; i_ < 4; ++i_) { f32x4 sv = S4[i_] + (sa * BUF[4 + i_] + vv * BUF[8 + i_]); S4[i_] = sv; oacc += sv * BUF[12 + i_]; } \
    oval = xsum16(xsum32((oacc.x + oacc.y) + (oacc.z + oacc.w))); } while (0)

#define RW7_ISSUE(BUF, bk, bv, va, vb) do { \
    DSR128(BUF[0], bk, 0); DSR128(BUF[1], bk, 16); DSR128(BUF[2], bk, 32); DSR128(BUF[3], bk, 48); \
    DSR128(BUF[4], bk, 256); DSR128(BUF[5], bk, 272); DSR128(BUF[6], bk, 288); DSR128(BUF[7], bk, 304); \
    DSR128(BUF[8], bk, 512); DSR128(BUF[9], bk, 528); DSR128(BUF[10], bk, 544); DSR128(BUF[11], bk, 560); \
    DSR128(BUF[12], bk, 768); DSR128(BUF[13], bk, 784); DSR128(BUF[14], bk, 800); DSR128(BUF[15], bk, 816); \
    DSR32(va, bv, 1024); DSR32(vb, bv, 1088); } while (0)
#define RW7_COMPUTE(BUF) do { \
    f32x4 sa0 = S4[0] * BUF[0] + S4[1] * BUF[1]; sa0 += S4[2] * BUF[2] + S4[3] * BUF[3]; \
    f32x4 sa1 = S4[4] * BUF[0] + S4[5] * BUF[1]; sa1 += S4[6] * BUF[2] + S4[7] * BUF[3]; \
    const float sA = xsum16(xsum32((sa0.x + sa0.y) + (sa0.z + sa0.w))), sB = xsum16(xsum32((sa1.x + sa1.y) + (sa1.z + sa1.w))); \
    f32x4 oa0 = (f32x4){0.f, 0.f, 0.f, 0.f}, oa1 = (f32x4){0.f, 0.f, 0.f, 0.f}; \
    _Pragma("unroll") for (int i_ = 0; i_ < 4; ++i_) { \
        f32x4 s0 = S4[i_] + (sA * BUF[4 + i_] + vv0 * BUF[8 + i_]); S4[i_] = s0; oa0 += s0 * BUF[12 + i_]; \
        f32x4 s1 = S4[4 + i_] + (sB * BUF[4 + i_] + vv1 * BUF[8 + i_]); S4[4 + i_] = s1; oa1 += s1 * BUF[12 + i_]; } \
    oval0 = xsum16(xsum32((oa0.x + oa0.y) + (oa0.z + oa0.w))); oval1 = xsum16(xsum32((oa1.x + oa1.y) + (oa1.z + oa1.w))); } while (0)

__device__ __forceinline__ void rwkv_scan_wg(const Params& p, int l, int pairIdx, LAS unsigned char* lds) {
    const int tid = opaque_tid(), wave = tid >> 6, lane = tid & 63;
    const int b = pairIdx / 6, h = pairIdx % 6;
    constexpr int CT = 16, NCH = SEQL / CT;
    LAS float* ring = (LAS float*)lds;
    LAS float* lam = (LAS float*)(lds + 81920);
    const bf16_t* proj = (const bf16_t*)(p.ws + OFF_PROJ);
    bf16_t* o_r = (bf16_t*)(p.ws + OFF_T);
    if (wave < 4) {
        const int dir = wave >> 1, half = wave & 1;
        const int kp = lane >> 4, row = lane & 15, v0 = half * 32 + row;
        f32x4 S4[8];
#pragma unroll
        for (int k = 0; k < 8; ++k) S4[k] = (f32x4){0.f, 0.f, 0.f, 0.f};
        f32x4 A[16], B[16]; float vv0 = 0.f, vv1 = 0.f, vn0 = 0.f, vn1 = 0.f, oval0 = 0.f, oval1 = 0.f;
        const unsigned ring_base = (unsigned)(unsigned long long)ring, lam_base = (unsigned)(unsigned long long)lam;
        bf16_t* orow = o_r + ((size_t)dir * MROWS + (size_t)b * SEQL) * RW + h * 64 + v0;
        __syncthreads();
        for (int chunk = 0; chunk < NCH; ++chunk) {
            const unsigned rb = ring_base + (unsigned)((((chunk & 1) * 2 + dir) * CT) * 1280);
            const unsigned offk = rb + kp * 64, offv = rb + v0 * 4;
            const unsigned lam_addr = lam_base + (unsigned)((((chunk & 1) * 2 + dir) * 2) * 256) + kp * 64;
            RW7_ISSUE(A, offk, offv, vn0, vn1);
#pragma unroll 1
            for (int sub = 0; sub < 2; ++sub) {
#pragma unroll 1
                for (int it = 0; it < 4; ++it) {
                    const int sl = sub * 8 + it * 2;
                    const unsigned bk1 = offk + (sl + 1) * 1280, bv1 = offv + (sl + 1) * 1280, bk2 = bk1 + 1280, bv2 = bv1 + 1280;
                    const int s = chunk * CT + sl;
                    LGKM0(); vv0 = vn0; vv1 = vn1; RW7_ISSUE(B, bk1, bv1, vn0, vn1); SCHEDB; RW7_COMPUTE(A); SCHEDB;
                    if (kp == 0) { const int t = dir ? SEQL - 1 - s : s; orow[(size_t)t * RW] = (bf16_t)f2bf(oval0); orow[(size_t)t * RW + 16] = (bf16_t)f2bf(oval1); }
                    LGKM0(); vv0 = vn0; vv1 = vn1; RW7_ISSUE(A, bk2, bv2, vn0, vn1); SCHEDB; RW7_COMPUTE(B); SCHEDB;
                    if (kp == 0) { const int t = dir ? SEQL - 2 - s : s + 1; orow[(size_t)t * RW] = (bf16_t)f2bf(oval0); orow[(size_t)t * RW + 16] = (bf16_t)f2bf(oval1); }
                }
                {   f32x4 L0, L1, L2, L3; const unsigned la = lam_addr + sub * 256;
                    DSR128(L0, la, 0); DSR128(L1, la, 16); DSR128(L2, la, 32); DSR128(L3, la, 48);
                    LGKM0();
                    S4[0] *= L0; S4[1] *= L1; S4[2] *= L2; S4[3] *= L3; S4[4] *= L0; S4[5] *= L1; S4[6] *= L2; S4[7] *= L3; SCHEDB; }
            }
            LGKM0();
            __syncthreads();
        }
    } else {
        const int dir = (wave - 4) >> 1, sub = (wave - 4) & 1;
        const int c = h * 64 + lane;
        const float w0c = p.in[8][(l * 2 + dir) * RW + c], a0c = p.in[10][(l * 2 + dir) * RW + c];
        const float kkc = p.in[13][l * RW + c], kac = p.in[14][l * RW + c];
        const float* mu0 = p.in[7] + (size_t)(l * 2 + 0) * NRW; const float* mu1 = mu0 + NRW;
        const float mr0 = mu0[c], mr1 = mu1[c], mk0 = mu0[384 + c], mk1 = mu1[384 + c], mv0 = mu0[768 + c], mv1 = mu1[768 + c];
        const int lcol = lane < 32 ? 1152 + dir * 32 + lane : 1216 + dir * 32 + (lane - 32);
        const float ml0 = mu0[lcol], ml1 = mu1[lcol];
        bf16x8 Bw[4], Ba[4];
        {   const float* wu = p.in[9] + (size_t)((l * 2 + dir) * 32) * RW + h * 64 + (lane & 15); const float* au = p.in[11] + (size_t)((l * 2 + dir) * 32) * RW + h * 64 + (lane & 15);
#pragma unroll
            for (int ct = 0; ct < 4; ++ct)
#pragma unroll
                for (int jj = 0; jj < 8; ++jj) { const int r = (lane >> 4) * 8 + jj;
                    Bw[ct][jj] = (short)f2bf(wu[(size_t)r * RW + ct * 16]); Ba[ct][jj] = (short)f2bf(au[(size_t)r * RW + ct * 16]); } }
        LAS unsigned short* xs = (LAS unsigned short*)(lds + 83968 + (wave - 4) * 4096);
        unsigned pfd = 0u;
        for (int chunk = 0; chunk <= NCH; ++chunk) {
            if (chunk < NCH) {
                asm volatile("s_waitcnt vmcnt(0)" : "+v"(pfd) :: "memory");
                const int s0 = chunk * CT + sub * 8;
                const int tlo = dir ? SEQL - 8 - s0 : s0;
                float rr[10], rk_[10], rv[10], rl[10];
#pragma unroll
                for (int q = 0; q < 10; ++q) {
                    const int tr = tlo - 1 + q; const bool ok = (tr >= 0) && (tr < SEQL);
                    const bf16_t* pr = proj + ((size_t)b * SEQL + (ok ? tr : 0)) * PS; const float m = ok ? 1.f : 0.f;
                    rr[q] = m * bf2f(pr[P_R + c]); rk_[q] = m * bf2f(pr[P_K + c]); rv[q] = m * bf2f(pr[P_V + c]); rl[q] = m * bf2f(pr[P_RW + lcol]);
                }
                float rs[8], ks[8], vs[8], lo[8];
#pragma unroll
                for (int i = 0; i < 8; ++i) {
                    const float rc = dir ? rr[8 - i] : rr[i + 1], rp = dir ? rr[7 - i] : rr[i], rn = dir ? rr[9 - i] : rr[i + 2];
                    const float kc = dir ? rk_[8 - i] : rk_[i + 1], kp_ = dir ? rk_[7 - i] : rk_[i], kn = dir ? rk_[9 - i] : rk_[i + 2];
                    const float vc = dir ? rv[8 - i] : rv[i + 1], vp = dir ? rv[7 - i] : rv[i], vn = dir ? rv[9 - i] : rv[i + 2];
                    const float lc = dir ? rl[8 - i] : rl[i + 1], lp = dir ? rl[7 - i] : rl[i], ln = dir ? rl[9 - i] : rl[i + 2];
                    rs[i] = rc + mr0 * (rp - rc) + mr1 * (rn - rc);
                    ks[i] = kc + mk0 * (kp_ - kc) + mk1 * (kn - kc);
                    vs[i] = vc + mv0 * (vp - vc) + mv1 * (vn - vc);
                    lo[i] = lc + ml0 * (lp - lc) + ml1 * (ln - lc);
                }
#pragma unroll
                for (int i = 0; i < 8; ++i) {
                    const float e2 = __expf(2.f * lo[i]); const float th = 1.f - 2.f / (e2 + 1.f);
                    xs[i * 64 + lane] = (unsigned short)f2bf(lane < 32 ? th : lo[i]);
                }
                WAVE_FENCE();
                const bf16x8 Aw = *(const LAS bf16x8*)(xs + (lane & 15) * 64 + (lane >> 4) * 8);
                const bf16x8 Aa = *(const LAS bf16x8*)(xs + (lane & 15) * 64 + 32 + (lane >> 4) * 8);
                f32x4 Dw[4], Da[4];
#pragma unroll
                for (int ct = 0; ct < 4; ++ct) {
                    Dw[ct] = __builtin_amdgcn_mfma_f32_16x16x32_bf16(Aw, Bw[ct], (f32x4){0.f, 0.f, 0.f, 0.f}, 0, 0, 0);
                    Da[ct] = __builtin_amdgcn_mfma_f32_16x16x32_bf16(Aa, Ba[ct], (f32x4){0.f, 0.f, 0.f, 0.f}, 0, 0, 0);
                }
                LAS float* wsf = (LAS float*)xs;
                WAVE_FENCE();
                if (lane < 32) {
#pragma unroll
                    for (int ct = 0; ct < 4; ++ct)
#pragma unroll
                        for (int jj = 0; jj < 4; ++jj) {
                            wsf[((lane >> 4) * 4 + jj) * 64 + ct * 16 + (lane & 15)] = Dw[ct][jj];
                            wsf[(8 + (lane >> 4) * 4 + jj) * 64 + ct * 16 + (lane & 15)] = Da[ct][jj];
                        }
                }
                WAVE_FENCE();
                const int pb = chunk & 1;
                float lamr = 0.f;
#pragma unroll
                for (int i = 0; i < 8; ++i) {
                    const int sl = sub * 8 + i;
                    const float wpre = w0c + wsf[i * 64 + lane], apre = a0c + wsf[(8 + i) * 64 + lane];
                    const float w = -__logf(1.f + __expf(-wpre)) - 0.5f;
                    const float ew = __expf(w);
                    const float a = sigmoidf_(apre);
                    float kk = ks[i] * kkc; const float n2 = wave_sum(kk * kk); kk = kk / fmaxf(sqrtf(n2), 1e-12f);
                    const float kd = ks[i] * (1.f + (a - 1.f) * kac);
                    const float Lprev = __expf(-lamr); lamr += ew; const float Lcur = __expf(-lamr), Linv = __expf(lamr);
                    LAS float* o = ring + (size_t)((((pb * 2 + dir) * CT) + sl) * 5) * 64;
                    o[0 * 64 + lane] = -kk * Lprev; o[1 * 64 + lane] = kk * a * Linv; o[2 * 64 + lane] = kd * Linv; o[3 * 64 + lane] = rs[i] * Lcur; o[4 * 64 + lane] = vs[i];
                }
                lam[((pb * 2 + dir) * 2 + sub) * 64 + lane] = __expf(-lamr);
                if (chunk + 1 < NCH) {
                    const int s1 = (chunk + 1) * CT + sub * 8; const int tl1 = dir ? SEQL - 8 - s1 : s1;
#pragma unroll
                    for (int q = 0; q < 10; ++q) { int tr = tl1 - 1 + q; tr = tr < 0 ? 0 : (tr >= SEQL ? SEQL - 1 : tr);
                        const bf16_t* pr = proj + ((size_t)b * SEQL + tr) * PS;
                        asm volatile("global_load_ushort %0, %1, off" : "+v"(pfd) : "v"(pr + P_R + c)); asm volatile("global_load_ushort %0, %1, off" : "+v"(pfd) : "v"(pr + P_K + c));
                        asm volatile("global_load_ushort %0, %1, off" : "+v"(pfd) : "v"(pr + P_V + c)); asm volatile("global_load_ushort %0, %1, off" : "+v"(pfd) : "v"(pr + P_RW + lcol)); }
                }
            }
            __syncthreads();
        }
        asm volatile("s_waitcnt vmcnt(0)" : "+v"(pfd) :: "memory");
    }
}


#define HG_ISSUE(BUF, bk) do { \
    DSR128(BUF[0], bk, 0); DSR128(BUF[1], bk, 16); DSR128(BUF[2], bk, 32); DSR128(BUF[3], bk, 48); DSR128(BUF[4], bk, 64); DSR128(BUF[5], bk, 80); DSR128(BUF[6], bk, 96); DSR128(BUF[7], bk, 112); \
    DSR128(BUF[8], bk, 256); DSR128(BUF[9], bk, 272); DSR128(BUF[10], bk, 288); DSR128(BUF[11], bk, 304); DSR128(BUF[12], bk, 320); DSR128(BUF[13], bk, 336); DSR128(BUF[14], bk, 352); DSR128(BUF[15], bk, 368); } while (0)
#define HG_COMPUTE(BUF) do { f32x4 oacc = (f32x4){0.f, 0.f, 0.f, 0.f}; \
    _Pragma("unroll") for (int i_ = 0; i_ < 8; ++i_) { f32x4 sv = S4[i_] + BUF[i_] * iv; S4[i_] = sv; oacc += sv * BUF[8 + i_]; } \
    oval = xsum32((oacc.x + oacc.y) + (oacc.z + oacc.w)); } while (0)

__device__ __forceinline__ void hgrn_scan_wg(const Params& p, int l, int grp, LAS unsigned char* lds) {
    const int tid = opaque_tid(), wave = tid >> 6, lane = tid & 63;
    constexpr int HTC = 16, NCH = SEQL / HTC;
    LAS float* ring = (LAS float*)lds;
    LAS float* lam = (LAS float*)(lds + 73728);
    LAS float* lbt = (LAS float*)(lds + 76800);
    bf16_t* proj = (bf16_t*)(p.ws + OFF_PROJ);
    for (int i = tid; i < 2 * RW; i += 512) { const int dr = i / RW, cc = i % RW; const float* lg = p.in[4] + (size_t)dr * 5 * RW + cc;
        float e[5], mx = -1e30f;
#pragma unroll
        for (int j = 0; j < 5; ++j) { e[j] = lg[j * RW]; mx = fmaxf(mx, e[j]); }
        float sum = 0.f, cum = 0.f;
#pragma unroll
        for (int j = 0; j < 5; ++j) { e[j] = __expf(e[j] - mx); sum += e[j]; if (j <= l) cum += e[j]; }
        lbt[i] = cum / sum; }
    __syncthreads();
    if (wave < 6) {
        const int j = wave >> 1, half = wave & 1, kp = lane >> 5, col = half * 32 + (lane & 31);
        const int cch = grp * 3 + j;
        const int cdir = cch & 1, cb = (cch >> 1) / 6, chh = (cch >> 1) % 6;
        bf16_t* orow = proj + (size_t)cb * SEQL * PS + (cdir ? P_FB : P_FF) + chh * 64 + col;
        f32x4 S4[8];
#pragma unroll
        for (int k = 0; k < 8; ++k) S4[k] = (f32x4){0.f, 0.f, 0.f, 0.f};
        f32x4 A[16], B[16]; float iv = 0.f, ivn = 0.f, oval = 0.f;
        const unsigned ring_addr = (unsigned)(unsigned long long)ring, lam_base = (unsigned)(unsigned long long)lam;
        __syncthreads();
        for (int chunk = 0; chunk < NCH; ++chunk) {
            const unsigned cbase = ring_addr + (unsigned)((((chunk & 1) * 3 + j) * HTC) * 768);
            const unsigned offk = cbase + kp * 128, offv = cbase + col * 4;
            const unsigned lam_addr = lam_base + (unsigned)((((chunk & 1) * 3 + j) * 2) * 256) + kp * 128;
            HG_ISSUE(A, offk); DSR32(ivn, offv, 512);
#pragma unroll 1
            for (int sub = 0; sub < 2; ++sub) {
#pragma unroll 1
                for (int it = 0; it < 4; ++it) {
                    const int sl = sub * 8 + it * 2;
                    const unsigned bk1 = offk + (sl + 1) * 768, bv1 = offv + (sl + 1) * 768, bk2 = bk1 + 768, bv2 = bv1 + 768;
                    const int s = chunk * HTC + sl;
                    LGKM0(); iv = ivn; HG_ISSUE(B, bk1); DSR32(ivn, bv1, 512); SCHEDB; HG_COMPUTE(A); SCHEDB;
                    if (kp == 0) { const int t = cdir ? SEQL - 1 - s : s; orow[(size_t)t * PS] = (bf16_t)f2bf(oval); }
                    LGKM0(); iv = ivn; HG_ISSUE(A, bk2); DSR32(ivn, bv2, 512); SCHEDB; HG_COMPUTE(B); SCHEDB;
                    if (kp == 0) { const int t = cdir ? SEQL - 2 - s : s + 1; orow[(size_t)t * PS] = (bf16_t)f2bf(oval); }
                }
                {   f32x4 L[8]; const unsigned la = lam_addr + sub * 256;
                    DSR128(L[0], la, 0); DSR128(L[1], la, 16); DSR128(L[2], la, 32); DSR128(L[3], la, 48); DSR128(L[4], la, 64); DSR128(L[5], la, 80); DSR128(L[6], la, 96); DSR128(L[7], la, 112);
                    LGKM0();
#pragma unroll
                    for (int i_ = 0; i_ < 8; ++i_) S4[i_] *= L[i_];
                    SCHEDB; }
            }
            LGKM0();
            __syncthreads();
        }
    } else {
        const int pw = wave - 6;
        unsigned pfd = 0u;
        for (int chunk = 0; chunk <= NCH; ++chunk) {
            if (chunk < NCH) {
                asm volatile("s_waitcnt vmcnt(0)" : "+v"(pfd) :: "memory");
                float qv[24], fv[24], ivv[24];
#pragma unroll
                for (int uu = 0; uu < 3; ++uu) {
                    const int u = pw * 3 + uu, j = u >> 1, hh = u & 1;
                    const int ch = grp * 3 + j, dir = ch & 1, b = (ch >> 1) / 6, h = (ch >> 1) % 6;
                    const bf16_t* prow = proj + (size_t)b * SEQL * PS + h * 64 + lane;
#pragma unroll
                    for (int i = 0; i < 8; ++i) {
                        const int s = chunk * HTC + hh * 8 + i, t = dir ? SEQL - 1 - s : s;
                        const bf16_t* pr = prow + (size_t)t * PS;
                        qv[uu * 8 + i] = bf2f(pr[P_Q]); fv[uu * 8 + i] = bf2f(pr[dir ? P_FB : P_FF]); ivv[uu * 8 + i] = bf2f(pr[P_I]);
                    }
                }
#pragma unroll
                for (int uu = 0; uu < 3; ++uu) {
                    const int u = pw * 3 + uu, j = u >> 1, hh = u & 1;
                    const int ch = grp * 3 + j, dir = ch & 1, h = (ch >> 1) % 6;
                    const float lb = lbt[dir * RW + h * 64 + lane];
                    float Lc = 1.f;
#pragma unroll
                    for (int i = 0; i < 8; ++i) {
                        const int sl = hh * 8 + i;
                        const float f = lb + (1.f - lb) * sigmoidf_(fv[uu * 8 + i]);
                        Lc *= f;
                        LAS float* o = ring + (size_t)(((((chunk & 1) * 3 + j) * HTC) + sl) * 3) * 64;
                        o[lane] = (1.f - f) / Lc; o[64 + lane] = qv[uu * 8 + i] * Lc; o[128 + lane] = ivv[uu * 8 + i];
                    }
                    lam[(((chunk & 1) * 3 + j) * 2 + hh) * 64 + lane] = Lc;
                }
                if (chunk + 1 < NCH) {
#pragma unroll
                    for (int uu = 0; uu < 3; ++uu) {
                        const int u = pw * 3 + uu, j = u >> 1, hh = u & 1;
                        const int ch = grp * 3 + j, dir = ch & 1, b = (ch >> 1) / 6, h = (ch >> 1) % 6;
                        const bf16_t* prow = proj + (size_t)b * SEQL * PS + h * 64 + lane;
#pragma unroll
                        for (int i = 0; i < 8; ++i) {
                            const int s = (chunk + 1) * HTC + hh * 8 + i, t = dir ? SEQL - 1 - s : s;
                            const bf16_t* pr = prow + (size_t)t * PS;
                            asm volatile("global_load_ushort %0, %1, off" : "+v"(pfd) : "v"(pr + P_Q)); asm volatile("global_load_ushort %0, %1, off" : "+v"(pfd) : "v"(pr + (dir ? P_FB : P_FF)));
                            asm volatile("global_load_ushort %0, %1, off" : "+v"(pfd) : "v"(pr + P_I));
                        }
                    }
                }
            }
            __syncthreads();
        }
        asm volatile("s_waitcnt vmcnt(0)" : "+v"(pfd) :: "memory");
    }
}

__device__ __forceinline__ void conv_wg(const Params& p, int l, int first, int stride, LAS unsigned char* lds) {
    const int tid = opaque_tid(), wave = tid >> 6, lane = tid & 63;
    LAS float* z = (LAS float*)lds;
    LAS float* ot = (LAS float*)(lds + 62 * 256 * 4);
    bf16_t* proj = (bf16_t*)(p.ws + OFF_PROJ);
    const int ch = tid & 255, half = tid >> 8;
    float w[31];
#pragma unroll
    for (int j = 0; j < 31; ++j) w[j] = p.in[18][(size_t)(l * 31 + j) * 256 + ch];
    const float cb = p.in[19][l * 256 + ch];
    const f32x4 lg = ((const f32x4*)(p.in[20] + l * 256))[lane], lbv = ((const f32x4*)(p.in[21] + l * 256))[lane];
    for (int tile = first; tile < MROWS / 32; tile += stride) {
        const int row0 = tile * 32, b = row0 / SEQL, t0 = row0 % SEQL;
        {
            float zv[31], zg[31];
#pragma unroll
            for (int i = 0; i < 31; ++i) { const int r = half + 2 * i, t = t0 - 15 + r; const bool ok = (t >= 0) && (t < SEQL);
                const bf16_t* pr = proj + ((size_t)b * SEQL + (ok ? t : 0)) * PS; zv[i] = ok ? bf2f(pr[P_CV + ch]) : 0.f; zg[i] = bf2f(pr[P_CG + ch]); }
#pragma unroll
            for (int i = 0; i < 31; ++i) z[(half + 2 * i) * 256 + ch] = zv[i] * sigmoidf_(zg[i]);
        }
        __syncthreads();
#pragma unroll 4
        for (int tt = 0; tt < 16; ++tt) { const int tok = half * 16 + tt; float acc = cb;
#pragma unroll
            for (int j = 0; j < 31; ++j) acc += w[j] * z[(tok + j) * 256 + ch];
            ot[tok * 256 + ch] = acc; }
        __syncthreads();
#pragma unroll
        for (int q = 0; q < 4; ++q) { const int tok = wave * 4 + q;
            f32x4 v = *(const LAS f32x4*)(ot + tok * 256 + lane * 4);
            const float mean = wave_sum((v.x + v.y) + (v.z + v.w)) * (1.f / 256.f);
            v = v - mean;
            const float var = wave_sum((v.x * v.x + v.y * v.y) + (v.z * v.z + v.w * v.w)) * (1.f / 256.f);
            const float rstd = rsqrtf(var + LN_EPS);
            f32x4 y = v * rstd * lg + lbv;
            y.x = y.x * sigmoidf_(y.x); y.y = y.y * sigmoidf_(y.y); y.z = y.z * sigmoidf_(y.z); y.w = y.w * sigmoidf_(y.w);
            u32x2 wv; wv.x = pk2(y.x, y.y); wv.y = pk2(y.z, y.w);
            *(u32x2*)(proj + (size_t)(row0 + tok) * PS + P_YC + lane * 4) = wv; }
        __syncthreads();
    }
}

__device__ __forceinline__ void combine_phase(const Params& p, int l, int widx, int nw, LAS unsigned char* lds) {
    const int tid = opaque_tid(), lane = tid & 63;
    bf16_t* proj = (bf16_t*)(p.ws + OFF_PROJ);
    const bf16_t* o_r = (const bf16_t*)(p.ws + OFF_T);
    LAS unsigned* WA = (LAS unsigned*)lds;
    LAS unsigned* WG = (LAS unsigned*)(lds + 49152);
    {
        const float* aup = p.in[11] + (size_t)(l * 2 * 32) * RW; const float* gup = p.in[12] + (size_t)(l * 64) * RW;
        for (int i = tid; i < 2 * 32 * 3 * 64; i += 512) { const int ln = i & 63, hp = (i >> 6) % 3, dr = i / 192; const float* s = aup + (size_t)dr * RW + (2 * hp) * 64 + ln; WA[i] = pk2(s[0], s[64]); }
        for (int i = tid; i < 64 * 3 * 64; i += 512) { const int ln = i & 63, hp = (i >> 6) % 3, r = i / 192; const float* s = gup + (size_t)r * RW + (2 * hp) * 64 + ln; WG[i] = pk2(s[0], s[64]); }
    }
    __syncthreads();
    const float* mu0 = p.in[7] + (size_t)(l * 2 + 0) * NRW; const float* mu1 = mu0 + NRW;
    const float mad0 = mu0[1216 + lane], mad1 = mu1[1216 + lane], mgd0 = mu0[1280 + lane], mgd1 = mu1[1280 + lane];
    for (int g4 = widx; g4 < MROWS / 2; g4 += nw) {
        const int row0 = g4 * 2;
        float adv[2], sgv[2];
#pragma unroll
        for (int tt = 0; tt < 2; ++tt) { const int row = row0 + tt, t = row % SEQL; const bf16_t* pr = proj + (size_t)row * PS;
            const bool hp = t > 0, hn = t < SEQL - 1; const bf16_t* pp = hp ? pr - PS : pr; const bf16_t* pn = hn ? pr + PS : pr; const float fp = hp ? 1.f : 0.f, fn = hn ? 1.f : 0.f;
            const float ac = bf2f(pr[P_AD + lane]), ap = fp * bf2f(pp[P_AD + lane]), an = fn * bf2f(pn[P_AD + lane]);
            const float gc = bf2f(pr[P_GD + lane]), gp = fp * bf2f(pp[P_GD + lane]), gn = fn * bf2f(pn[P_GD + lane]);
            adv[tt] = ac + mad0 * (ap - ac) + mad1 * (an - ac);
            sgv[tt] = sigmoidf_(gc + mgd0 * (gp - gc) + mgd1 * (gn - gc)); }
        float A0[2][6], A1[2][6], G[2][6];
#pragma unroll
        for (int tt = 0; tt < 2; ++tt)
#pragma unroll
            for (int h = 0; h < 6; ++h) { A0[tt][h] = 0.f; A1[tt][h] = 0.f; G[tt][h] = 0.f; }
#pragma unroll 4
        for (int r = 0; r < 32; ++r) {
            float w0[6], w1[6];
#pragma unroll
            for (int hp = 0; hp < 3; ++hp) { const unsigned u0 = WA[(r * 3 + hp) * 64 + lane], u1 = WA[((32 + r) * 3 + hp) * 64 + lane];
                w0[2 * hp] = __uint_as_float(u0 << 16); w0[2 * hp + 1] = __uint_as_float(u0 & 0xffff0000u); w1[2 * hp] = __uint_as_float(u1 << 16); w1[2 * hp + 1] = __uint_as_float(u1 & 0xffff0000u); }
#pragma unroll
            for (int tt = 0; tt < 2; ++tt) { const float s0 = rdlane(adv[tt], r), s1 = rdlane(adv[tt], 32 + r);
#pragma unroll
                for (int h = 0; h < 6; ++h) { A0[tt][h] += s0 * w0[h]; A1[tt][h] += s1 * w1[h]; } }
        }
#pragma unroll 4
        for (int r = 0; r < 64; ++r) {
            float wg[6];
#pragma unroll
            for (int hp = 0; hp < 3; ++hp) { const unsigned u = WG[(r * 3 + hp) * 64 + lane]; wg[2 * hp] = __uint_as_float(u << 16); wg[2 * hp + 1] = __uint_as_float(u & 0xffff0000u); }
#pragma unroll
            for (int tt = 0; tt < 2; ++tt) { const float s = rdlane(sgv[tt], r);
#pragma unroll
                for (int h = 0; h < 6; ++h) G[tt][h] += s * wg[h]; }
        }
#pragma unroll
        for (int h = 0; h < 6; ++h) {
            const int c = h * 64 + lane;
            const float a00 = p.in[10][(l * 2 + 0) * RW + c], a01 = p.in[10][(l * 2 + 1) * RW + c], kac = p.in[14][l * RW + c];
            const float rk = p.in[15][(l * 6 + h) * 64 + lane], gng = p.in[16][l * RW + c], gnb = p.in[17][l * RW + c], ng = p.in[6][l * RW + c];
            const float mr0 = mu0[c], mr1 = mu1[c], mk0 = mu0[384 + c], mk1 = mu1[384 + c], mv0 = mu0[768 + c], mv1 = mu1[768 + c];
#pragma unroll
            for (int tt = 0; tt < 2; ++tt) { const int row = row0 + tt, t = row % SEQL; bf16_t* pr = proj + (size_t)row * PS;
                const bool hp = t > 0, hn = t < SEQL - 1; const bf16_t* pp = hp ? pr - PS : pr; const bf16_t* pn = hn ? pr + PS : pr; const float fp = hp ? 1.f : 0.f, fn = hn ? 1.f : 0.f;
                const float rc = bf2f(pr[P_R + c]), rp = fp * bf2f(pp[P_R + c]), rn = fn * bf2f(pn[P_R + c]);
                const float kc = bf2f(pr[P_K + c]), kp = fp * bf2f(pp[P_K + c]), kn = fn * bf2f(pn[P_K + c]);
                const float vc = bf2f(pr[P_V + c]), vp = fp * bf2f(pp[P_V + c]), vn = fn * bf2f(pn[P_V + c]);
                const float rs = rc + mr0 * (rp - rc) + mr1 * (rn - rc);
                const float ks = kc + mk0 * (kp - kc) + mk1 * (kn - kc);
                const float vs = vc + mv0 * (vp - vc) + mv1 * (vn - vc);
                const float a0 = sigmoidf_(a00 + A0[tt][h]), a1 = sigmoidf_(a01 + A1[tt][h]);
                const float kh = ks * (1.f + (0.5f * (a0 + a1) - 1.f) * kac);
                const float bsum = wave_sum(rs * kh * rk);
                const float o = bf2f(o_r[(size_t)row * RW + c]) + bf2f(o_r[((size_t)MROWS + row) * RW + c]);
                const float mean = wave_sum(o) * (1.f / 64.f); const float dlt = o - mean;
                const float var = wave_sum(dlt * dlt) * (1.f / 64.f);
                const float on = dlt * rsqrtf(var + GN_EPS) * gng + gnb;
                const float yr = (on + bsum * vs) * G[tt][h];
                const float oh = bf2f(pr[P_FF + c]) + bf2f(pr[P_FB + c]);
                const float ms = wave_sum(oh * oh) * (1.f / 64.f);
                const float gh = bf2f(pr[P_G + c]);
                const float yh = oh * rsqrtf(ms + RMS_EPS) * ng * (gh * sigmoidf_(gh));
                pr[P_I + c] = (bf16_t)f2bf(yr);
                pr[P_Q + c] = (bf16_t)f2bf(yh);
            }
        }
    }
}

__global__ void __launch_bounds__(512, 2) fwd_mega(Params p) {
    extern __shared__ __attribute__((aligned(16))) unsigned char smem_raw[];
    LAS unsigned char* lds = (LAS unsigned char*)smem_raw;
    cg::grid_group grid = cg::this_grid();
    const int tid = threadIdx.x, wave = tid >> 6, lane = tid & 63;
    const int G = gridDim.x, bid = blockIdx.x;
    const int widx = bid * 8 + wave, nw = G * 8;
    bf16_t* win_t = (bf16_t*)(p.ws + OFF_WIN); bf16_t* wout_t = (bf16_t*)(p.ws + OFF_WOUT); bf16_t* wup_t = (bf16_t*)(p.ws + OFF_WUP); bf16_t* wdn_t = (bf16_t*)(p.ws + OFF_WDN);
    bf16_t* proj = (bf16_t*)(p.ws + OFF_PROJ); bf16_t* xb = (bf16_t*)(p.ws + OFF_T); bf16_t* hid = proj;
    float* x = p.out;
    volatile LAS unsigned* xst = (volatile LAS unsigned*)(lds + 131072);
    if (tid == 0) { xst[0] = 0u; xst[1] = 0u; xst[2] = 0u; xst[3] = 0u; }
    __syncthreads();
    XcdBarrier xbar = xcd_barrier_post((unsigned*)(p.ws + OFF_BAR), xst);

    convert_weights(p, 0, lds, widx, nw);
    for (int row = widx; row < MROWS; row += nw) {
        const float* src = row < 16 * SEQL ? p.in[0] + (size_t)row * D : p.in[1] + (size_t)(row - 16 * SEQL) * D;
        ln_row(src, x + (size_t)row * D, xb + (size_t)row * D, p.in[2], p.in[3], lane);
    }
    grid.sync();
    for (int l = 0; l < DEPTH; ++l) {
        {
            pg8::Gemm g{xb, win_t, MROWS, NINP, D, D}; pg8::StaticOrder S; S.init(MROWS, NINP, G, bid);
            pg8::EpiBf16<0> E{proj + 256, PS};
            for (int rep = 0; rep < REP_GIN; ++rep) pg8::gemm_phase(lds, g, S, E);
        }
        GSYNC();
        for (int rep = 0; rep < REP_SCAN; ++rep) {
            if (bid < 144) rwkv_scan_wg(p, l, bid, lds);
            else if (bid < 240) { if (rep == 0) hgrn_scan_wg(p, l, bid - 144, lds); }
            else { }
        }
        GSYNC();
        conv_wg(p, l, bid, G, lds);
        for (int rep = 0; rep < REP_COMB; ++rep) combine_phase(p, l, widx, nw, lds);
        GSYNC();
        {
            pg8::Gemm g{proj, wout_t, MROWS, D, D, PS}; pg8::StaticOrder S; S.init(MROWS, D, G, bid);
            pg8::EpiResid E{x, D, DN_ALPHA};
            pg8::gemm_phase(lds, g, S, E);
        }
        GSYNC();
        for (int row = widx; row < MROWS; row += 2 * nw) {
            const int r1 = row + nw;
            if (r1 < MROWS) ln_row2(x + (size_t)row * D, x + (size_t)r1 * D, x + (size_t)row * D, x + (size_t)r1 * D, xb + (size_t)row * D, xb + (size_t)r1 * D, p.in[23] + l * D, p.in[24] + l * D, lane);
            else ln_row(x + (size_t)row * D, x + (size_t)row * D, xb + (size_t)row * D, p.in[23] + l * D, p.in[24] + l * D, lane); }
        GSYNC();
        for (int third = 0; third < 3; ++third) {
            constexpr int MT = MROWS / 3;
            {   pg8::Gemm g{xb + (size_t)third * MT * D, wup_t, MT, FFN, D, D}; pg8::StaticOrder S; S.init(MT, FFN, G, bid);
                pg8::EpiBf16<1> E{hid, FFN};
                for (int rep = 0; rep < REP_UP; ++rep) pg8::gemm_phase(lds, g, S, E); }
            GSYNC();
            {   pg8::Gemm g{hid, wdn_t, MT, D, FFN, FFN}; pg8::StaticOrder S; S.init(MT, D, G, bid);
                pg8::EpiResid E{x + (size_t)third * MT * D, D, DN_ALPHA};
                pg8::gemm_phase(lds, g, S, E); }
            GSYNC();
        }
        if (l + 1 < DEPTH) convert_weights(p, l + 1, lds, widx, nw);
        for (int row = widx; row < MROWS; row += 2 * nw) {
            const int r1 = row + nw;
            if (r1 < MROWS) ln_row2(x + (size_t)row * D, x + (size_t)r1 * D, x + (size_t)row * D, x + (size_t)r1 * D, xb + (size_t)row * D, xb + (size_t)r1 * D, p.in[27] + l * D, p.in[28] + l * D, lane);
            else ln_row(x + (size_t)row * D, x + (size_t)row * D, xb + (size_t)row * D, p.in[27] + l * D, p.in[28] + l * D, lane); }
        GSYNC();
    }
}

extern "C" void kernel_launch(void* const* d_in, const int* in_sizes, int n_in, void* d_out, int out_size, void* d_ws, size_t ws_size, hipStream_t stream) {
    static int grid = 0;
    if (grid == 0) {
        if (n_in != 29 || out_size != MROWS * D || ws_size < WS_END) { fprintf(stderr, "kernel_launch: unexpected shapes (n_in %d out %d ws %zu need %zu)\n", n_in, out_size, ws_size, (size_t)WS_END); grid = -1; return; }
        int dev = 0, cus = 0, per_cu = 0;
        hipGetDevice(&dev);
        hipDeviceGetAttribute(&cus, hipDeviceAttributeMultiprocessorCount, dev);
        if (hipFuncSetAttribute((const void*)fwd_mega, hipFuncAttributeMaxDynamicSharedMemorySize, LDS_BYTES) != hipSuccess) { fprintf(stderr, "kernel_launch: hipFuncSetAttribute failed\n"); grid = -1; return; }
        hipOccupancyMaxActiveBlocksPerMultiprocessor(&per_cu, (const void*)fwd_mega, 512, LDS_BYTES);
        (void)hipGetLastError();
        if (per_cu < 1) per_cu = 1;
        grid = cus;
        if (grid != 256) fprintf(stderr, "kernel_launch: note: %d CUs\n", grid);
    }
    if (grid < 0) return;
    if (hipMemsetAsync((char*)d_ws + OFF_BAR, 0, SZ_BAR, stream) != hipSuccess) { fprintf(stderr, "kernel_launch: memset failed\n"); return; }
    Params p{};
    for (int i = 0; i < 29; ++i) p.in[i] = (const float*)d_in[i];
    p.out = (float*)d_out; p.ws = (unsigned char*)d_ws;
    void* args[] = {&p};
    hipError_t e = hipLaunchCooperativeKernel((const void*)fwd_mega, dim3(grid), dim3(512), args, LDS_BYTES, stream);
    if (e != hipSuccess) fprintf(stderr, "cooperative launch failed: %s (grid %d)\n", hipGetErrorString(e), grid);
}
```

```cpp
#include <hip/hip_runtime.h>
#include <hip/hip_cooperative_groups.h>
#include <cstdio>
#include <cstdint>
namespace cg = cooperative_groups;

#define LAS __attribute__((address_space(3)))
typedef unsigned short bf16_t;
typedef short bf16x8 __attribute__((ext_vector_type(8)));
typedef float f32x4 __attribute__((ext_vector_type(4)));
typedef unsigned u32x4 __attribute__((ext_vector_type(4)));
typedef unsigned u32x2 __attribute__((ext_vector_type(2)));

constexpr int D = 1024, SEQL = 2048, NSEQ = 24, MROWS = NSEQ * SEQL, DEPTH = 4, FFN = 4096;
constexpr int NIN = 3776, NINP = 3840, PS = 4096;
constexpr int RW = 384, NRW = 1344;
constexpr int P_YC = 0, P_Q = 256, P_I = 640, P_FF = 1024, P_FB = 1408, P_G = 1792;
constexpr int P_RW = 2176, P_R = P_RW, P_K = P_RW + 384, P_V = P_RW + 768, P_WD = P_RW + 1152, P_AD = P_RW + 1216, P_GD = P_RW + 1280;
constexpr int P_CV = 3520, P_CG = 3776;
constexpr float LN_EPS = 1e-5f, RMS_EPS = 1e-6f, GN_EPS = 64e-5f;
constexpr float DN_ALPHA = 1.681792830507429f;

constexpr size_t OFF_WIN = 0, SZ_WIN = (size_t)NINP * D * 2;
constexpr size_t OFF_WOUT = OFF_WIN + SZ_WIN, SZ_WOUT = (size_t)D * D * 2;
constexpr size_t OFF_WUP = OFF_WOUT + SZ_WOUT, SZ_WUP = (size_t)FFN * D * 2;
constexpr size_t OFF_WDN = OFF_WUP + SZ_WUP, SZ_WDN = (size_t)FFN * D * 2;
constexpr size_t OFF_PROJ = OFF_WDN + SZ_WDN, SZ_PROJ = (size_t)MROWS * PS * 2;
constexpr size_t OFF_T = OFF_PROJ + SZ_PROJ, SZ_T = (size_t)MROWS * D * 2;
constexpr size_t OFF_BAR = OFF_T + SZ_T, SZ_BAR = 3456 * 4;
constexpr size_t WS_END = OFF_BAR + SZ_BAR;
constexpr int LDS_BYTES = 131072 + 16;
#define REP_SCAN 1
#define REP_COMB 1
#define REP_GIN 1
#define REP_UP 1
#define REP_SYNC 1
#define GSYNC() do { for (int r_ = 0; r_ < REP_SYNC; ++r_) xcd_barrier(xbar); } while (0)

struct Params {
    const float* in[29];
    float* out;
    unsigned char* ws;
};

__device__ __forceinline__ float bf2f(bf16_t b) { return __uint_as_float(((unsigned)b) << 16); }
__device__ __forceinline__ unsigned f2bf(float f) { unsigned u = __float_as_uint(f); u += 0x7FFFu + ((u >> 16) & 1u); return u >> 16; }
__device__ __forceinline__ unsigned pk2(float lo, float hi) { return f2bf(lo) | (f2bf(hi) << 16); }
__device__ __forceinline__ float dpp_add(float v, const int ctrl_sel) {
    int r;
    switch (ctrl_sel) {
        case 0: r = __builtin_amdgcn_update_dpp(0, __float_as_int(v), 0xB1, 0xF, 0xF, true); break;
        case 1: r = __builtin_amdgcn_update_dpp(0, __float_as_int(v), 0x4E, 0xF, 0xF, true); break;
        case 2: r = __builtin_amdgcn_update_dpp(0, __float_as_int(v), 0x141, 0xF, 0xF, true); break;
        default: r = __builtin_amdgcn_update_dpp(0, __float_as_int(v), 0x140, 0xF, 0xF, true); break;
    }
    return v + __int_as_float(r);
}
__device__ __forceinline__ float wave_sum(float v) {
    v = dpp_add(v, 0); v = dpp_add(v, 1); v = dpp_add(v, 2); v = dpp_add(v, 3);
    { auto r = __builtin_amdgcn_permlane16_swap(__float_as_uint(v), __float_as_uint(v), false, false); v = __uint_as_float(r[0]) + __uint_as_float(r[1]); }
    { auto r = __builtin_amdgcn_permlane32_swap(__float_as_uint(v), __float_as_uint(v), false, false); v = __uint_as_float(r[0]) + __uint_as_float(r[1]); }
    return v;
}
__device__ __forceinline__ int opaque_tid() { int t = threadIdx.x; asm volatile("" : "+v"(t)); return t; }
__device__ __forceinline__ float sigmoidf_(float x) { return 1.0f / (1.0f + __expf(-x)); }
__device__ __forceinline__ float rdlane(float v, int l) { return __int_as_float(__builtin_amdgcn_readlane(__float_as_int(v), l)); }

#define XB_TMO      128
#define XB_XCNT(j)  (256  + 64 * (j))
#define XB_XSUB(j)  (1280 + 64 * (j))
#define XB_XGEN(j)  (2304 + 64 * (j))
#define XB_TOP      3328
#define XB_TOPGEN   3392
#define XCD_BAR_WORDS 3456
#define XB_SPIN_CAP (1u << 22)
__device__ __forceinline__ unsigned xb_ld(unsigned* p)              { return __hip_atomic_load(p, __ATOMIC_RELAXED, __HIP_MEMORY_SCOPE_AGENT); }
__device__ __forceinline__ unsigned xb_add(unsigned* p, unsigned v) { return __hip_atomic_fetch_add(p, v, __ATOMIC_RELAXED, __HIP_MEMORY_SCOPE_AGENT); }
__device__ __forceinline__ unsigned xb_xcc_id() { return (unsigned)__builtin_amdgcn_s_getreg((3 << 11) | 20) & 0xFu; }
#define XB_SPIN(cond, bar) do { unsigned _sp = 0; while (cond) { __builtin_amdgcn_s_sleep(1); \
    if ((++_sp & 255u) == 0u) { if (xb_ld(&(bar)[XB_TMO])) break; if (_sp > XB_SPIN_CAP) { atomicAdd(&(bar)[XB_TMO], 1u); break; } } } } while (0)
struct XcdBarrier { unsigned* bar; unsigned x; volatile LAS unsigned* st; };
__device__ __forceinline__ XcdBarrier xcd_barrier_post(unsigned* bar, volatile LAS unsigned* st) {
    XcdBarrier b; b.bar = bar; b.x = xb_xcc_id(); b.st = st;
    if (threadIdx.x == 0) (void)xb_add(&bar[XB_XCNT(b.x)], 1u);
    return b;
}
__device__ __forceinline__ void xcd_barrier_complete(unsigned* bar, unsigned x, unsigned& nloc, unsigned& nx) {
    const unsigned G = gridDim.x * gridDim.y * gridDim.z;
    unsigned sum, cnt, mine, sp = 0u;
    for (;;) {
        sum = 0u; cnt = 0u; mine = 0u;
#pragma unroll
        for (unsigned j = 0; j < 16; ++j) { const unsigned c = xb_ld(&bar[XB_XCNT(j)]); sum += c; cnt += (c > 0u) ? 1u : 0u; mine = (j == x) ? c : mine; }
        if (sum == G) break;
        __builtin_amdgcn_s_sleep(1);
        if ((++sp & 255u) == 0u) { if (xb_ld(&bar[XB_TMO])) break; if (sp > XB_SPIN_CAP) { atomicAdd(&bar[XB_TMO], 1u); break; } }
    }
    nloc = mine > 0u ? mine : 1u; nx = cnt > 0u ? cnt : 1u;
}
__device__ __forceinline__ void xcd_barrier(const XcdBarrier& b) {
    asm volatile("s_waitcnt vmcnt(0)" ::: "memory");
    __syncthreads();
    if (threadIdx.x == 0) {
        unsigned* bar = b.bar;
        __builtin_amdgcn_s_waitcnt(0);
        unsigned nloc = b.st[0], nx = b.st[1];
        if (nloc == 0u) { xcd_barrier_complete(bar, b.x, nloc, nx); b.st[0] = nloc; b.st[1] = nx; }
        const unsigned old = xb_add(&bar[XB_XSUB(b.x)], 1u);
        const unsigned gen = old / nloc;
        if (old + 1u == (gen + 1u) * nloc) {
            __builtin_amdgcn_fence(__ATOMIC_RELEASE, "agent");
            asm volatile("s_waitcnt vmcnt(0)" ::: "memory");
            const unsigned og = xb_add(&bar[XB_TOP], 1u);
            const unsigned tg = og / nx;
            if (og + 1u == (tg + 1u) * nx) xb_add(&bar[XB_TOPGEN], 1u);
            else XB_SPIN(xb_ld(&bar[XB_TOPGEN]) == tg, bar);
            __builtin_amdgcn_fence(__ATOMIC_ACQUIRE, "agent");
            xb_add(&bar[XB_XGEN(b.x)], 1u);
            asm volatile("s_waitcnt vmcnt(0)" ::: "memory");
        } else {
            XB_SPIN(xb_ld(&bar[XB_XGEN(b.x)]) == gen, bar);
            __builtin_amdgcn_fence(__ATOMIC_ACQUIRE, "agent");
            asm volatile("s_waitcnt vmcnt(0)" ::: "memory");
        }
    }
    __syncthreads();
}

namespace pg8 {
constexpr int BM = 256, BK = 64, HALF = 128, HTB = HALF * BK * 2, STAGE_BYTES = 8 * HTB, NXCD = 8, WGM = 8;
__device__ __forceinline__ int lds_byte(int r, int c) { const int st = (r >> 4) * 2 + (c >> 5), rr = r & 15, cc = c & 31, ob = rr * 64 + cc * 2; return st * 1024 + (ob ^ (((ob >> 9) & 1) << 5)); }
__device__ __forceinline__ void stage_rc(int b, int& R, int& C) { const int st = b / 1024, sb = b % 1024, swz = sb ^ (((sb >> 9) & 1) << 5); R = (st >> 1) * 16 + swz / 64; C = (st & 1) * 32 + (swz % 64) / 2; }
__device__ __forceinline__ int perm32(int rho) { const int n = rho >> 4, i = rho & 15; return 8 * (i >> 2) + 4 * n + (i & 3); }
struct Unit { int pm, pn; };
struct Gemm { const bf16_t* A; const bf16_t* Bt; int M, N, K, lda; };
struct StaticOrder {
    int nM, nN, nwg, G, c;
    __device__ void init(int M, int N, int G_, int c_) { nM = M / BM; nN = N / BM; nwg = nM * nN; G = G_; c = c_; }
    __device__ bool next(int i, Unit& u) const {
        const long L = (long)i * G + c; if (L >= nwg) return false;
        int wgid = (int)L; { const int q = nwg / NXCD, r = nwg % NXCD, xcd = wgid % NXCD, off = wgid / NXCD; wgid = (xcd < r ? xcd * (q + 1) : r * (q + 1) + (xcd - r) * q) + off; }
        const int nig = WGM * nN, gid = wgid / nig, fm = gid * WGM, gsz = (nM - fm) < WGM ? (nM - fm) : WGM;
        u.pm = fm + ((wgid % nig) % gsz); u.pn = (wgid % nig) / gsz; return true;
    }
};
__device__ __forceinline__ unsigned cvt_pk_bf16(float lo, float hi) { unsigned r; asm volatile("v_cvt_pk_bf16_f32 %0, %1, %2" : "=v"(r) : "v"(lo), "v"(hi)); return r; }

template <int ACT  > struct EpiBf16 {
    static constexpr bool PERM = true;
    bf16_t* O; int ldc;
    __device__ __forceinline__ void operator()(const f32x4 (&acc)[2][2][4][2], const Unit& u, int wr, int wc, int fr, int fq) const {
        const int row0 = u.pm * BM + wr * 64 + fr; const int col0 = u.pn * BM + wc * 32 + 8 * fq;
#pragma unroll
        for (int ai = 0; ai < 2; ++ai)
#pragma unroll
            for (int m = 0; m < 4; ++m) { bf16_t* rowp = O + (size_t)(row0 + ai * HALF + m * 16) * ldc + col0;
#pragma unroll
                for (int bj = 0; bj < 2; ++bj) { f32x4 v0 = acc[ai][bj][m][0], v1 = acc[ai][bj][m][1];
                    if (ACT == 1) {
#pragma unroll
                        for (int j = 0; j < 4; ++j) { float a = fmaxf(v0[j], 0.f), b = fmaxf(v1[j], 0.f); v0[j] = a * a; v1[j] = b * b; } }
                    u32x4 w; w.x = cvt_pk_bf16(v0[0], v0[1]); w.y = cvt_pk_bf16(v0[2], v0[3]); w.z = cvt_pk_bf16(v1[0], v1[1]); w.w = cvt_pk_bf16(v1[2], v1[3]);
                    *(u32x4*)(rowp + bj * HALF) = w; } }
    }
};
struct EpiResid {
    static constexpr bool PERM = false;
    float* C; int ldc; float alpha;
    __device__ __forceinline__ void operator()(const f32x4 (&acc)[2][2][4][2], const Unit& u, int wr, int wc, int fr, int fq) const {
        const int row0 = u.pm * BM + wr * 64 + fr, col0 = u.pn * BM + wc * 32 + 4 * fq;
#pragma unroll
        for (int ai = 0; ai < 2; ++ai)
#pragma unroll
            for (int m = 0; m < 4; ++m) { float* rowp = C + (size_t)(row0 + ai * HALF + m * 16) * ldc + col0;
                f32x4 old[2][2];
#pragma unroll
                for (int bj = 0; bj < 2; ++bj)
#pragma unroll
                    for (int n = 0; n < 2; ++n) old[bj][n] = *(const f32x4*)(rowp + bj * HALF + n * 16);
#pragma unroll
                for (int bj = 0; bj < 2; ++bj)
#pragma unroll
                    for (int n = 0; n < 2; ++n) *(f32x4*)(rowp + bj * HALF + n * 16) = old[bj][n] * alpha + acc[ai][bj][m][n]; }
    }
};

template <class Epi, class Sched>
__device__ __forceinline__ void gemm_phase(LAS unsigned char* lds, const Gemm g, const Sched& S, const Epi& E) {
    const int tid = opaque_tid(), wid = __builtin_amdgcn_readfirstlane(tid >> 6), lane = tid & 63, wr = wid >> 2, wc = wid & 3, fr = lane & 15, fq = lane >> 4;
    const int K = g.K, nt = K / BK, lda = g.lda;
    unsigned voffA[2], voffB[2];
#pragma unroll
    for (int i = 0; i < 2; ++i) { int R, C; stage_rc(tid * 16 + i * 8192, R, C); const int Rb = Epi::PERM ? ((R & ~31) + perm32(R & 31)) : R;
        voffA[i] = (unsigned)(R * lda + C) * 2u; voffB[i] = (unsigned)(Rb * K + C) * 2u; }
    const size_t kstep = (size_t)(BK * 2);
    const size_t hstepA = (size_t)HALF * lda * 2, hstepB = (size_t)HALF * K * 2;
    const size_t tstepA = 2 * hstepA, tstepB = 2 * hstepB;
    const unsigned ldsw = (unsigned)wid * 1024u;
    const int aoff = lds_byte(wr * 64 + fr, fq * 8), boff = lds_byte(wc * 32 + fr, fq * 8);
#define PG8_SA(b, h) (((b) * 2 + (h)) * HTB)
#define PG8_SB(b, h) ((4 + (b) * 2 + (h)) * HTB)
#define PG8_STAGE(bufoff, gbase, voff) do { _Pragma("unroll") for (int _i = 0; _i < 2; ++_i) \
        __builtin_amdgcn_global_load_lds((const unsigned*)((const char*)(gbase) + (voff)[_i]), (LAS unsigned*)(lds + (bufoff) + ldsw + _i * 8192), 16, 0, 0); } while (0)
#define PG8_LDA(dst, b, h) do { _Pragma("unroll") for (int m = 0; m < 4; ++m) _Pragma("unroll") for (int k = 0; k < 2; ++k) dst[m][k] = *(const LAS bf16x8*)(lds + PG8_SA(b, h) + aoff + m * 2048 + k * 1024); } while (0)
#define PG8_LDB(dst, b, h) do { _Pragma("unroll") for (int n = 0; n < 2; ++n) _Pragma("unroll") for (int k = 0; k < 2; ++k) dst[n][k] = *(const LAS bf16x8*)(lds + PG8_SB(b, h) + boff + n * 2048 + k * 1024); } while (0)
#define PG8_MMA(ai, bj, At, Bt) do { __builtin_amdgcn_s_setprio(1); _Pragma("unroll") for (int m = 0; m < 4; ++m) _Pragma("unroll") for (int n = 0; n < 2; ++n) _Pragma("unroll") for (int k = 0; k < 2; ++k) \
        acc[ai][bj][m][n] = __builtin_amdgcn_mfma_f32_16x16x32_bf16(Bt[n][k], At[m][k], acc[ai][bj][m][n], 0, 0, 0); __builtin_amdgcn_s_setprio(0); } while (0)
#define PG8_WAIT_V(n) asm volatile("s_waitcnt vmcnt(" #n ")" ::: "memory")
#define PG8_WAIT_L(n) asm volatile("s_waitcnt lgkmcnt(" #n ")" ::: "memory")
#define PG8_BAR __builtin_amdgcn_s_barrier()
#define PG8_SCHED __builtin_amdgcn_sched_barrier(0)
    Unit cur, nxt; int ui = 0;
    if (!S.next(0, cur)) return;
    f32x4 acc[2][2][4][2];
#pragma unroll
    for (int a = 0; a < 2; ++a)
#pragma unroll
        for (int b = 0; b < 2; ++b)
#pragma unroll
            for (int m = 0; m < 4; ++m)
#pragma unroll
                for (int n = 0; n < 2; ++n) acc[a][b][m][n] = (f32x4){0.f, 0.f, 0.f, 0.f};
    bf16x8 At[4][2], B0[2][2], B1[2][2];
    const char* cA = (const char*)g.A + (size_t)cur.pm * tstepA; const char* cB = (const char*)g.Bt + (size_t)cur.pn * tstepB;
    PG8_STAGE(PG8_SB(0, 0), cB, voffB); PG8_STAGE(PG8_SB(0, 1), cB + hstepB, voffB); PG8_STAGE(PG8_SA(0, 0), cA, voffA); PG8_STAGE(PG8_SA(0, 1), cA + hstepA, voffA);
    if (wr == 1) PG8_BAR;
    PG8_WAIT_V(2); PG8_BAR;
    PG8_STAGE(PG8_SB(1, 0), cB + kstep, voffB); PG8_STAGE(PG8_SA(1, 0), cA + kstep, voffA); PG8_STAGE(PG8_SB(1, 1), cB + hstepB + kstep, voffB);
    PG8_WAIT_V(6); PG8_BAR;
    for (;;) {
        const bool has_next = S.next(ui + 1, nxt);
        const char* nA = has_next ? (const char*)g.A + (size_t)nxt.pm * tstepA : cA; const char* nB = has_next ? (const char*)g.Bt + (size_t)nxt.pn * tstepB : cB;
        for (int t = 0; t < nt; t += 2) {
            const bool last = (t == nt - 2);
            const char* a1 = cA + (size_t)(t + 1) * kstep;
            const char* a2 = last ? nA : cA + (size_t)(t + 2) * kstep; const char* b2 = last ? nB : cB + (size_t)(t + 2) * kstep;
            const char* a3 = a2 + kstep; const char* b3 = b2 + kstep;
            PG8_LDB(B0, 0, 0); PG8_LDB(B1, 0, 1); PG8_SCHED; PG8_LDA(At, 0, 0); PG8_STAGE(PG8_SA(1, 1), a1 + hstepA, voffA);
            PG8_WAIT_V(8); PG8_WAIT_L(0); PG8_BAR; PG8_MMA(0, 0, At, B0); PG8_MMA(0, 1, At, B1); PG8_BAR; PG8_SCHED;
            PG8_LDA(At, 0, 1); PG8_STAGE(PG8_SB(0, 0), b2, voffB); PG8_STAGE(PG8_SB(0, 1), b2 + hstepB, voffB); PG8_STAGE(PG8_SA(0, 0), a2, voffA);
            PG8_WAIT_V(8); PG8_WAIT_L(0); PG8_BAR; PG8_MMA(1, 0, At, B0); PG8_MMA(1, 1, At, B1); PG8_BAR; PG8_SCHED;
            PG8_LDB(B0, 1, 0); PG8_LDB(B1, 1, 1); PG8_SCHED; PG8_LDA(At, 1, 0); PG8_STAGE(PG8_SA(0, 1), a2 + hstepA, voffA);
            PG8_WAIT_V(8); PG8_WAIT_L(0); PG8_BAR; PG8_MMA(0, 0, At, B0); PG8_MMA(0, 1, At, B1); PG8_BAR; PG8_SCHED;
            PG8_LDA(At, 1, 1); PG8_STAGE(PG8_SB(1, 0), b3, voffB); PG8_STAGE(PG8_SB(1, 1), b3 + hstepB, voffB); PG8_STAGE(PG8_SA(1, 0), a3, voffA);
            PG8_WAIT_V(8); PG8_WAIT_L(0); PG8_BAR; PG8_MMA(1, 0, At, B0); PG8_MMA(1, 1, At, B1); PG8_BAR; PG8_SCHED;
        }
        if (wr == 0) PG8_BAR;
        E(acc, cur, wr, wc, fr, fq);
        if (!has_next) break;
#pragma unroll
        for (int a = 0; a < 2; ++a)
#pragma unroll
            for (int b = 0; b < 2; ++b)
#pragma unroll
                for (int m = 0; m < 4; ++m)
#pragma unroll
                    for (int n = 0; n < 2; ++n) acc[a][b][m][n] = (f32x4){0.f, 0.f, 0.f, 0.f};
        cur = nxt; cA = nA; cB = nB; ++ui;
        if (wr == 1) PG8_BAR;
    }
    PG8_WAIT_V(0);
    PG8_BAR;
#undef PG8_SA
#undef PG8_SB
#undef PG8_STAGE
#undef PG8_LDA
#undef PG8_LDB
#undef PG8_MMA
#undef PG8_WAIT_V
#undef PG8_WAIT_L
#undef PG8_BAR
#undef PG8_SCHED
}
}

__device__ __forceinline__ void transpose_item(const float* W, int Nsrc, int ksrc0, int nsrc0, bf16_t* WT, int K, int k0, int n0, LAS float* scr, int lane) {
#pragma unroll 8
    for (int i = 0; i < 32; ++i) { const int kk = 2 * i + (lane >> 5);
        scr[kk * 33 + (lane & 31)] = nsrc0 >= 0 ? W[(size_t)(ksrc0 + kk) * Nsrc + nsrc0 + (lane & 31)] : 0.f; }
    asm volatile("s_waitcnt lgkmcnt(0)" ::: "memory");
    const int c = lane & 7;
#pragma unroll
    for (int j = 0; j < 4; ++j) { const int n = (lane >> 3) + 8 * j; const LAS float* s = scr + (8 * c) * 33 + n;
        u32x4 o; o.x = pk2(s[0 * 33], s[1 * 33]); o.y = pk2(s[2 * 33], s[3 * 33]); o.z = pk2(s[4 * 33], s[5 * 33]); o.w = pk2(s[6 * 33], s[7 * 33]);
        *(u32x4*)(WT + (size_t)(n0 + n) * K + k0 + 8 * c) = o; }
    asm volatile("s_waitcnt lgkmcnt(0)" ::: "memory");
}
__device__ __forceinline__ int win_colmap(int n0) {
    if (n0 < 384) return n0;
    if (n0 < 768) return 1152 + (n0 - 384);
    if (n0 < 1152) return 384 + (n0 - 768);
    if (n0 < 1536) return 768 + (n0 - 1152);
    if (n0 < NIN) return n0;
    return -1;
}
__device__ __forceinline__ void convert_weights(const Params& p, int l, LAS unsigned char* lds, int widx, int nw) {
    const int tid_ = opaque_tid(); const int wave = tid_ >> 6, lane = tid_ & 63;
    LAS float* scr = (LAS float*)(lds + wave * 8448);
    bf16_t* win_t = (bf16_t*)(p.ws + OFF_WIN); bf16_t* wout_t = (bf16_t*)(p.ws + OFF_WOUT); bf16_t* wup_t = (bf16_t*)(p.ws + OFF_WUP); bf16_t* wdn_t = (bf16_t*)(p.ws + OFF_WDN);
    const float* w_in = p.in[5] + (size_t)l * D * NIN; const float* w_out = p.in[22] + (size_t)l * D * D;
    const float* w_up = p.in[25] + (size_t)l * D * FFN; const float* w_dn = p.in[26] + (size_t)l * FFN * D;
    constexpr int I_IN = (D / 64) * (NINP / 32), I_OUT = (D / 64) * (D / 32), I_UP = (D / 64) * (FFN / 32), I_DN = (FFN / 64) * (D / 32);
    for (int it = widx; it < I_IN + I_OUT + I_UP + I_DN; it += nw) {
        int r = it;
        if (r < I_IN) { const int nb = NINP / 32, kb = r / nb, n0 = (r % nb) * 32; transpose_item(w_in, NIN, kb * 64, win_colmap(n0), win_t, D, kb * 64, n0, scr, lane); continue; } r -= I_IN;
        if (r < I_OUT) { const int nb = D / 32, kb = r / nb, n0 = (r % nb) * 32, k0 = kb * 64; const int ks = k0 < 256 ? 768 + k0 : k0 - 256;
            transpose_item(w_out, D, ks, n0, wout_t, D, k0, n0, scr, lane); continue; } r -= I_OUT;
        if (r < I_UP) { const int nb = FFN / 32, kb = r / nb, n0 = (r % nb) * 32; transpose_item(w_up, FFN, kb * 64, n0, wup_t, D, kb * 64, n0, scr, lane); continue; } r -= I_UP;
        { const int nb = D / 32, kb = r / nb, n0 = (r % nb) * 32; transpose_item(w_dn, D, kb * 64, n0, wdn_t, FFN, kb * 64, n0, scr, lane); }
    }
}

__device__ __forceinline__ void ln_row(const float* src, float* dst32, bf16_t* dstb, const float* g, const float* b, int lane_) {
    int lane = lane_; asm volatile("" : "+v"(lane));
    const f32x4* xr = (const f32x4*)src + lane;
    f32x4 v[4]; float s = 0.f;
#pragma unroll
    for (int j = 0; j < 4; ++j) { v[j] = xr[64 * j]; s += (v[j].x + v[j].y) + (v[j].z + v[j].w); }
    const float mean = wave_sum(s) * (1.f / D); float s2 = 0.f;
#pragma unroll
    for (int j = 0; j < 4; ++j) { v[j] = v[j] - mean; s2 += (v[j].x * v[j].x + v[j].y * v[j].y) + (v[j].z * v[j].z + v[j].w * v[j].w); }
    const float rstd = rsqrtf(wave_sum(s2) * (1.f / D) + LN_EPS);
#pragma unroll
    for (int j = 0; j < 4; ++j) {
        const f32x4 gg = ((const f32x4*)g)[lane + 64 * j], bb = ((const f32x4*)b)[lane + 64 * j];
        f32x4 o = v[j] * rstd * gg + bb;
        ((f32x4*)dst32)[lane + 64 * j] = o;
        u32x2 w; w.x = pk2(o.x, o.y); w.y = pk2(o.z, o.w);
        ((u32x2*)dstb)[lane + 64 * j] = w;
    }
}

__device__ __forceinline__ void ln_row2(const float* src0, const float* src1, float* d0, float* d1, bf16_t* b0, bf16_t* b1, const float* g, const float* b, int lane_) {
    int lane = lane_; asm volatile("" : "+v"(lane));
    const f32x4* x0 = (const f32x4*)src0 + lane; const f32x4* x1 = (const f32x4*)src1 + lane;
    f32x4 v[4], u[4]; float s = 0.f, t = 0.f;
#pragma unroll
    for (int j = 0; j < 4; ++j) { v[j] = x0[64 * j]; u[j] = x1[64 * j]; }
#pragma unroll
    for (int j = 0; j < 4; ++j) { s += (v[j].x + v[j].y) + (v[j].z + v[j].w); t += (u[j].x + u[j].y) + (u[j].z + u[j].w); }
    const float m0 = wave_sum(s) * (1.f / D), m1 = wave_sum(t) * (1.f / D); float s2 = 0.f, t2 = 0.f;
#pragma unroll
    for (int j = 0; j < 4; ++j) { v[j] = v[j] - m0; u[j] = u[j] - m1; s2 += (v[j].x * v[j].x + v[j].y * v[j].y) + (v[j].z * v[j].z + v[j].w * v[j].w); t2 += (u[j].x * u[j].x + u[j].y * u[j].y) + (u[j].z * u[j].z + u[j].w * u[j].w); }
    const float r0 = rsqrtf(wave_sum(s2) * (1.f / D) + LN_EPS), r1 = rsqrtf(wave_sum(t2) * (1.f / D) + LN_EPS);
#pragma unroll
    for (int j = 0; j < 4; ++j) {
        const f32x4 gg = ((const f32x4*)g)[lane + 64 * j], bb = ((const f32x4*)b)[lane + 64 * j];
        const f32x4 o0 = v[j] * r0 * gg + bb, o1 = u[j] * r1 * gg + bb;
        ((f32x4*)d0)[lane + 64 * j] = o0; ((f32x4*)d1)[lane + 64 * j] = o1;
        u32x2 w0, w1; w0.x = pk2(o0.x, o0.y); w0.y = pk2(o0.z, o0.w); w1.x = pk2(o1.x, o1.y); w1.y = pk2(o1.z, o1.w);
        ((u32x2*)b0)[lane + 64 * j] = w0; ((u32x2*)b1)[lane + 64 * j] = w1;
    }
}

#define DSR128(dst, addr, off) asm volatile("ds_read_b128 %0, %1 offset:%2" : "=v"(dst) : "v"(addr), "n"(off))
#define DSR32(dst, addr, off) asm volatile("ds_read_b32 %0, %1 offset:%2" : "=v"(dst) : "v"(addr), "n"(off))
#define LGKM0() do { asm volatile("s_waitcnt lgkmcnt(0)" ::: "memory"); __builtin_amdgcn_sched_barrier(0); } while (0)
#define SCHEDB __builtin_amdgcn_sched_barrier(0)
#define WAVE_FENCE() do { __builtin_amdgcn_fence(__ATOMIC_RELEASE, "wavefront"); __builtin_amdgcn_wave_barrier(); __builtin_amdgcn_fence(__ATOMIC_ACQUIRE, "wavefront"); } while (0)
__device__ __forceinline__ float xsum32(float x) { auto r = __builtin_amdgcn_permlane32_swap(__float_as_uint(x), __float_as_uint(x), false, false); return __uint_as_float(r[0]) + __uint_as_float(r[1]); }
__device__ __forceinline__ float xsum16(float x) { auto r = __builtin_amdgcn_permlane16_swap(__float_as_uint(x), __float_as_uint(x), false, false); return __uint_as_float(r[0]) + __uint_as_float(r[1]); }

constexpr int RTC = 32;
#define RW_ISSUE(BUF, bk, bv, vvn) do { \
    DSR128(BUF[0], bk, 0); DSR128(BUF[1], bk, 16); DSR128(BUF[2], bk, 32); DSR128(BUF[3], bk, 48); \
    DSR128(BUF[4], bk, 256); DSR128(BUF[5], bk, 272); DSR128(BUF[6], bk, 288); DSR128(BUF[7], bk, 304); \
    DSR128(BUF[8], bk, 512); DSR128(BUF[9], bk, 528); DSR128(BUF[10], bk, 544); DSR128(BUF[11], bk, 560); \
    DSR128(BUF[12], bk, 768); DSR128(BUF[13], bk, 784); DSR128(BUF[14], bk, 800); DSR128(BUF[15], bk, 816); \
    DSR32(vvn, bv, 1024); } while (0)
#define RW_COMPUTE(BUF) do { \
    f32x4 sacc = S4[0] * BUF[0] + S4[1] * BUF[1]; sacc += S4[2] * BUF[2] + S4[3] * BUF[3]; \
    const float sa = xsum16(xsum32((sacc.x + sacc.y) + (sacc.z + sacc.w))); \
    f32x4 oacc = (f32x4){0.f, 0.f, 0.f, 0.f}; \
    _Pragma("unroll") for (int i_ = 0; i_ < 4; ++i_) { f32x4 sv = S4[i_] + (sa * BUF[4 + i_] + vv * BUF[8 + i_]); S4[i_] = sv; oacc += sv * BUF[12 + i_]; } \
    oval = xsum16(xsum32((oacc.x + oacc.y) + (oacc.z + oacc.w))); } while (0)

#define RW7_ISSUE(BUF, bk, bv, va, vb) do { \
    DSR128(BUF[0], bk, 0); DSR128(BUF[1], bk, 16); DSR128(BUF[2], bk, 32); DSR128(BUF[3], bk, 48); \
    DSR128(BUF[4], bk, 256); DSR128(BUF[5], bk, 272); DSR128(BUF[6], bk, 288); DSR128(BUF[7], bk, 304); \
    DSR128(BUF[8], bk, 512); DSR128(BUF[9], bk, 528); DSR128(BUF[10], bk, 544); DSR128(BUF[11], bk, 560); \
    DSR128(BUF[12], bk, 768); DSR128(BUF[13], bk, 784); DSR128(BUF[14], bk, 800); DSR128(BUF[15], bk, 816); \
    DSR32(va, bv, 1024); DSR32(vb, bv, 1088); } while (0)
#define RW7_COMPUTE(BUF) do { \
    f32x4 sa0 = S4[0] * BUF[0] + S4[1] * BUF[1]; sa0 += S4[2] * BUF[2] + S4[3] * BUF[3]; \
    f32x4 sa1 = S4[4] * BUF[0] + S4[5] * BUF[1]; sa1 += S4[6] * BUF[2] + S4[7] * BUF[3]; \
    const float sA = xsum16(xsum32((sa0.x + sa0.y) + (sa0.z + sa0.w))), sB = xsum16(xsum32((sa1.x + sa1.y) + (sa1.z + sa1.w))); \
    f32x4 oa0 = (f32x4){0.f, 0.f, 0.f, 0.f}, oa1 = (f32x4){0.f, 0.f, 0.f, 0.f}; \
    _Pragma("unroll") for (int i_ = 0; i_ < 4; ++i_) { \
        f32x4 s0 = S4[i_] + (sA * BUF[4 + i_] + vv0 * BUF[8 + i_]); S4[i_] = s0; oa0 += s0 * BUF[12 + i_]; \
        f32x4 s1 = S4[4 + i_] + (sB * BUF[4 + i_] + vv1 * BUF[8 + i_]); S4[4 + i_] = s1; oa1 += s1 * BUF[12 + i_]; } \
    oval0 = xsum16(xsum32((oa0.x + oa0.y) + (oa0.z + oa0.w))); oval1 = xsum16(xsum32((oa1.x + oa1.y) + (oa1.z + oa1.w))); } while (0)

__device__ __forceinline__ void rwkv_scan_wg(const Params& p, int l, int pairIdx, LAS unsigned char* lds) {
    const int tid = opaque_tid(), wave = tid >> 6, lane = tid & 63;
    const int b = pairIdx / 6, h = pairIdx % 6;
    constexpr int CT = 16, NCH = SEQL / CT;
    LAS float* ring = (LAS float*)lds;
    LAS float* lam = (LAS float*)(lds + 81920);
    const bf16_t* proj = (const bf16_t*)(p.ws + OFF_PROJ);
    bf16_t* o_r = (bf16_t*)(p.ws + OFF_T);
    if (wave < 4) {
        const int dir = wave >> 1, half = wave & 1;
        const int kp = lane >> 4, row = lane & 15, v0 = half * 32 + row;
        f32x4 S4[8];
#pragma unroll
        for (int k = 0; k < 8; ++k) S4[k] = (f32x4){0.f, 0.f, 0.f, 0.f};
        f32x4 A[16], B[16]; float vv0 = 0.f, vv1 = 0.f, vn0 = 0.f, vn1 = 0.f, oval0 = 0.f, oval1 = 0.f;
        const unsigned ring_base = (unsigned)(unsigned long long)ring, lam_base = (unsigned)(unsigned long long)lam;
        bf16_t* orow = o_r + ((size_t)dir * MROWS + (size_t)b * SEQL) * RW + h * 64 + v0;
        __syncthreads();
        for (int chunk = 0; chunk < NCH; ++chunk) {
            const unsigned rb = ring_base + (unsigned)((((chunk & 1) * 2 + dir) * CT) * 1280);
            const unsigned offk = rb + kp * 64, offv = rb + v0 * 4;
            const unsigned lam_addr = lam_base + (unsigned)((((chunk & 1) * 2 + dir) * 2) * 256) + kp * 64;
            RW7_ISSUE(A, offk, offv, vn0, vn1);
#pragma unroll 1
            for (int sub = 0; sub < 2; ++sub) {
#pragma unroll 1
                for (int it = 0; it < 4; ++it) {
                    const int sl = sub * 8 + it * 2;
                    const unsigned bk1 = offk + (sl + 1) * 1280, bv1 = offv + (sl + 1) * 1280, bk2 = bk1 + 1280, bv2 = bv1 + 1280;
                    const int s = chunk * CT + sl;
                    LGKM0(); vv0 = vn0; vv1 = vn1; RW7_ISSUE(B, bk1, bv1, vn0, vn1); SCHEDB; RW7_COMPUTE(A); SCHEDB;
                    if (kp == 0) { const int t = dir ? SEQL - 1 - s : s; orow[(size_t)t * RW] = (bf16_t)f2bf(oval0); orow[(size_t)t * RW + 16] = (bf16_t)f2bf(oval1); }
                    LGKM0(); vv0 = vn0; vv1 = vn1; RW7_ISSUE(A, bk2, bv2, vn0, vn1); SCHEDB; RW7_COMPUTE(B); SCHEDB;
                    if (kp == 0) { const int t = dir ? SEQL - 2 - s : s + 1; orow[(size_t)t * RW] = (bf16_t)f2bf(oval0); orow[(size_t)t * RW + 16] = (bf16_t)f2bf(oval1); }
                }
                {   f32x4 L0, L1, L2, L3; const unsigned la = lam_addr + sub * 256;
                    DSR128(L0, la, 0); DSR128(L1, la, 16); DSR128(L2, la, 32); DSR128(L3, la, 48);
                    LGKM0();
                    S4[0] *= L0; S4[1] *= L1; S4[2] *= L2; S4[3] *= L3; S4[4] *= L0; S4[5] *= L1; S4[6] *= L2; S4[7] *= L3; SCHEDB; }
            }
            LGKM0();
            __syncthreads();
        }
    } else {
        const int dir = (wave - 4) >> 1, sub = (wave - 4) & 1;
        const int c = h * 64 + lane;
        const float w0c = p.in[8][(l * 2 + dir) * RW + c], a0c = p.in[10][(l * 2 + dir) * RW + c];
        const float kkc = p.in[13][l * RW + c], kac = p.in[14][l * RW + c];
        const float* mu0 = p.in[7] + (size_t)(l * 2 + 0) * NRW; const float* mu1 = mu0 + NRW;
        const float mr0 = mu0[c], mr1 = mu1[c], mk0 = mu0[384 + c], mk1 = mu1[384 + c], mv0 = mu0[768 + c], mv1 = mu1[768 + c];
        const int lcol = lane < 32 ? 1152 + dir * 32 + lane : 1216 + dir * 32 + (lane - 32);
        const float ml0 = mu0[lcol], ml1 = mu1[lcol];
        bf16x8 Bw[4], Ba[4];
        {   const float* wu = p.in[9] + (size_t)((l * 2 + dir) * 32) * RW + h * 64 + (lane & 15); const float* au = p.in[11] + (size_t)((l * 2 + dir) * 32) * RW + h * 64 + (lane & 15);
#pragma unroll
            for (int ct = 0; ct < 4; ++ct)
#pragma unroll
                for (int jj = 0; jj < 8; ++jj) { const int r = (lane >> 4) * 8 + jj;
                    Bw[ct][jj] = (short)f2bf(wu[(size_t)r * RW + ct * 16]); Ba[ct][jj] = (short)f2bf(au[(size_t)r * RW + ct * 16]); } }
        LAS unsigned short* xs = (LAS unsigned short*)(lds + 83968 + (wave - 4) * 4096);
        unsigned pfd = 0u;
        for (int chunk = 0; chunk <= NCH; ++chunk) {
            if (chunk < NCH) {
                asm volatile("s_waitcnt vmcnt(0)" : "+v"(pfd) :: "memory");
                const int s0 = chunk * CT + sub * 8;
                const int tlo = dir ? SEQL - 8 - s0 : s0;
                float rr[10], rk_[10], rv[10], rl[10];
#pragma unroll
                for (int q = 0; q < 10; ++q) {
                    const int tr = tlo - 1 + q; const bool ok = (tr >= 0) && (tr < SEQL);
                    const bf16_t* pr = proj + ((size_t)b * SEQL + (ok ? tr : 0)) * PS; const float m = ok ? 1.f : 0.f;
                    rr[q] = m * bf2f(pr[P_R + c]); rk_[q] = m * bf2f(pr[P_K + c]); rv[q] = m * bf2f(pr[P_V + c]); rl[q] = m * bf2f(pr[P_RW + lcol]);
                }
                float rs[8], ks[8], vs[8], lo[8];
#pragma unroll
                for (int i = 0; i < 8; ++i) {
                    const float rc = dir ? rr[8 - i] : rr[i + 1], rp = dir ? rr[7 - i] : rr[i], rn = dir ? rr[9 - i] : rr[i + 2];
                    const float kc = dir ? rk_[8 - i] : rk_[i + 1], kp_ = dir ? rk_[7 - i] : rk_[i], kn = dir ? rk_[9 - i] : rk_[i + 2];
                    const float vc = dir ? rv[8 - i] : rv[i + 1], vp = dir ? rv[7 - i] : rv[i], vn = dir ? rv[9 - i] : rv[i + 2];
                    const float lc = dir ? rl[8 - i] : rl[i + 1], lp = dir ? rl[7 - i] : rl[i], ln = dir ? rl[9 - i] : rl[i + 2];
                    rs[i] = rc + mr0 * (rp - rc) + mr1 * (rn - rc);
                    ks[i] = kc + mk0 * (kp_ - kc) + mk1 * (kn - kc);
                    vs[i] = vc + mv0 * (vp - vc) + mv1 * (vn - vc);
                    lo[i] = lc + ml0 * (lp - lc) + ml1 * (ln - lc);
                }
#pragma unroll
                for (int i = 0; i < 8; ++i) {
                    const float e2 = __expf(2.f * lo[i]); const float th = 1.f - 2.f / (e2 + 1.f);
                    xs[i * 64 + lane] = (unsigned short)f2bf(lane < 32 ? th : lo[i]);
                }
                WAVE_FENCE();
                const bf16x8 Aw = *(const LAS bf16x8*)(xs + (lane & 15) * 64 + (lane >> 4) * 8);
                const bf16x8 Aa = *(const LAS bf16x8*)(xs + (lane & 15) * 64 + 32 + (lane >> 4) * 8);
                f32x4 Dw[4], Da[4];
#pragma unroll
                for (int ct = 0; ct < 4; ++ct) {
                    Dw[ct] = __builtin_amdgcn_mfma_f32_16x16x32_bf16(Aw, Bw[ct], (f32x4){0.f, 0.f, 0.f, 0.f}, 0, 0, 0);
                    Da[ct] = __builtin_amdgcn_mfma_f32_16x16x32_bf16(Aa, Ba[ct], (f32x4){0.f, 0.f, 0.f, 0.f}, 0, 0, 0);
                }
                LAS float* wsf = (LAS float*)xs;
                WAVE_FENCE();
                if (lane < 32) {
#pragma unroll
                    for (int ct = 0; ct < 4; ++ct)
#pragma unroll
                        for (int jj = 0; jj < 4; ++jj) {
                            wsf[((lane >> 4) * 4 + jj) * 64 + ct * 16 + (lane & 15)] = Dw[ct][jj];
                            wsf[(8 + (lane >> 4) * 4 + jj) * 64 + ct * 16 + (lane & 15)] = Da[ct][jj];
                        }
                }
                WAVE_FENCE();
                const int pb = chunk & 1;
                float lamr = 0.f;
#pragma unroll
                for (int i = 0; i < 8; ++i) {
                    const int sl = sub * 8 + i;
                    const float wpre = w0c + wsf[i * 64 + lane], apre = a0c + wsf[(8 + i) * 64 + lane];
                    const float w = -__logf(1.f + __expf(-wpre)) - 0.5f;
                    const float ew = __expf(w);
                    const float a = sigmoidf_(apre);
                    float kk = ks[i] * kkc; const float n2 = wave_sum(kk * kk); kk = kk / fmaxf(sqrtf(n2), 1e-12f);
                    const float kd = ks[i] * (1.f + (a - 1.f) * kac);
                    const float Lprev = __expf(-lamr); lamr += ew; const float Lcur = __expf(-lamr), Linv = __expf(lamr);
                    LAS float* o = ring + (size_t)((((pb * 2 + dir) * CT) + sl) * 5) * 64;
                    o[0 * 64 + lane] = -kk * Lprev; o[1 * 64 + lane] = kk * a * Linv; o[2 * 64 + lane] = kd * Linv; o[3 * 64 + lane] = rs[i] * Lcur; o[4 * 64 + lane] = vs[i];
                }
                lam[((pb * 2 + dir) * 2 + sub) * 64 + lane] = __expf(-lamr);
                if (chunk + 1 < NCH) {
                    const int s1 = (chunk + 1) * CT + sub * 8; const int tl1 = dir ? SEQL - 8 - s1 : s1;
#pragma unroll
                    for (int q = 0; q < 10; ++q) { int tr = tl1 - 1 + q; tr = tr < 0 ? 0 : (tr >= SEQL ? SEQL - 1 : tr);
                        const bf16_t* pr = proj + ((size_t)b * SEQL + tr) * PS;
                        asm volatile("global_load_ushort %0, %1, off" : "+v"(pfd) : "v"(pr + P_R + c)); asm volatile("global_load_ushort %0, %1, off" : "+v"(pfd) : "v"(pr + P_K + c));
                        asm volatile("global_load_ushort %0, %1, off" : "+v"(pfd) : "v"(pr + P_V + c)); asm volatile("global_load_ushort %0, %1, off" : "+v"(pfd) : "v"(pr + P_RW + lcol)); }
                }
            }
            __syncthreads();
        }
        asm volatile("s_waitcnt vmcnt(0)" : "+v"(pfd) :: "memory");
    }
}


#define HG_ISSUE(BUF, bk) do { \
    DSR128(BUF[0], bk, 0); DSR128(BUF[1], bk, 16); DSR128(BUF[2], bk, 32); DSR128(BUF[3], bk, 48); DSR128(BUF[4], bk, 64); DSR128(BUF[5], bk, 80); DSR128(BUF[6], bk, 96); DSR128(BUF[7], bk, 112); \
    DSR128(BUF[8], bk, 256); DSR128(BUF[9], bk, 272); DSR128(BUF[10], bk, 288); DSR128(BUF[11], bk, 304); DSR128(BUF[12], bk, 320); DSR128(BUF[13], bk, 336); DSR128(BUF[14], bk, 352); DSR128(BUF[15], bk, 368); } while (0)
#define HG_COMPUTE(BUF) do { f32x4 oacc = (f32x4){0.f, 0.f, 0.f, 0.f}; \
    _Pragma("unroll") for (int i_ = 0; i_ < 8; ++i_) { f32x4 sv = S4[i_] + BUF[i_] * iv; S4[i_] = sv; oacc += sv * BUF[8 + i_]; } \
    oval = xsum32((oacc.x + oacc.y) + (oacc.z + oacc.w)); } while (0)

__device__ __forceinline__ void hgrn_scan_wg(const Params& p, int l, int grp, LAS unsigned char* lds) {
    const int tid = opaque_tid(), wave = tid >> 6, lane = tid & 63;
    constexpr int HTC = 16, NCH = SEQL / HTC;
    LAS float* ring = (LAS float*)lds;
    LAS float* lam = (LAS float*)(lds + 73728);
    LAS float* lbt = (LAS float*)(lds + 76800);
    bf16_t* proj = (bf16_t*)(p.ws + OFF_PROJ);
    for (int i = tid; i < 2 * RW; i += 512) { const int dr = i / RW, cc = i % RW; const float* lg = p.in[4] + (size_t)dr * 5 * RW + cc;
        float e[5], mx = -1e30f;
#pragma unroll
        for (int j = 0; j < 5; ++j) { e[j] = lg[j * RW]; mx = fmaxf(mx, e[j]); }
        float sum = 0.f, cum = 0.f;
#pragma unroll
        for (int j = 0; j < 5; ++j) { e[j] = __expf(e[j] - mx); sum += e[j]; if (j <= l) cum += e[j]; }
        lbt[i] = cum / sum; }
    __syncthreads();
    if (wave < 6) {
        const int j = wave >> 1, half = wave & 1, kp = lane >> 5, col = half * 32 + (lane & 31);
        const int cch = grp * 3 + j;
        const int cdir = cch & 1, cb = (cch >> 1) / 6, chh = (cch >> 1) % 6;
        bf16_t* orow = proj + (size_t)cb * SEQL * PS + (cdir ? P_FB : P_FF) + chh * 64 + col;
        f32x4 S4[8];
#pragma unroll
        for (int k = 0; k < 8; ++k) S4[k] = (f32x4){0.f, 0.f, 0.f, 0.f};
        f32x4 A[16], B[16]; float iv = 0.f, ivn = 0.f, oval = 0.f;
        const unsigned ring_addr = (unsigned)(unsigned long long)ring, lam_base = (unsigned)(unsigned long long)lam;
        __syncthreads();
        for (int chunk = 0; chunk < NCH; ++chunk) {
            const unsigned cbase = ring_addr + (unsigned)((((chunk & 1) * 3 + j) * HTC) * 768);
            const unsigned offk = cbase + kp * 128, offv = cbase + col * 4;
            const unsigned lam_addr = lam_base + (unsigned)((((chunk & 1) * 3 + j) * 2) * 256) + kp * 128;
            HG_ISSUE(A, offk); DSR32(ivn, offv, 512);
#pragma unroll 1
            for (int sub = 0; sub < 2; ++sub) {
#pragma unroll 1
                for (int it = 0; it < 4; ++it) {
                    const int sl = sub * 8 + it * 2;
                    const unsigned bk1 = offk + (sl + 1) * 768, bv1 = offv + (sl + 1) * 768, bk2 = bk1 + 768, bv2 = bv1 + 768;
                    const int s = chunk * HTC + sl;
                    LGKM0(); iv = ivn; HG_ISSUE(B, bk1); DSR32(ivn, bv1, 512); SCHEDB; HG_COMPUTE(A); SCHEDB;
                    if (kp == 0) { const int t = cdir ? SEQL - 1 - s : s; orow[(size_t)t * PS] = (bf16_t)f2bf(oval); }
                    LGKM0(); iv = ivn; HG_ISSUE(A, bk2); DSR32(ivn, bv2, 512); SCHEDB; HG_COMPUTE(B); SCHEDB;
                    if (kp == 0) { const int t = cdir ? SEQL - 2 - s : s + 1; orow[(size_t)t * PS] = (bf16_t)f2bf(oval); }
                }
                {   f32x4 L[8]; const unsigned la = lam_addr + sub * 256;
                    DSR128(L[0], la, 0); DSR128(L[1], la, 16); DSR128(L[2], la, 32); DSR128(L[3], la, 48); DSR128(L[4], la, 64); DSR128(L[5], la, 80); DSR128(L[6], la, 96); DSR128(L[7], la, 112);
                    LGKM0();
#pragma unroll
                    for (int i_ = 0; i_ < 8; ++i_) S4[i_] *= L[i_];
                    SCHEDB; }
            }
            LGKM0();
            __syncthreads();
        }
    } else {
        const int pw = wave - 6;
        unsigned pfd = 0u;
        for (int chunk = 0; chunk <= NCH; ++chunk) {
            if (chunk < NCH) {
                asm volatile("s_waitcnt vmcnt(0)" : "+v"(pfd) :: "memory");
                float qv[24], fv[24], ivv[24];
#pragma unroll
                for (int uu = 0; uu < 3; ++uu) {
                    const int u = pw * 3 + uu, j = u >> 1, hh = u & 1;
                    const int ch = grp * 3 + j, dir = ch & 1, b = (ch >> 1) / 6, h = (ch >> 1) % 6;
                    const bf16_t* prow = proj + (size_t)b * SEQL * PS + h * 64 + lane;
#pragma unroll
                    for (int i = 0; i < 8; ++i) {
                        const int s = chunk * HTC + hh * 8 + i, t = dir ? SEQL - 1 - s : s;
                        const bf16_t* pr = prow + (size_t)t * PS;
                        qv[uu * 8 + i] = bf2f(pr[P_Q]); fv[uu * 8 + i] = bf2f(pr[dir ? P_FB : P_FF]); ivv[uu * 8 + i] = bf2f(pr[P_I]);
                    }
                }
#pragma unroll
                for (int uu = 0; uu < 3; ++uu) {
                    const int u = pw * 3 + uu, j = u >> 1, hh = u & 1;
                    const int ch = grp * 3 + j, dir = ch & 1, h = (ch >> 1) % 6;
                    const float lb = lbt[dir * RW + h * 64 + lane];
                    float Lc = 1.f;
#pragma unroll
                    for (int i = 0; i < 8; ++i) {
                        const int sl = hh * 8 + i;
                        const float f = lb + (1.f - lb) * sigmoidf_(fv[uu * 8 + i]);
                        Lc *= f;
                        LAS float* o = ring + (size_t)(((((chunk & 1) * 3 + j) * HTC) + sl) * 3) * 64;
                        o[lane] = (1.f - f) / Lc; o[64 + lane] = qv[uu * 8 + i] * Lc; o[128 + lane] = ivv[uu * 8 + i];
                    }
                    lam[(((chunk & 1) * 3 + j) * 2 + hh) * 64 + lane] = Lc;
                }
                if (chunk + 1 < NCH) {
#pragma unroll
                    for (int uu = 0; uu < 3; ++uu) {
                        const int u = pw * 3 + uu, j = u >> 1, hh = u & 1;
                        const int ch = grp * 3 + j, dir = ch & 1, b = (ch >> 1) / 6, h = (ch >> 1) % 6;
                        const bf16_t* prow = proj + (size_t)b * SEQL * PS + h * 64 + lane;
#pragma unroll
                        for (int i = 0; i < 8; ++i) {
                            const int s = (chunk + 1) * HTC + hh * 8 + i, t = dir ? SEQL - 1 - s : s;
                            const bf16_t* pr = prow + (size_t)t * PS;
                            asm volatile("global_load_ushort %0, %1, off" : "+v"(pfd) : "v"(pr + P_Q)); asm volatile("global_load_ushort %0, %1, off" : "+v"(pfd) : "v"(pr + (dir ? P_FB : P_FF)));
                            asm volatile("global_load_ushort %0, %1, off" : "+v"(pfd) : "v"(pr + P_I));
                        }
                    }
                }
            }
            __syncthreads();
        }
        asm volatile("s_waitcnt vmcnt(0)" : "+v"(pfd) :: "memory");
    }
}

__device__ __forceinline__ void conv_wg(const Params& p, int l, int first, int stride, LAS unsigned char* lds) {
    const int tid = opaque_tid(), wave = tid >> 6, lane = tid & 63;
    LAS float* z = (LAS float*)lds;
    LAS float* ot = (LAS float*)(lds + 62 * 256 * 4);
    bf16_t* proj = (bf16_t*)(p.ws + OFF_PROJ);
    const int ch = tid & 255, half = tid >> 8;
    float w[31];
#pragma unroll
    for (int j = 0; j < 31; ++j) w[j] = p.in[18][(size_t)(l * 31 + j) * 256 + ch];
    const float cb = p.in[19][l * 256 + ch];
    const f32x4 lg = ((const f32x4*)(p.in[20] + l * 256))[lane], lbv = ((const f32x4*)(p.in[21] + l * 256))[lane];
    for (int tile = first; tile < MROWS / 32; tile += stride) {
        const int row0 = tile * 32, b = row0 / SEQL, t0 = row0 % SEQL;
        {
            float zv[31], zg[31];
#pragma unroll
            for (int i = 0; i < 31; ++i) { const int r = half + 2 * i, t = t0 - 15 + r; const bool ok = (t >= 0) && (t < SEQL);
                const bf16_t* pr = proj + ((size_t)b * SEQL + (ok ? t : 0)) * PS; zv[i] = ok ? bf2f(pr[P_CV + ch]) : 0.f; zg[i] = bf2f(pr[P_CG + ch]); }
#pragma unroll
            for (int i = 0; i < 31; ++i) z[(half + 2 * i) * 256 + ch] = zv[i] * sigmoidf_(zg[i]);
        }
        __syncthreads();
#pragma unroll 4
        for (int tt = 0; tt < 16; ++tt) { const int tok = half * 16 + tt; float acc = cb;
#pragma unroll
            for (int j = 0; j < 31; ++j) acc += w[j] * z[(tok + j) * 256 + ch];
            ot[tok * 256 + ch] = acc; }
        __syncthreads();
#pragma unroll
        for (int q = 0; q < 4; ++q) { const int tok = wave * 4 + q;
            f32x4 v = *(const LAS f32x4*)(ot + tok * 256 + lane * 4);
            const float mean = wave_sum((v.x + v.y) + (v.z + v.w)) * (1.f / 256.f);
            v = v - mean;
            const float var = wave_sum((v.x * v.x + v.y * v.y) + (v.z * v.z + v.w * v.w)) * (1.f / 256.f);
            const float rstd = rsqrtf(var + LN_EPS);
            f32x4 y = v * rstd * lg + lbv;
            y.x = y.x * sigmoidf_(y.x); y.y = y.y * sigmoidf_(y.y); y.z = y.z * sigmoidf_(y.z); y.w = y.w * sigmoidf_(y.w);
            u32x2 wv; wv.x = pk2(y.x, y.y); wv.y = pk2(y.z, y.w);
            *(u32x2*)(proj + (size_t)(row0 + tok) * PS + P_YC + lane * 4) = wv; }
        __syncthreads();
    }
}

__device__ __forceinline__ void combine_phase(const Params& p, int l, int widx, int nw, LAS unsigned char* lds) {
    const int tid = opaque_tid(), lane = tid & 63;
    bf16_t* proj = (bf16_t*)(p.ws + OFF_PROJ);
    const bf16_t* o_r = (const bf16_t*)(p.ws + OFF_T);
    LAS unsigned* WA = (LAS unsigned*)lds;
    LAS unsigned* WG = (LAS unsigned*)(lds + 49152);
    {
        const float* aup = p.in[11] + (size_t)(l * 2 * 32) * RW; const float* gup = p.in[12] + (size_t)(l * 64) * RW;
        for (int i = tid; i < 2 * 32 * 3 * 64; i += 512) { const int ln = i & 63, hp = (i >> 6) % 3, dr = i / 192; const float* s = aup + (size_t)dr * RW + (2 * hp) * 64 + ln; WA[i] = pk2(s[0], s[64]); }
        for (int i = tid; i < 64 * 3 * 64; i += 512) { const int ln = i & 63, hp = (i >> 6) % 3, r = i / 192; const float* s = gup + (size_t)r * RW + (2 * hp) * 64 + ln; WG[i] = pk2(s[0], s[64]); }
    }
    __syncthreads();
    const float* mu0 = p.in[7] + (size_t)(l * 2 + 0) * NRW; const float* mu1 = mu0 + NRW;
    const float mad0 = mu0[1216 + lane], mad1 = mu1[1216 + lane], mgd0 = mu0[1280 + lane], mgd1 = mu1[1280 + lane];
    for (int g4 = widx; g4 < MROWS / 2; g4 += nw) {
        const int row0 = g4 * 2;
        float adv[2], sgv[2];
#pragma unroll
        for (int tt = 0; tt < 2; ++tt) { const int row = row0 + tt, t = row % SEQL; const bf16_t* pr = proj + (size_t)row * PS;
            const bool hp = t > 0, hn = t < SEQL - 1; const bf16_t* pp = hp ? pr - PS : pr; const bf16_t* pn = hn ? pr + PS : pr; const float fp = hp ? 1.f : 0.f, fn = hn ? 1.f : 0.f;
            const float ac = bf2f(pr[P_AD + lane]), ap = fp * bf2f(pp[P_AD + lane]), an = fn * bf2f(pn[P_AD + lane]);
            const float gc = bf2f(pr[P_GD + lane]), gp = fp * bf2f(pp[P_GD + lane]), gn = fn * bf2f(pn[P_GD + lane]);
            adv[tt] = ac + mad0 * (ap - ac) + mad1 * (an - ac);
            sgv[tt] = sigmoidf_(gc + mgd0 * (gp - gc) + mgd1 * (gn - gc)); }
        float A0[2][6], A1[2][6], G[2][6];
#pragma unroll
        for (int tt = 0; tt < 2; ++tt)
#pragma unroll
            for (int h = 0; h < 6; ++h) { A0[tt][h] = 0.f; A1[tt][h] = 0.f; G[tt][h] = 0.f; }
#pragma unroll 4
        for (int r = 0; r < 32; ++r) {
            float w0[6], w1[6];
#pragma unroll
            for (int hp = 0; hp < 3; ++hp) { const unsigned u0 = WA[(r * 3 + hp) * 64 + lane], u1 = WA[((32 + r) * 3 + hp) * 64 + lane];
                w0[2 * hp] = __uint_as_float(u0 << 16); w0[2 * hp + 1] = __uint_as_float(u0 & 0xffff0000u); w1[2 * hp] = __uint_as_float(u1 << 16); w1[2 * hp + 1] = __uint_as_float(u1 & 0xffff0000u); }
#pragma unroll
            for (int tt = 0; tt < 2; ++tt) { const float s0 = rdlane(adv[tt], r), s1 = rdlane(adv[tt], 32 + r);
#pragma unroll
                for (int h = 0; h < 6; ++h) { A0[tt][h] += s0 * w0[h]; A1[tt][h] += s1 * w1[h]; } }
        }
#pragma unroll 4
        for (int r = 0; r < 64; ++r) {
            float wg[6];
#pragma unroll
            for (int hp = 0; hp < 3; ++hp) { const unsigned u = WG[(r * 3 + hp) * 64 + lane]; wg[2 * hp] = __uint_as_float(u << 16); wg[2 * hp + 1] = __uint_as_float(u & 0xffff0000u); }
#pragma unroll
            for (int tt = 0; tt < 2; ++tt) { const float s = rdlane(sgv[tt], r);
#pragma unroll
                for (int h = 0; h < 6; ++h) G[tt][h] += s * wg[h]; }
        }
#pragma unroll
        for (int h = 0; h < 6; ++h) {
            const int c = h * 64 + lane;
            const float a00 = p.in[10][(l * 2 + 0) * RW + c], a01 = p.in[10][(l * 2 + 1) * RW + c], kac = p.in[14][l * RW + c];
            const float rk = p.in[15][(l * 6 + h) * 64 + lane], gng = p.in[16][l * RW + c], gnb = p.in[17][l * RW + c], ng = p.in[6][l * RW + c];
            const float mr0 = mu0[c], mr1 = mu1[c], mk0 = mu0[384 + c], mk1 = mu1[384 + c], mv0 = mu0[768 + c], mv1 = mu1[768 + c];
#pragma unroll
            for (int tt = 0; tt < 2; ++tt) { const int row = row0 + tt, t = row % SEQL; bf16_t* pr = proj + (size_t)row * PS;
                const bool hp = t > 0, hn = t < SEQL - 1; const bf16_t* pp = hp ? pr - PS : pr; const bf16_t* pn = hn ? pr + PS : pr; const float fp = hp ? 1.f : 0.f, fn = hn ? 1.f : 0.f;
                const float rc = bf2f(pr[P_R + c]), rp = fp * bf2f(pp[P_R + c]), rn = fn * bf2f(pn[P_R + c]);
                const float kc = bf2f(pr[P_K + c]), kp = fp * bf2f(pp[P_K + c]), kn = fn * bf2f(pn[P_K + c]);
                const float vc = bf2f(pr[P_V + c]), vp = fp * bf2f(pp[P_V + c]), vn = fn * bf2f(pn[P_V + c]);
                const float rs = rc + mr0 * (rp - rc) + mr1 * (rn - rc);
                const float ks = kc + mk0 * (kp - kc) + mk1 * (kn - kc);
                const float vs = vc + mv0 * (vp - vc) + mv1 * (vn - vc);
                const float a0 = sigmoidf_(a00 + A0[tt][h]), a1 = sigmoidf_(a01 + A1[tt][h]);
                const float kh = ks * (1.f + (0.5f * (a0 + a1) - 1.f) * kac);
                const float bsum = wave_sum(rs * kh * rk);
                const float o = bf2f(o_r[(size_t)row * RW + c]) + bf2f(o_r[((size_t)MROWS + row) * RW + c]);
                const float mean = wave_sum(o) * (1.f / 64.f); const float dlt = o - mean;
                const float var = wave_sum(dlt * dlt) * (1.f / 64.f);
                const float on = dlt * rsqrtf(var + GN_EPS) * gng + gnb;
                const float yr = (on + bsum * vs) * G[tt][h];
                const float oh = bf2f(pr[P_FF + c]) + bf2f(pr[P_FB + c]);
                const float ms = wave_sum(oh * oh) * (1.f / 64.f);
                const float gh = bf2f(pr[P_G + c]);
                const float yh = oh * rsqrtf(ms + RMS_EPS) * ng * (gh * sigmoidf_(gh));
                pr[P_I + c] = (bf16_t)f2bf(yr);
                pr[P_Q + c] = (bf16_t)f2bf(yh);
            }
        }
    }
}

__global__ void __launch_bounds__(512, 2) fwd_mega(Params p) {
    extern __shared__ __attribute__((aligned(16))) unsigned char smem_raw[];
    LAS unsigned char* lds = (LAS unsigned char*)smem_raw;
    cg::grid_group grid = cg::this_grid();
    const int tid = threadIdx.x, wave = tid >> 6, lane = tid & 63;
    const int G = gridDim.x, bid = blockIdx.x;
    const int widx = bid * 8 + wave, nw = G * 8;
    bf16_t* win_t = (bf16_t*)(p.ws + OFF_WIN); bf16_t* wout_t = (bf16_t*)(p.ws + OFF_WOUT); bf16_t* wup_t = (bf16_t*)(p.ws + OFF_WUP); bf16_t* wdn_t = (bf16_t*)(p.ws + OFF_WDN);
    bf16_t* proj = (bf16_t*)(p.ws + OFF_PROJ); bf16_t* xb = (bf16_t*)(p.ws + OFF_T); bf16_t* hid = proj;
    float* x = p.out;
    volatile LAS unsigned* xst = (volatile LAS unsigned*)(lds + 131072);
    if (tid == 0) { xst[0] = 0u; xst[1] = 0u; xst[2] = 0u; xst[3] = 0u; }
    __syncthreads();
    XcdBarrier xbar = xcd_barrier_post((unsigned*)(p.ws + OFF_BAR), xst);

    convert_weights(p, 0, lds, widx, nw);
    for (int row = widx; row < MROWS; row += nw) {
        const float* src = row < 16 * SEQL ? p.in[0] + (size_t)row * D : p.in[1] + (size_t)(row - 16 * SEQL) * D;
        ln_row(src, x + (size_t)row * D, xb + (size_t)row * D, p.in[2], p.in[3], lane);
    }
    grid.sync();
    for (int l = 0; l < DEPTH; ++l) {
        {
            pg8::Gemm g{xb, win_t, MROWS, NINP, D, D}; pg8::StaticOrder S; S.init(MROWS, NINP, G, bid);
            pg8::EpiBf16<0> E{proj + 256, PS};
            for (int rep = 0; rep < REP_GIN; ++rep) pg8::gemm_phase(lds, g, S, E);
        }
        GSYNC();
        for (int rep = 0; rep < REP_SCAN; ++rep) {
            if (bid < 144) rwkv_scan_wg(p, l, (bid & 7) * 18 + (bid >> 3), lds);
            else if (bid < 240) { if (rep == 0) hgrn_scan_wg(p, l, ((bid - 144) & 7) * 12 + ((bid - 144) >> 3), lds); }
            else { }
        }
        GSYNC();
        conv_wg(p, l, bid, G, lds);
        for (int rep = 0; rep < REP_COMB; ++rep) combine_phase(p, l, widx, nw, lds);
        GSYNC();
        {
            pg8::Gemm g{proj, wout_t, MROWS, D, D, PS}; pg8::StaticOrder S; S.init(MROWS, D, G, bid);
            pg8::EpiResid E{x, D, DN_ALPHA};
            pg8::gemm_phase(lds, g, S, E);
        }
        GSYNC();
        for (int row = widx; row < MROWS; row += 2 * nw) {
            const int r1 = row + nw;
            if (r1 < MROWS) ln_row2(x + (size_t)row * D, x + (size_t)r1 * D, x + (size_t)row * D, x + (size_t)r1 * D, xb + (size_t)row * D, xb + (size_t)r1 * D, p.in[23] + l * D, p.in[24] + l * D, lane);
            else ln_row(x + (size_t)row * D, x + (size_t)row * D, xb + (size_t)row * D, p.in[23] + l * D, p.in[24] + l * D, lane); }
        GSYNC();
        for (int third = 0; third < 3; ++third) {
            constexpr int MT = MROWS / 3;
            {   pg8::Gemm g{xb + (size_t)third * MT * D, wup_t, MT, FFN, D, D}; pg8::StaticOrder S; S.init(MT, FFN, G, bid);
                pg8::EpiBf16<1> E{hid, FFN};
                for (int rep = 0; rep < REP_UP; ++rep) pg8::gemm_phase(lds, g, S, E); }
            GSYNC();
            {   pg8::Gemm g{hid, wdn_t, MT, D, FFN, FFN}; pg8::StaticOrder S; S.init(MT, D, G, bid);
                pg8::EpiResid E{x + (size_t)third * MT * D, D, DN_ALPHA};
                pg8::gemm_phase(lds, g, S, E); }
            GSYNC();
        }
        if (l + 1 < DEPTH) convert_weights(p, l + 1, lds, widx, nw);
        for (int row = widx; row < MROWS; row += 2 * nw) {
            const int r1 = row + nw;
            if (r1 < MROWS) ln_row2(x + (size_t)row * D, x + (size_t)r1 * D, x + (size_t)row * D, x + (size_t)r1 * D, xb + (size_t)row * D, xb + (size_t)r1 * D, p.in[27] + l * D, p.in[28] + l * D, lane);
            else ln_row(x + (size_t)row * D, x + (size_t)row * D, xb + (size_t)row * D, p.in[27] + l * D, p.in[28] + l * D, lane); }
        GSYNC();
    }
}

extern "C" void kernel_launch(void* const* d_in, const int* in_sizes, int n_in, void* d_out, int out_size, void* d_ws, size_t ws_size, hipStream_t stream) {
    static int grid = 0;
    if (grid == 0) {
        if (n_in != 29 || out_size != MROWS * D || ws_size < WS_END) { fprintf(stderr, "kernel_launch: unexpected shapes (n_in %d out %d ws %zu need %zu)\n", n_in, out_size, ws_size, (size_t)WS_END); grid = -1; return; }
        int dev = 0, cus = 0, per_cu = 0;
        hipGetDevice(&dev);
        hipDeviceGetAttribute(&cus, hipDeviceAttributeMultiprocessorCount, dev);
        if (hipFuncSetAttribute((const void*)fwd_mega, hipFuncAttributeMaxDynamicSharedMemorySize, LDS_BYTES) != hipSuccess) { fprintf(stderr, "kernel_launch: hipFuncSetAttribute failed\n"); grid = -1; return; }
        hipOccupancyMaxActiveBlocksPerMultiprocessor(&per_cu, (const void*)fwd_mega, 512, LDS_BYTES);
        (void)hipGetLastError();
        if (per_cu < 1) per_cu = 1;
        grid = cus;
        if (grid != 256) fprintf(stderr, "kernel_launch: note: %d CUs\n", grid);
    }
    if (grid < 0) return;
    if (hipMemsetAsync((char*)d_ws + OFF_BAR, 0, SZ_BAR, stream) != hipSuccess) { fprintf(stderr, "kernel_launch: memset failed\n"); return; }
    Params p{};
    for (int i = 0; i < 29; ++i) p.in[i] = (const float*)d_in[i];
    p.out = (float*)d_out; p.ws = (unsigned char*)d_ws;
    void* args[] = {&p};
    hipError_t e = hipLaunchCooperativeKernel((const void*)fwd_mega, dim3(grid), dim3(512), args, LDS_BYTES, stream);
    if (e != hipSuccess) fprintf(stderr, "cooperative launch failed: %s (grid %d)\n", hipGetErrorString(e), grid);
}
```

```cpp
#include <hip/hip_runtime.h>
#include <hip/hip_cooperative_groups.h>
#include <cstdio>
#include <cstdint>
namespace cg = cooperative_groups;

#define LAS __attribute__((address_space(3)))
typedef unsigned short bf16_t;
typedef short bf16x8 __attribute__((ext_vector_type(8)));
typedef float f32x4 __attribute__((ext_vector_type(4)));
typedef unsigned u32x4 __attribute__((ext_vector_type(4)));
typedef unsigned u32x2 __attribute__((ext_vector_type(2)));

constexpr int D = 1024, SEQL = 2048, NSEQ = 24, MROWS = NSEQ * SEQL, DEPTH = 4, FFN = 4096;
constexpr int NIN = 3776, NINP = 3840, PS = 4096;
constexpr int RW = 384, NRW = 1344;
constexpr int P_YC = 0, P_Q = 256, P_I = 640, P_FF = 1024, P_FB = 1408, P_G = 1792;
constexpr int P_RW = 2176, P_R = P_RW, P_K = P_RW + 384, P_V = P_RW + 768, P_WD = P_RW + 1152, P_AD = P_RW + 1216, P_GD = P_RW + 1280;
constexpr int P_CV = 3520, P_CG = 3776;
constexpr float LN_EPS = 1e-5f, RMS_EPS = 1e-6f, GN_EPS = 64e-5f;
constexpr float DN_ALPHA = 1.681792830507429f;

constexpr size_t OFF_WIN = 0, SZ_WIN = (size_t)NINP * D * 2;
constexpr size_t OFF_WOUT = OFF_WIN + SZ_WIN, SZ_WOUT = (size_t)D * D * 2;
constexpr size_t OFF_WUP = OFF_WOUT + SZ_WOUT, SZ_WUP = (size_t)FFN * D * 2;
constexpr size_t OFF_WDN = OFF_WUP + SZ_WUP, SZ_WDN = (size_t)FFN * D * 2;
constexpr size_t OFF_PROJ = OFF_WDN + SZ_WDN, SZ_PROJ = (size_t)MROWS * PS * 2;
constexpr size_t OFF_T = OFF_PROJ + SZ_PROJ, SZ_T = (size_t)MROWS * D * 2;
constexpr size_t OFF_BAR = OFF_T + SZ_T, SZ_BAR = 3456 * 4;
constexpr size_t WS_END = OFF_BAR + SZ_BAR;
constexpr int LDS_BYTES = 131072 + 16;
#define REP_SCAN 1
#define REP_COMB 1
#define REP_GIN 1
#define REP_UP 1
#define REP_SYNC 1
#define GSYNC() do { for (int r_ = 0; r_ < REP_SYNC; ++r_) xcd_barrier(xbar); } while (0)

struct Params {
    const float* in[29];
    float* out;
    unsigned char* ws;
};

__device__ __forceinline__ float bf2f(bf16_t b) { return __uint_as_float(((unsigned)b) << 16); }
__device__ __forceinline__ unsigned f2bf(float f) { unsigned u = __float_as_uint(f); u += 0x7FFFu + ((u >> 16) & 1u); return u >> 16; }
__device__ __forceinline__ unsigned pk2(float lo, float hi) { return f2bf(lo) | (f2bf(hi) << 16); }
__device__ __forceinline__ float dpp_add(float v, const int ctrl_sel) {
    int r;
    switch (ctrl_sel) {
        case 0: r = __builtin_amdgcn_update_dpp(0, __float_as_int(v), 0xB1, 0xF, 0xF, true); break;
        case 1: r = __builtin_amdgcn_update_dpp(0, __float_as_int(v), 0x4E, 0xF, 0xF, true); break;
        case 2: r = __builtin_amdgcn_update_dpp(0, __float_as_int(v), 0x141, 0xF, 0xF, true); break;
        default: r = __builtin_amdgcn_update_dpp(0, __float_as_int(v), 0x140, 0xF, 0xF, true); break;
    }
    return v + __int_as_float(r);
}
__device__ __forceinline__ float wave_sum(float v) {
    v = dpp_add(v, 0); v = dpp_add(v, 1); v = dpp_add(v, 2); v = dpp_add(v, 3);
    { auto r = __builtin_amdgcn_permlane16_swap(__float_as_uint(v), __float_as_uint(v), false, false); v = __uint_as_float(r[0]) + __uint_as_float(r[1]); }
    { auto r = __builtin_amdgcn_permlane32_swap(__float_as_uint(v), __float_as_uint(v), false, false); v = __uint_as_float(r[0]) + __uint_as_float(r[1]); }
    return v;
}
__device__ __forceinline__ int opaque_tid() { int t = threadIdx.x; asm volatile("" : "+v"(t)); return t; }
__device__ __forceinline__ float sigmoidf_(float x) { return 1.0f / (1.0f + __expf(-x)); }
__device__ __forceinline__ float rdlane(float v, int l) { return __int_as_float(__builtin_amdgcn_readlane(__float_as_int(v), l)); }

#define XB_TMO      128
#define XB_XCNT(j)  (256  + 64 * (j))
#define XB_XSUB(j)  (1280 + 64 * (j))
#define XB_XGEN(j)  (2304 + 64 * (j))
#define XB_TOP      3328
#define XB_TOPGEN   3392
#define XCD_BAR_WORDS 3456
#define XB_SPIN_CAP (1u << 22)
__device__ __forceinline__ unsigned xb_ld(unsigned* p)              { return __hip_atomic_load(p, __ATOMIC_RELAXED, __HIP_MEMORY_SCOPE_AGENT); }
__device__ __forceinline__ unsigned xb_add(unsigned* p, unsigned v) { return __hip_atomic_fetch_add(p, v, __ATOMIC_RELAXED, __HIP_MEMORY_SCOPE_AGENT); }
__device__ __forceinline__ unsigned xb_xcc_id() { return (unsigned)__builtin_amdgcn_s_getreg((3 << 11) | 20) & 0xFu; }
#define XB_SPIN(cond, bar) do { unsigned _sp = 0; while (cond) { __builtin_amdgcn_s_sleep(1); \
    if ((++_sp & 255u) == 0u) { if (xb_ld(&(bar)[XB_TMO])) break; if (_sp > XB_SPIN_CAP) { atomicAdd(&(bar)[XB_TMO], 1u); break; } } } } while (0)
struct XcdBarrier { unsigned* bar; unsigned x; volatile LAS unsigned* st; };
__device__ __forceinline__ XcdBarrier xcd_barrier_post(unsigned* bar, volatile LAS unsigned* st) {
    XcdBarrier b; b.bar = bar; b.x = xb_xcc_id(); b.st = st;
    if (threadIdx.x == 0) (void)xb_add(&bar[XB_XCNT(b.x)], 1u);
    return b;
}
__device__ __forceinline__ void xcd_barrier_complete(unsigned* bar, unsigned x, unsigned& nloc, unsigned& nx) {
    const unsigned G = gridDim.x * gridDim.y * gridDim.z;
    unsigned sum, cnt, mine, sp = 0u;
    for (;;) {
        sum = 0u; cnt = 0u; mine = 0u;
#pragma unroll
        for (unsigned j = 0; j < 16; ++j) { const unsigned c = xb_ld(&bar[XB_XCNT(j)]); sum += c; cnt += (c > 0u) ? 1u : 0u; mine = (j == x) ? c : mine; }
        if (sum == G) break;
        __builtin_amdgcn_s_sleep(1);
        if ((++sp & 255u) == 0u) { if (xb_ld(&bar[XB_TMO])) break; if (sp > XB_SPIN_CAP) { atomicAdd(&bar[XB_TMO], 1u); break; } }
    }
    nloc = mine > 0u ? mine : 1u; nx = cnt > 0u ? cnt : 1u;
}
__device__ __forceinline__ void xcd_barrier(const XcdBarrier& b) {
    asm volatile("s_waitcnt vmcnt(0)" ::: "memory");
    __syncthreads();
    if (threadIdx.x == 0) {
        unsigned* bar = b.bar;
        __builtin_amdgcn_s_waitcnt(0);
        unsigned nloc = b.st[0], nx = b.st[1];
        if (nloc == 0u) { xcd_barrier_complete(bar, b.x, nloc, nx); b.st[0] = nloc; b.st[1] = nx; }
        const unsigned old = xb_add(&bar[XB_XSUB(b.x)], 1u);
        const unsigned gen = old / nloc;
        if (old + 1u == (gen + 1u) * nloc) {
            __builtin_amdgcn_fence(__ATOMIC_RELEASE, "agent");
            asm volatile("s_waitcnt vmcnt(0)" ::: "memory");
            const unsigned og = xb_add(&bar[XB_TOP], 1u);
            const unsigned tg = og / nx;
            if (og + 1u == (tg + 1u) * nx) xb_add(&bar[XB_TOPGEN], 1u);
            else XB_SPIN(xb_ld(&bar[XB_TOPGEN]) == tg, bar);
            __builtin_amdgcn_fence(__ATOMIC_ACQUIRE, "agent");
            xb_add(&bar[XB_XGEN(b.x)], 1u);
            asm volatile("s_waitcnt vmcnt(0)" ::: "memory");
        } else {
            XB_SPIN(xb_ld(&bar[XB_XGEN(b.x)]) == gen, bar);
            __builtin_amdgcn_fence(__ATOMIC_ACQUIRE, "agent");
            asm volatile("s_waitcnt vmcnt(0)" ::: "memory");
        }
    }
    __syncthreads();
}

namespace pg8 {
constexpr int BM = 256, BK = 64, HALF = 128, HTB = HALF * BK * 2, STAGE_BYTES = 8 * HTB, NXCD = 8, WGM = 8;
__device__ __forceinline__ int lds_byte(int r, int c) { const int st = (r >> 4) * 2 + (c >> 5), rr = r & 15, cc = c & 31, ob = rr * 64 + cc * 2; return st * 1024 + (ob ^ (((ob >> 9) & 1) << 5)); }
__device__ __forceinline__ void stage_rc(int b, int& R, int& C) { const int st = b / 1024, sb = b % 1024, swz = sb ^ (((sb >> 9) & 1) << 5); R = (st >> 1) * 16 + swz / 64; C = (st & 1) * 32 + (swz % 64) / 2; }
__device__ __forceinline__ int perm32(int rho) { const int n = rho >> 4, i = rho & 15; return 8 * (i >> 2) + 4 * n + (i & 3); }
struct Unit { int pm, pn; };
struct Gemm { const bf16_t* A; const bf16_t* Bt; int M, N, K, lda; };
struct StaticOrder {
    int nM, nN, nwg, G, c;
    __device__ void init(int M, int N, int G_, int c_) { nM = M / BM; nN = N / BM; nwg = nM * nN; G = G_; c = c_; }
    __device__ bool next(int i, Unit& u) const {
        const long L = (long)i * G + c; if (L >= nwg) return false;
        int wgid = (int)L; { const int q = nwg / NXCD, r = nwg % NXCD, xcd = wgid % NXCD, off = wgid / NXCD; wgid = (xcd < r ? xcd * (q + 1) : r * (q + 1) + (xcd - r) * q) + off; }
        const int nig = WGM * nN, gid = wgid / nig, fm = gid * WGM, gsz = (nM - fm) < WGM ? (nM - fm) : WGM;
        u.pm = fm + ((wgid % nig) % gsz); u.pn = (wgid % nig) / gsz; return true;
    }
};
__device__ __forceinline__ unsigned cvt_pk_bf16(float lo, float hi) { unsigned r; asm volatile("v_cvt_pk_bf16_f32 %0, %1, %2" : "=v"(r) : "v"(lo), "v"(hi)); return r; }

template <int ACT  > struct EpiBf16 {
    static constexpr bool PERM = true;
    bf16_t* O; int ldc;
    __device__ __forceinline__ void operator()(const f32x4 (&acc)[2][2][4][2], const Unit& u, int wr, int wc, int fr, int fq) const {
        const int row0 = u.pm * BM + wr * 64 + fr; const int col0 = u.pn * BM + wc * 32 + 8 * fq;
#pragma unroll
        for (int ai = 0; ai < 2; ++ai)
#pragma unroll
            for (int m = 0; m < 4; ++m) { bf16_t* rowp = O + (size_t)(row0 + ai * HALF + m * 16) * ldc + col0;
#pragma unroll
                for (int bj = 0; bj < 2; ++bj) { f32x4 v0 = acc[ai][bj][m][0], v1 = acc[ai][bj][m][1];
                    if (ACT == 1) {
#pragma unroll
                        for (int j = 0; j < 4; ++j) { float a = fmaxf(v0[j], 0.f), b = fmaxf(v1[j], 0.f); v0[j] = a * a; v1[j] = b * b; } }
                    u32x4 w; w.x = cvt_pk_bf16(v0[0], v0[1]); w.y = cvt_pk_bf16(v0[2], v0[3]); w.z = cvt_pk_bf16(v1[0], v1[1]); w.w = cvt_pk_bf16(v1[2], v1[3]);
                    *(u32x4*)(rowp + bj * HALF) = w; } }
    }
};
struct EpiResid {
    static constexpr bool PERM = false;
    float* C; int ldc; float alpha;
    __device__ __forceinline__ void operator()(const f32x4 (&acc)[2][2][4][2], const Unit& u, int wr, int wc, int fr, int fq) const {
        const int row0 = u.pm * BM + wr * 64 + fr, col0 = u.pn * BM + wc * 32 + 4 * fq;
#pragma unroll
        for (int ai = 0; ai < 2; ++ai)
#pragma unroll
            for (int m = 0; m < 4; ++m) { float* rowp = C + (size_t)(row0 + ai * HALF + m * 16) * ldc + col0;
                f32x4 old[2][2];
#pragma unroll
                for (int bj = 0; bj < 2; ++bj)
#pragma unroll
                    for (int n = 0; n < 2; ++n) old[bj][n] = *(const f32x4*)(rowp + bj * HALF + n * 16);
#pragma unroll
                for (int bj = 0; bj < 2; ++bj)
#pragma unroll
                    for (int n = 0; n < 2; ++n) *(f32x4*)(rowp + bj * HALF + n * 16) = old[bj][n] * alpha + acc[ai][bj][m][n]; }
    }
};

template <class Epi, class Sched>
__device__ __forceinline__ void gemm_phase(LAS unsigned char* lds, const Gemm g, const Sched& S, const Epi& E) {
    const int tid = opaque_tid(), wid = __builtin_amdgcn_readfirstlane(tid >> 6), lane = tid & 63, wr = wid >> 2, wc = wid & 3, fr = lane & 15, fq = lane >> 4;
    const int K = g.K, nt = K / BK, lda = g.lda;
    unsigned voffA[2], voffB[2];
#pragma unroll
    for (int i = 0; i < 2; ++i) { int R, C; stage_rc(tid * 16 + i * 8192, R, C); const int Rb = Epi::PERM ? ((R & ~31) + perm32(R & 31)) : R;
        voffA[i] = (unsigned)(R * lda + C) * 2u; voffB[i] = (unsigned)(Rb * K + C) * 2u; }
    const size_t kstep = (size_t)(BK * 2);
    const size_t hstepA = (size_t)HALF * lda * 2, hstepB = (size_t)HALF * K * 2;
    const size_t tstepA = 2 * hstepA, tstepB = 2 * hstepB;
    const unsigned ldsw = (unsigned)wid * 1024u;
    const int aoff = lds_byte(wr * 64 + fr, fq * 8), boff = lds_byte(wc * 32 + fr, fq * 8);
#define PG8_SA(b, h) (((b) * 2 + (h)) * HTB)
#define PG8_SB(b, h) ((4 + (b) * 2 + (h)) * HTB)
#define PG8_STAGE(bufoff, gbase, voff) do { _Pragma("unroll") for (int _i = 0; _i < 2; ++_i) \
        __builtin_amdgcn_global_load_lds((const unsigned*)((const char*)(gbase) + (voff)[_i]), (LAS unsigned*)(lds + (bufoff) + ldsw + _i * 8192), 16, 0, 0); } while (0)
#define PG8_LDA(dst, b, h) do { _Pragma("unroll") for (int m = 0; m < 4; ++m) _Pragma("unroll") for (int k = 0; k < 2; ++k) dst[m][k] = *(const LAS bf16x8*)(lds + PG8_SA(b, h) + aoff + m * 2048 + k * 1024); } while (0)
#define PG8_LDB(dst, b, h) do { _Pragma("unroll") for (int n = 0; n < 2; ++n) _Pragma("unroll") for (int k = 0; k < 2; ++k) dst[n][k] = *(const LAS bf16x8*)(lds + PG8_SB(b, h) + boff + n * 2048 + k * 1024); } while (0)
#define PG8_MMA(ai, bj, At, Bt) do { __builtin_amdgcn_s_setprio(1); _Pragma("unroll") for (int m = 0; m < 4; ++m) _Pragma("unroll") for (int n = 0; n < 2; ++n) _Pragma("unroll") for (int k = 0; k < 2; ++k) \
        acc[ai][bj][m][n] = __builtin_amdgcn_mfma_f32_16x16x32_bf16(Bt[n][k], At[m][k], acc[ai][bj][m][n], 0, 0, 0); __builtin_amdgcn_s_setprio(0); } while (0)
#define PG8_WAIT_V(n) asm volatile("s_waitcnt vmcnt(" #n ")" ::: "memory")
#define PG8_WAIT_L(n) asm volatile("s_waitcnt lgkmcnt(" #n ")" ::: "memory")
#define PG8_BAR __builtin_amdgcn_s_barrier()
#define PG8_SCHED __builtin_amdgcn_sched_barrier(0)
    Unit cur, nxt; int ui = 0;
    if (!S.next(0, cur)) return;
    f32x4 acc[2][2][4][2];
#pragma unroll
    for (int a = 0; a < 2; ++a)
#pragma unroll
        for (int b = 0; b < 2; ++b)
#pragma unroll
            for (int m = 0; m < 4; ++m)
#pragma unroll
                for (int n = 0; n < 2; ++n) acc[a][b][m][n] = (f32x4){0.f, 0.f, 0.f, 0.f};
    bf16x8 At[4][2], B0[2][2], B1[2][2];
    const char* cA = (const char*)g.A + (size_t)cur.pm * tstepA; const char* cB = (const char*)g.Bt + (size_t)cur.pn * tstepB;
    PG8_STAGE(PG8_SB(0, 0), cB, voffB); PG8_STAGE(PG8_SB(0, 1), cB + hstepB, voffB); PG8_STAGE(PG8_SA(0, 0), cA, voffA); PG8_STAGE(PG8_SA(0, 1), cA + hstepA, voffA);
    if (wr == 1) PG8_BAR;
    PG8_WAIT_V(2); PG8_BAR;
    PG8_STAGE(PG8_SB(1, 0), cB + kstep, voffB); PG8_STAGE(PG8_SA(1, 0), cA + kstep, voffA); PG8_STAGE(PG8_SB(1, 1), cB + hstepB + kstep, voffB);
    PG8_WAIT_V(6); PG8_BAR;
    for (;;) {
        const bool has_next = S.next(ui + 1, nxt);
        const char* nA = has_next ? (const char*)g.A + (size_t)nxt.pm * tstepA : cA; const char* nB = has_next ? (const char*)g.Bt + (size_t)nxt.pn * tstepB : cB;
        for (int t = 0; t < nt; t += 2) {
            const bool last = (t == nt - 2);
            const char* a1 = cA + (size_t)(t + 1) * kstep;
            const char* a2 = last ? nA : cA + (size_t)(t + 2) * kstep; const char* b2 = last ? nB : cB + (size_t)(t + 2) * kstep;
            const char* a3 = a2 + kstep; const char* b3 = b2 + kstep;
            PG8_LDB(B0, 0, 0); PG8_LDB(B1, 0, 1); PG8_SCHED; PG8_LDA(At, 0, 0); PG8_STAGE(PG8_SA(1, 1), a1 + hstepA, voffA);
            PG8_WAIT_V(8); PG8_WAIT_L(0); PG8_BAR; PG8_MMA(0, 0, At, B0); PG8_MMA(0, 1, At, B1); PG8_BAR; PG8_SCHED;
            PG8_LDA(At, 0, 1); PG8_STAGE(PG8_SB(0, 0), b2, voffB); PG8_STAGE(PG8_SB(0, 1), b2 + hstepB, voffB); PG8_STAGE(PG8_SA(0, 0), a2, voffA);
            PG8_WAIT_V(8); PG8_WAIT_L(0); PG8_BAR; PG8_MMA(1, 0, At, B0); PG8_MMA(1, 1, At, B1); PG8_BAR; PG8_SCHED;
            PG8_LDB(B0, 1, 0); PG8_LDB(B1, 1, 1); PG8_SCHED; PG8_LDA(At, 1, 0); PG8_STAGE(PG8_SA(0, 1), a2 + hstepA, voffA);
            PG8_WAIT_V(8); PG8_WAIT_L(0); PG8_BAR; PG8_MMA(0, 0, At, B0); PG8_MMA(0, 1, At, B1); PG8_BAR; PG8_SCHED;
            PG8_LDA(At, 1, 1); PG8_STAGE(PG8_SB(1, 0), b3, voffB); PG8_STAGE(PG8_SB(1, 1), b3 + hstepB, voffB); PG8_STAGE(PG8_SA(1, 0), a3, voffA);
            PG8_WAIT_V(8); PG8_WAIT_L(0); PG8_BAR; PG8_MMA(1, 0, At, B0); PG8_MMA(1, 1, At, B1); PG8_BAR; PG8_SCHED;
        }
        if (wr == 0) PG8_BAR;
        E(acc, cur, wr, wc, fr, fq);
        if (!has_next) break;
#pragma unroll
        for (int a = 0; a < 2; ++a)
#pragma unroll
            for (int b = 0; b < 2; ++b)
#pragma unroll
                for (int m = 0; m < 4; ++m)
#pragma unroll
                    for (int n = 0; n < 2; ++n) acc[a][b][m][n] = (f32x4){0.f, 0.f, 0.f, 0.f};
        cur = nxt; cA = nA; cB = nB; ++ui;
        if (wr == 1) PG8_BAR;
    }
    PG8_WAIT_V(0);
    PG8_BAR;
#undef PG8_SA
#undef PG8_SB
#undef PG8_STAGE
#undef PG8_LDA
#undef PG8_LDB
#undef PG8_MMA
#undef PG8_WAIT_V
#undef PG8_WAIT_L
#undef PG8_BAR
#undef PG8_SCHED
}
}

__device__ __forceinline__ void transpose_item(const float* W, int Nsrc, int ksrc0, int nsrc0, bf16_t* WT, int K, int k0, int n0, LAS float* scr, int lane) {
#pragma unroll 8
    for (int i = 0; i < 32; ++i) { const int kk = 2 * i + (lane >> 5);
        scr[kk * 33 + (lane & 31)] = nsrc0 >= 0 ? W[(size_t)(ksrc0 + kk) * Nsrc + nsrc0 + (lane & 31)] : 0.f; }
    asm volatile("s_waitcnt lgkmcnt(0)" ::: "memory");
    const int c = lane & 7;
#pragma unroll
    for (int j = 0; j < 4; ++j) { const int n = (lane >> 3) + 8 * j; const LAS float* s = scr + (8 * c) * 33 + n;
        u32x4 o; o.x = pk2(s[0 * 33], s[1 * 33]); o.y = pk2(s[2 * 33], s[3 * 33]); o.z = pk2(s[4 * 33], s[5 * 33]); o.w = pk2(s[6 * 33], s[7 * 33]);
        *(u32x4*)(WT + (size_t)(n0 + n) * K + k0 + 8 * c) = o; }
    asm volatile("s_waitcnt lgkmcnt(0)" ::: "memory");
}
__device__ __forceinline__ int win_colmap(int n0) {
    if (n0 < 384) return n0;
    if (n0 < 768) return 1152 + (n0 - 384);
    if (n0 < 1152) return 384 + (n0 - 768);
    if (n0 < 1536) return 768 + (n0 - 1152);
    if (n0 < NIN) return n0;
    return -1;
}
__device__ __forceinline__ void convert_weights(const Params& p, int l, LAS unsigned char* lds, int widx, int nw) {
    const int tid_ = opaque_tid(); const int wave = tid_ >> 6, lane = tid_ & 63;
    LAS float* scr = (LAS float*)(lds + wave * 8448);
    bf16_t* win_t = (bf16_t*)(p.ws + OFF_WIN); bf16_t* wout_t = (bf16_t*)(p.ws + OFF_WOUT); bf16_t* wup_t = (bf16_t*)(p.ws + OFF_WUP); bf16_t* wdn_t = (bf16_t*)(p.ws + OFF_WDN);
    const float* w_in = p.in[5] + (size_t)l * D * NIN; const float* w_out = p.in[22] + (size_t)l * D * D;
    const float* w_up = p.in[25] + (size_t)l * D * FFN; const float* w_dn = p.in[26] + (size_t)l * FFN * D;
    constexpr int I_IN = (D / 64) * (NINP / 32), I_OUT = (D / 64) * (D / 32), I_UP = (D / 64) * (FFN / 32), I_DN = (FFN / 64) * (D / 32);
    for (int it = widx; it < I_IN + I_OUT + I_UP + I_DN; it += nw) {
        int r = it;
        if (r < I_IN) { const int nb = NINP / 32, kb = r / nb, n0 = (r % nb) * 32; transpose_item(w_in, NIN, kb * 64, win_colmap(n0), win_t, D, kb * 64, n0, scr, lane); continue; } r -= I_IN;
        if (r < I_OUT) { const int nb = D / 32, kb = r / nb, n0 = (r % nb) * 32, k0 = kb * 64; const int ks = k0 < 256 ? 768 + k0 : k0 - 256;
            transpose_item(w_out, D, ks, n0, wout_t, D, k0, n0, scr, lane); continue; } r -= I_OUT;
        if (r < I_UP) { const int nb = FFN / 32, kb = r / nb, n0 = (r % nb) * 32; transpose_item(w_up, FFN, kb * 64, n0, wup_t, D, kb * 64, n0, scr, lane); continue; } r -= I_UP;
        { const int nb = D / 32, kb = r / nb, n0 = (r % nb) * 32; transpose_item(w_dn, D, kb * 64, n0, wdn_t, FFN, kb * 64, n0, scr, lane); }
    }
}

__device__ __forceinline__ void ln_row(const float* src, float* dst32, bf16_t* dstb, const float* g, const float* b, int lane_) {
    int lane = lane_; asm volatile("" : "+v"(lane));
    const f32x4* xr = (const f32x4*)src + lane;
    f32x4 v[4]; float s = 0.f;
#pragma unroll
    for (int j = 0; j < 4; ++j) { v[j] = xr[64 * j]; s += (v[j].x + v[j].y) + (v[j].z + v[j].w); }
    const float mean = wave_sum(s) * (1.f / D); float s2 = 0.f;
#pragma unroll
    for (int j = 0; j < 4; ++j) { v[j] = v[j] - mean; s2 += (v[j].x * v[j].x + v[j].y * v[j].y) + (v[j].z * v[j].z + v[j].w * v[j].w); }
    const float rstd = rsqrtf(wave_sum(s2) * (1.f / D) + LN_EPS);
#pragma unroll
    for (int j = 0; j < 4; ++j) {
        const f32x4 gg = ((const f32x4*)g)[lane + 64 * j], bb = ((const f32x4*)b)[lane + 64 * j];
        f32x4 o = v[j] * rstd * gg + bb;
        ((f32x4*)dst32)[lane + 64 * j] = o;
        u32x2 w; w.x = pk2(o.x, o.y); w.y = pk2(o.z, o.w);
        ((u32x2*)dstb)[lane + 64 * j] = w;
    }
}

__device__ __forceinline__ void ln_row2(const float* src0, const float* src1, float* d0, float* d1, bf16_t* b0, bf16_t* b1, const float* g, const float* b, int lane_) {
    int lane = lane_; asm volatile("" : "+v"(lane));
    const f32x4* x0 = (const f32x4*)src0 + lane; const f32x4* x1 = (const f32x4*)src1 + lane;
    f32x4 v[4], u[4]; float s = 0.f, t = 0.f;
#pragma unroll
    for (int j = 0; j < 4; ++j) { v[j] = x0[64 * j]; u[j] = x1[64 * j]; }
#pragma unroll
    for (int j = 0; j < 4; ++j) { s += (v[j].x + v[j].y) + (v[j].z + v[j].w); t += (u[j].x + u[j].y) + (u[j].z + u[j].w); }
    const float m0 = wave_sum(s) * (1.f / D), m1 = wave_sum(t) * (1.f / D); float s2 = 0.f, t2 = 0.f;
#pragma unroll
    for (int j = 0; j < 4; ++j) { v[j] = v[j] - m0; u[j] = u[j] - m1; s2 += (v[j].x * v[j].x + v[j].y * v[j].y) + (v[j].z * v[j].z + v[j].w * v[j].w); t2 += (u[j].x * u[j].x + u[j].y * u[j].y) + (u[j].z * u[j].z + u[j].w * u[j].w); }
    const float r0 = rsqrtf(wave_sum(s2) * (1.f / D) + LN_EPS), r1 = rsqrtf(wave_sum(t2) * (1.f / D) + LN_EPS);
#pragma unroll
    for (int j = 0; j < 4; ++j) {
        const f32x4 gg = ((const f32x4*)g)[lane + 64 * j], bb = ((const f32x4*)b)[lane + 64 * j];
        const f32x4 o0 = v[j] * r0 * gg + bb, o1 = u[j] * r1 * gg + bb;
        ((f32x4*)d0)[lane + 64 * j] = o0; ((f32x4*)d1)[lane + 64 * j] = o1;
        u32x2 w0, w1; w0.x = pk2(o0.x, o0.y); w0.y = pk2(o0.z, o0.w); w1.x = pk2(o1.x, o1.y); w1.y = pk2(o1.z, o1.w);
        ((u32x2*)b0)[lane + 64 * j] = w0; ((u32x2*)b1)[lane + 64 * j] = w1;
    }
}

#define DSR128(dst, addr, off) asm volatile("ds_read_b128 %0, %1 offset:%2" : "=v"(dst) : "v"(addr), "n"(off))
#define DSR32(dst, addr, off) asm volatile("ds_read_b32 %0, %1 offset:%2" : "=v"(dst) : "v"(addr), "n"(off))
#define LGKM0() do { asm volatile("s_waitcnt lgkmcnt(0)" ::: "memory"); __builtin_amdgcn_sched_barrier(0); } while (0)
#define SCHEDB __builtin_amdgcn_sched_barrier(0)
#define WAVE_FENCE() do { __builtin_amdgcn_fence(__ATOMIC_RELEASE, "wavefront"); __builtin_amdgcn_wave_barrier(); __builtin_amdgcn_fence(__ATOMIC_ACQUIRE, "wavefront"); } while (0)
__device__ __forceinline__ float xsum32(float x) { auto r = __builtin_amdgcn_permlane32_swap(__float_as_uint(x), __float_as_uint(x), false, false); return __uint_as_float(r[0]) + __uint_as_float(r[1]); }
__device__ __forceinline__ float xsum16(float x) { auto r = __builtin_amdgcn_permlane16_swap(__float_as_uint(x), __float_as_uint(x), false, false); return __uint_as_float(r[0]) + __uint_as_float(r[1]); }

constexpr int RTC = 32;
#define RW_ISSUE(BUF, bk, bv, vvn) do { \
    DSR128(BUF[0], bk, 0); DSR128(BUF[1], bk, 16); DSR128(BUF[2], bk, 32); DSR128(BUF[3], bk, 48); \
    DSR128(BUF[4], bk, 256); DSR128(BUF[5], bk, 272); DSR128(BUF[6], bk, 288); DSR128(BUF[7], bk, 304); \
    DSR128(BUF[8], bk, 512); DSR128(BUF[9], bk, 528); DSR128(BUF[10], bk, 544); DSR128(BUF[11], bk, 560); \
    DSR128(BUF[12], bk, 768); DSR128(BUF[13], bk, 784); DSR128(BUF[14], bk, 800); DSR128(BUF[15], bk, 816); \
    DSR32(vvn, bv, 1024); } while (0)
#define RW_COMPUTE(BUF) do { \
    f32x4 sacc = S4[0] * BUF[0] + S4[1] * BUF[1]; sacc += S4[2] * BUF[2] + S4[3] * BUF[3]; \
    const float sa = xsum16(xsum32((sacc.x + sacc.y) + (sacc.z + sacc.w))); \
    f32x4 oacc = (f32x4){0.f, 0.f, 0.f, 0.f}; \
    _Pragma("unroll") for (int i_ = 0; i_ < 4; ++i_) { f32x4 sv = S4[i_] + (sa * BUF[4 + i_] + vv * BUF[8 + i_]); S4[i_] = sv; oacc += sv * BUF[12 + i_]; } \
    oval = xsum16(xsum32((oacc.x + oacc.y) + (oacc.z + oacc.w))); } while (0)

#define RW7_ISSUE(BUF, bk, bv, va, vb) do { \
    DSR128(BUF[0], bk, 0); DSR128(BUF[1], bk, 16); DSR128(BUF[2], bk, 32); DSR128(BUF[3], bk, 48); \
    DSR128(BUF[4], bk, 256); DSR128(BUF[5], bk, 272); DSR128(BUF[6], bk, 288); DSR128(BUF[7], bk, 304); \
    DSR128(BUF[8], bk, 512); DSR128(BUF[9], bk, 528); DSR128(BUF[10], bk, 544); DSR128(BUF[11], bk, 560); \
    DSR128(BUF[12], bk, 768); DSR128(BUF[13], bk, 784); DSR128(BUF[14], bk, 800); DSR128(BUF[15], bk, 816); \
    DSR32(va, bv, 1024); DSR32(vb, bv, 1088); } while (0)
#define RW7_COMPUTE(BUF) do { \
    f32x4 sa0 = S4[0] * BUF[0] + S4[1] * BUF[1]; sa0 += S4[2] * BUF[2] + S4[3] * BUF[3]; \
    f32x4 sa1 = S4[4] * BUF[0] + S4[5] * BUF[1]; sa1 += S4[6] * BUF[2] + S4[7] * BUF[3]; \
    const float sA = xsum16(xsum32((sa0.x + sa0.y) + (sa0.z + sa0.w))), sB = xsum16(xsum32((sa1.x + sa1.y) + (sa1.z + sa1.w))); \
    f32x4 oa0 = (f32x4){0.f, 0.f, 0.f, 0.f}, oa1 = (f32x4){0.f, 0.f, 0.f, 0.f}; \
    _Pragma("unroll") for (int i_ = 0; i_ < 4; ++i_) { \
        f32x4 s0 = S4[i_] + (sA * BUF[4 + i_] + vv0 * BUF[8 + i_]); S4[i_] = s0; oa0 += s0 * BUF[12 + i_]; \
        f32x4 s1 = S4[4 + i_] + (sB * BUF[4 + i_] + vv1 * BUF[8 + i_]); S4[4 + i_] = s1; oa1 += s1 * BUF[12 + i_]; } \
    oval0 = xsum16(xsum32((oa0.x + oa0.y) + (oa0.z + oa0.w))); oval1 = xsum16(xsum32((oa1.x + oa1.y) + (oa1.z + oa1.w))); } while (0)

__device__ __forceinline__ void rwkv_scan_wg(const Params& p, int l, int pairIdx, LAS unsigned char* lds) {
    const int tid = opaque_tid(), wave = tid >> 6, lane = tid & 63;
    const int b = pairIdx / 6, h = pairIdx % 6;
    constexpr int CT = 16, NCH = SEQL / CT;
    LAS float* ring = (LAS float*)lds;
    LAS float* lam = (LAS float*)(lds + 81920);
    const bf16_t* proj = (const bf16_t*)(p.ws + OFF_PROJ);
    bf16_t* o_r = (bf16_t*)(p.ws + OFF_T);
    if (wave < 4) {
        const int dir = wave >> 1, half = wave & 1;
        const int kp = lane >> 4, row = lane & 15, v0 = half * 32 + row;
        f32x4 S4[8];
#pragma unroll
        for (int k = 0; k < 8; ++k) S4[k] = (f32x4){0.f, 0.f, 0.f, 0.f};
        f32x4 A[16], B[16]; float vv0 = 0.f, vv1 = 0.f, vn0 = 0.f, vn1 = 0.f, oval0 = 0.f, oval1 = 0.f;
        const unsigned ring_base = (unsigned)(unsigned long long)ring, lam_base = (unsigned)(unsigned long long)lam;
        bf16_t* orow = o_r + ((size_t)dir * MROWS + (size_t)b * SEQL) * RW + h * 64 + v0;
        __syncthreads();
        for (int chunk = 0; chunk < NCH; ++chunk) {
            const unsigned rb = ring_base + (unsigned)((((chunk & 1) * 2 + dir) * CT) * 1280);
            const unsigned offk = rb + kp * 64, offv = rb + v0 * 4;
            const unsigned lam_addr = lam_base + (unsigned)((((chunk & 1) * 2 + dir) * 2) * 256) + kp * 64;
            RW7_ISSUE(A, offk, offv, vn0, vn1);
#pragma unroll 1
            for (int sub = 0; sub < 2; ++sub) {
#pragma unroll 1
                for (int it = 0; it < 4; ++it) {
                    const int sl = sub * 8 + it * 2;
                    const unsigned bk1 = offk + (sl + 1) * 1280, bv1 = offv + (sl + 1) * 1280, bk2 = bk1 + 1280, bv2 = bv1 + 1280;
                    const int s = chunk * CT + sl;
                    LGKM0(); vv0 = vn0; vv1 = vn1; RW7_ISSUE(B, bk1, bv1, vn0, vn1); SCHEDB; RW7_COMPUTE(A); SCHEDB;
                    if (kp == 0) { const int t = dir ? SEQL - 1 - s : s; orow[(size_t)t * RW] = (bf16_t)f2bf(oval0); orow[(size_t)t * RW + 16] = (bf16_t)f2bf(oval1); }
                    LGKM0(); vv0 = vn0; vv1 = vn1; RW7_ISSUE(A, bk2, bv2, vn0, vn1); SCHEDB; RW7_COMPUTE(B); SCHEDB;
                    if (kp == 0) { const int t = dir ? SEQL - 2 - s : s + 1; orow[(size_t)t * RW] = (bf16_t)f2bf(oval0); orow[(size_t)t * RW + 16] = (bf16_t)f2bf(oval1); }
                }
                {   f32x4 L0, L1, L2, L3; const unsigned la = lam_addr + sub * 256;
                    DSR128(L0, la, 0); DSR128(L1, la, 16); DSR128(L2, la, 32); DSR128(L3, la, 48);
                    LGKM0();
                    S4[0] *= L0; S4[1] *= L1; S4[2] *= L2; S4[3] *= L3; S4[4] *= L0; S4[5] *= L1; S4[6] *= L2; S4[7] *= L3; SCHEDB; }
            }
            LGKM0();
            __syncthreads();
        }
    } else {
        const int dir = (wave - 4) >> 1, sub = (wave - 4) & 1;
        const int c = h * 64 + lane;
        const float w0c = p.in[8][(l * 2 + dir) * RW + c], a0c = p.in[10][(l * 2 + dir) * RW + c];
        const float kkc = p.in[13][l * RW + c], kac = p.in[14][l * RW + c];
        const float* mu0 = p.in[7] + (size_t)(l * 2 + 0) * NRW; const float* mu1 = mu0 + NRW;
        const float mr0 = mu0[c], mr1 = mu1[c], mk0 = mu0[384 + c], mk1 = mu1[384 + c], mv0 = mu0[768 + c], mv1 = mu1[768 + c];
        const int lcol = lane < 32 ? 1152 + dir * 32 + lane : 1216 + dir * 32 + (lane - 32);
        const float ml0 = mu0[lcol], ml1 = mu1[lcol];
        bf16x8 Bw[4], Ba[4];
        {   const float* wu = p.in[9] + (size_t)((l * 2 + dir) * 32) * RW + h * 64 + (lane & 15); const float* au = p.in[11] + (size_t)((l * 2 + dir) * 32) * RW + h * 64 + (lane & 15);
#pragma unroll
            for (int ct = 0; ct < 4; ++ct)
#pragma unroll
                for (int jj = 0; jj < 8; ++jj) { const int r = (lane >> 4) * 8 + jj;
                    Bw[ct][jj] = (short)f2bf(wu[(size_t)r * RW + ct * 16]); Ba[ct][jj] = (short)f2bf(au[(size_t)r * RW + ct * 16]); } }
        LAS unsigned short* xs = (LAS unsigned short*)(lds + 83968 + (wave - 4) * 4096);
        unsigned pfd = 0u;
        for (int chunk = 0; chunk <= NCH; ++chunk) {
            if (chunk < NCH) {
                asm volatile("s_waitcnt vmcnt(0)" : "+v"(pfd) :: "memory");
                const int s0 = chunk * CT + sub * 8;
                const int tlo = dir ? SEQL - 8 - s0 : s0;
                float rr[10], rk_[10], rv[10], rl[10];
#pragma unroll
                for (int q = 0; q < 10; ++q) {
                    const int tr = tlo - 1 + q; const bool ok = (tr >= 0) && (tr < SEQL);
                    const bf16_t* pr = proj + ((size_t)b * SEQL + (ok ? tr : 0)) * PS; const float m = ok ? 1.f : 0.f;
                    rr[q] = m * bf2f(pr[P_R + c]); rk_[q] = m * bf2f(pr[P_K + c]); rv[q] = m * bf2f(pr[P_V + c]); rl[q] = m * bf2f(pr[P_RW + lcol]);
                }
                float rs[8], ks[8], vs[8], lo[8];
#pragma unroll
                for (int i = 0; i < 8; ++i) {
                    const float rc = dir ? rr[8 - i] : rr[i + 1], rp = dir ? rr[7 - i] : rr[i], rn = dir ? rr[9 - i] : rr[i + 2];
                    const float kc = dir ? rk_[8 - i] : rk_[i + 1], kp_ = dir ? rk_[7 - i] : rk_[i], kn = dir ? rk_[9 - i] : rk_[i + 2];
                    const float vc = dir ? rv[8 - i] : rv[i + 1], vp = dir ? rv[7 - i] : rv[i], vn = dir ? rv[9 - i] : rv[i + 2];
                    const float lc = dir ? rl[8 - i] : rl[i + 1], lp = dir ? rl[7 - i] : rl[i], ln = dir ? rl[9 - i] : rl[i + 2];
                    rs[i] = rc + mr0 * (rp - rc) + mr1 * (rn - rc);
                    ks[i] = kc + mk0 * (kp_ - kc) + mk1 * (kn - kc);
                    vs[i] = vc + mv0 * (vp - vc) + mv1 * (vn - vc);
                    lo[i] = lc + ml0 * (lp - lc) + ml1 * (ln - lc);
                }
#pragma unroll
                for (int i = 0; i < 8; ++i) {
                    const float e2 = __expf(2.f * lo[i]); const float th = 1.f - 2.f / (e2 + 1.f);
                    xs[i * 64 + lane] = (unsigned short)f2bf(lane < 32 ? th : lo[i]);
                }
                WAVE_FENCE();
                const bf16x8 Aw = *(const LAS bf16x8*)(xs + (lane & 15) * 64 + (lane >> 4) * 8);
                const bf16x8 Aa = *(const LAS bf16x8*)(xs + (lane & 15) * 64 + 32 + (lane >> 4) * 8);
                f32x4 Dw[4], Da[4];
#pragma unroll
                for (int ct = 0; ct < 4; ++ct) {
                    Dw[ct] = __builtin_amdgcn_mfma_f32_16x16x32_bf16(Aw, Bw[ct], (f32x4){0.f, 0.f, 0.f, 0.f}, 0, 0, 0);
                    Da[ct] = __builtin_amdgcn_mfma_f32_16x16x32_bf16(Aa, Ba[ct], (f32x4){0.f, 0.f, 0.f, 0.f}, 0, 0, 0);
                }
                LAS float* wsf = (LAS float*)xs;
                WAVE_FENCE();
                if (lane < 32) {
#pragma unroll
                    for (int ct = 0; ct < 4; ++ct)
#pragma unroll
                        for (int jj = 0; jj < 4; ++jj) {
                            wsf[((lane >> 4) * 4 + jj) * 64 + ct * 16 + (lane & 15)] = Dw[ct][jj];
                            wsf[(8 + (lane >> 4) * 4 + jj) * 64 + ct * 16 + (lane & 15)] = Da[ct][jj];
                        }
                }
                WAVE_FENCE();
                const int pb = chunk & 1;
                float lamr = 0.f;
#pragma unroll
                for (int i = 0; i < 8; ++i) {
                    const int sl = sub * 8 + i;
                    const float wpre = w0c + wsf[i * 64 + lane], apre = a0c + wsf[(8 + i) * 64 + lane];
                    const float w = -__logf(1.f + __expf(-wpre)) - 0.5f;
                    const float ew = __expf(w);
                    const float a = sigmoidf_(apre);
                    float kk = ks[i] * kkc; const float n2 = wave_sum(kk * kk); kk = kk / fmaxf(sqrtf(n2), 1e-12f);
                    const float kd = ks[i] * (1.f + (a - 1.f) * kac);
                    const float Lprev = __expf(-lamr); lamr += ew; const float Lcur = __expf(-lamr), Linv = __expf(lamr);
                    LAS float* o = ring + (size_t)((((pb * 2 + dir) * CT) + sl) * 5) * 64;
                    o[0 * 64 + lane] = -kk * Lprev; o[1 * 64 + lane] = kk * a * Linv; o[2 * 64 + lane] = kd * Linv; o[3 * 64 + lane] = rs[i] * Lcur; o[4 * 64 + lane] = vs[i];
                }
                lam[((pb * 2 + dir) * 2 + sub) * 64 + lane] = __expf(-lamr);
                if (chunk + 1 < NCH) {
                    const int s1 = (chunk + 1) * CT + sub * 8; const int tl1 = dir ? SEQL - 8 - s1 : s1;
#pragma unroll
                    for (int q = 0; q < 10; ++q) { int tr = tl1 - 1 + q; tr = tr < 0 ? 0 : (tr >= SEQL ? SEQL - 1 : tr);
                        const bf16_t* pr = proj + ((size_t)b * SEQL + tr) * PS;
                        asm volatile("global_load_ushort %0, %1, off" : "+v"(pfd) : "v"(pr + P_R + c)); asm volatile("global_load_ushort %0, %1, off" : "+v"(pfd) : "v"(pr + P_K + c));
                        asm volatile("global_load_ushort %0, %1, off" : "+v"(pfd) : "v"(pr + P_V + c)); asm volatile("global_load_ushort %0, %1, off" : "+v"(pfd) : "v"(pr + P_RW + lcol)); }
                }
            }
            __syncthreads();
        }
        asm volatile("s_waitcnt vmcnt(0)" : "+v"(pfd) :: "memory");
    }
}


#define HG_ISSUE(BUF, bk) do { \
    DSR128(BUF[0], bk, 0); DSR128(BUF[1], bk, 16); DSR128(BUF[2], bk, 32); DSR128(BUF[3], bk, 48); DSR128(BUF[4], bk, 64); DSR128(BUF[5], bk, 80); DSR128(BUF[6], bk, 96); DSR128(BUF[7], bk, 112); \
    DSR128(BUF[8], bk, 256); DSR128(BUF[9], bk, 272); DSR128(BUF[10], bk, 288); DSR128(BUF[11], bk, 304); DSR128(BUF[12], bk, 320); DSR128(BUF[13], bk, 336); DSR128(BUF[14], bk, 352); DSR128(BUF[15], bk, 368); } while (0)
#define HG_COMPUTE(BUF) do { f32x4 oacc = (f32x4){0.f, 0.f, 0.f, 0.f}; \
    _Pragma("unroll") for (int i_ = 0; i_ < 8; ++i_) { f32x4 sv = S4[i_] + BUF[i_] * iv; S4[i_] = sv; oacc += sv * BUF[8 + i_]; } \
    oval = xsum32((oacc.x + oacc.y) + (oacc.z + oacc.w)); } while (0)

__device__ __forceinline__ void hgrn_scan_wg(const Params& p, int l, int grp, LAS unsigned char* lds) {
    const int tid = opaque_tid(), wave = tid >> 6, lane = tid & 63;
    constexpr int HTC = 16, NCH = SEQL / HTC;
    LAS float* ring = (LAS float*)lds;
    LAS float* lam = (LAS float*)(lds + 73728);
    LAS float* lbt = (LAS float*)(lds + 76800);
    bf16_t* proj = (bf16_t*)(p.ws + OFF_PROJ);
    for (int i = tid; i < 2 * RW; i += 512) { const int dr = i / RW, cc = i % RW; const float* lg = p.in[4] + (size_t)dr * 5 * RW + cc;
        float e[5], mx = -1e30f;
#pragma unroll
        for (int j = 0; j < 5; ++j) { e[j] = lg[j * RW]; mx = fmaxf(mx, e[j]); }
        float sum = 0.f, cum = 0.f;
#pragma unroll
        for (int j = 0; j < 5; ++j) { e[j] = __expf(e[j] - mx); sum += e[j]; if (j <= l) cum += e[j]; }
        lbt[i] = cum / sum; }
    __syncthreads();
    if (wave < 6) {
        const int j = wave >> 1, half = wave & 1, kp = lane >> 5, col = half * 32 + (lane & 31);
        const int cch = grp * 3 + j;
        const int cdir = cch & 1, cb = (cch >> 1) / 6, chh = (cch >> 1) % 6;
        bf16_t* orow = proj + (size_t)cb * SEQL * PS + (cdir ? P_FB : P_FF) + chh * 64 + col;
        f32x4 S4[8];
#pragma unroll
        for (int k = 0; k < 8; ++k) S4[k] = (f32x4){0.f, 0.f, 0.f, 0.f};
        f32x4 A[16], B[16]; float iv = 0.f, ivn = 0.f, oval = 0.f;
        const unsigned ring_addr = (unsigned)(unsigned long long)ring, lam_base = (unsigned)(unsigned long long)lam;
        __syncthreads();
        for (int chunk = 0; chunk < NCH; ++chunk) {
            const unsigned cbase = ring_addr + (unsigned)((((chunk & 1) * 3 + j) * HTC) * 768);
            const unsigned offk = cbase + kp * 128, offv = cbase + col * 4;
            const unsigned lam_addr = lam_base + (unsigned)((((chunk & 1) * 3 + j) * 2) * 256) + kp * 128;
            HG_ISSUE(A, offk); DSR32(ivn, offv, 512);
#pragma unroll 1
            for (int sub = 0; sub < 2; ++sub) {
#pragma unroll 1
                for (int it = 0; it < 4; ++it) {
                    const int sl = sub * 8 + it * 2;
                    const unsigned bk1 = offk + (sl + 1) * 768, bv1 = offv + (sl + 1) * 768, bk2 = bk1 + 768, bv2 = bv1 + 768;
                    const int s = chunk * HTC + sl;
                    LGKM0(); iv = ivn; HG_ISSUE(B, bk1); DSR32(ivn, bv1, 512); SCHEDB; HG_COMPUTE(A); SCHEDB;
                    if (kp == 0) { const int t = cdir ? SEQL - 1 - s : s; orow[(size_t)t * PS] = (bf16_t)f2bf(oval); }
                    LGKM0(); iv = ivn; HG_ISSUE(A, bk2); DSR32(ivn, bv2, 512); SCHEDB; HG_COMPUTE(B); SCHEDB;
                    if (kp == 0) { const int t = cdir ? SEQL - 2 - s : s + 1; orow[(size_t)t * PS] = (bf16_t)f2bf(oval); }
                }
                {   f32x4 L[8]; const unsigned la = lam_addr + sub * 256;
                    DSR128(L[0], la, 0); DSR128(L[1], la, 16); DSR128(L[2], la, 32); DSR128(L[3], la, 48); DSR128(L[4], la, 64); DSR128(L[5], la, 80); DSR128(L[6], la, 96); DSR128(L[7], la, 112);
                    LGKM0();
#pragma unroll
                    for (int i_ = 0; i_ < 8; ++i_) S4[i_] *= L[i_];
                    SCHEDB; }
            }
            LGKM0();
            __syncthreads();
        }
    } else {
        const int pw = wave - 6;
        unsigned pfd = 0u;
        for (int chunk = 0; chunk <= NCH; ++chunk) {
            if (chunk < NCH) {
                asm volatile("s_waitcnt vmcnt(0)" : "+v"(pfd) :: "memory");
                float qv[24], fv[24], ivv[24];
#pragma unroll
                for (int uu = 0; uu < 3; ++uu) {
                    const int u = pw * 3 + uu, j = u >> 1, hh = u & 1;
                    const int ch = grp * 3 + j, dir = ch & 1, b = (ch >> 1) / 6, h = (ch >> 1) % 6;
                    const bf16_t* prow = proj + (size_t)b * SEQL * PS + h * 64 + lane;
#pragma unroll
                    for (int i = 0; i < 8; ++i) {
                        const int s = chunk * HTC + hh * 8 + i, t = dir ? SEQL - 1 - s : s;
                        const bf16_t* pr = prow + (size_t)t * PS;
                        qv[uu * 8 + i] = bf2f(pr[P_Q]); fv[uu * 8 + i] = bf2f(pr[dir ? P_FB : P_FF]); ivv[uu * 8 + i] = bf2f(pr[P_I]);
                    }
                }
#pragma unroll
                for (int uu = 0; uu < 3; ++uu) {
                    const int u = pw * 3 + uu, j = u >> 1, hh = u & 1;
                    const int ch = grp * 3 + j, dir = ch & 1, h = (ch >> 1) % 6;
                    const float lb = lbt[dir * RW + h * 64 + lane];
                    float Lc = 1.f;
#pragma unroll
                    for (int i = 0; i < 8; ++i) {
                        const int sl = hh * 8 + i;
                        const float f = lb + (1.f - lb) * sigmoidf_(fv[uu * 8 + i]);
                        Lc *= f;
                        LAS float* o = ring + (size_t)(((((chunk & 1) * 3 + j) * HTC) + sl) * 3) * 64;
                        o[lane] = (1.f - f) / Lc; o[64 + lane] = qv[uu * 8 + i] * Lc; o[128 + lane] = ivv[uu * 8 + i];
                    }
                    lam[(((chunk & 1) * 3 + j) * 2 + hh) * 64 + lane] = Lc;
                }
                if (chunk + 1 < NCH) {
#pragma unroll
                    for (int uu = 0; uu < 3; ++uu) {
                        const int u = pw * 3 + uu, j = u >> 1, hh = u & 1;
                        const int ch = grp * 3 + j, dir = ch & 1, b = (ch >> 1) / 6, h = (ch >> 1) % 6;
                        const bf16_t* prow = proj + (size_t)b * SEQL * PS + h * 64 + lane;
#pragma unroll
                        for (int i = 0; i < 8; ++i) {
                            const int s = (chunk + 1) * HTC + hh * 8 + i, t = dir ? SEQL - 1 - s : s;
                            const bf16_t* pr = prow + (size_t)t * PS;
                            asm volatile("global_load_ushort %0, %1, off" : "+v"(pfd) : "v"(pr + P_Q)); asm volatile("global_load_ushort %0, %1, off" : "+v"(pfd) : "v"(pr + (dir ? P_FB : P_FF)));
                            asm volatile("global_load_ushort %0, %1, off" : "+v"(pfd) : "v"(pr + P_I));
                        }
                    }
                }
            }
            __syncthreads();
        }
        asm volatile("s_waitcnt vmcnt(0)" : "+v"(pfd) :: "memory");
    }
}

__device__ __forceinline__ void conv_wg(const Params& p, int l, int first, int stride, LAS unsigned char* lds) {
    const int tid = opaque_tid(), wave = tid >> 6, lane = tid & 63;
    LAS float* z = (LAS float*)lds;
    LAS float* ot = (LAS float*)(lds + 62 * 256 * 4);
    bf16_t* proj = (bf16_t*)(p.ws + OFF_PROJ);
    const int ch = tid & 255, half = tid >> 8;
    float w[31];
#pragma unroll
    for (int j = 0; j < 31; ++j) w[j] = p.in[18][(size_t)(l * 31 + j) * 256 + ch];
    const float cb = p.in[19][l * 256 + ch];
    const f32x4 lg = ((const f32x4*)(p.in[20] + l * 256))[lane], lbv = ((const f32x4*)(p.in[21] + l * 256))[lane];
    for (int tile = first; tile < MROWS / 32; tile += stride) {
        const int row0 = tile * 32, b = row0 / SEQL, t0 = row0 % SEQL;
        {
            float zv[31], zg[31];
#pragma unroll
            for (int i = 0; i < 31; ++i) { const int r = half + 2 * i, t = t0 - 15 + r; const bool ok = (t >= 0) && (t < SEQL);
                const bf16_t* pr = proj + ((size_t)b * SEQL + (ok ? t : 0)) * PS; zv[i] = ok ? bf2f(pr[P_CV + ch]) : 0.f; zg[i] = bf2f(pr[P_CG + ch]); }
#pragma unroll
            for (int i = 0; i < 31; ++i) z[(half + 2 * i) * 256 + ch] = zv[i] * sigmoidf_(zg[i]);
        }
        __syncthreads();
        {
            float zw[46];
#pragma unroll
            for (int i = 0; i < 46; ++i) zw[i] = z[(half * 16 + i) * 256 + ch];
#pragma unroll
            for (int tt = 0; tt < 16; ++tt) { float acc = cb;
#pragma unroll
                for (int j = 0; j < 31; ++j) acc += w[j] * zw[tt + j];
                ot[(half * 16 + tt) * 256 + ch] = acc; }
        }
        __syncthreads();
#pragma unroll
        for (int q = 0; q < 4; ++q) { const int tok = wave * 4 + q;
            f32x4 v = *(const LAS f32x4*)(ot + tok * 256 + lane * 4);
            const float mean = wave_sum((v.x + v.y) + (v.z + v.w)) * (1.f / 256.f);
            v = v - mean;
            const float var = wave_sum((v.x * v.x + v.y * v.y) + (v.z * v.z + v.w * v.w)) * (1.f / 256.f);
            const float rstd = rsqrtf(var + LN_EPS);
            f32x4 y = v * rstd * lg + lbv;
            y.x = y.x * sigmoidf_(y.x); y.y = y.y * sigmoidf_(y.y); y.z = y.z * sigmoidf_(y.z); y.w = y.w * sigmoidf_(y.w);
            u32x2 wv; wv.x = pk2(y.x, y.y); wv.y = pk2(y.z, y.w);
            *(u32x2*)(proj + (size_t)(row0 + tok) * PS + P_YC + lane * 4) = wv; }
        __syncthreads();
    }
}

__device__ __forceinline__ void combine_phase(const Params& p, int l, int widx, int nw, LAS unsigned char* lds) {
    const int tid = opaque_tid(), lane = tid & 63;
    bf16_t* proj = (bf16_t*)(p.ws + OFF_PROJ);
    const bf16_t* o_r = (const bf16_t*)(p.ws + OFF_T);
    LAS unsigned* WA = (LAS unsigned*)lds;
    LAS unsigned* WG = (LAS unsigned*)(lds + 49152);
    {
        const float* aup = p.in[11] + (size_t)(l * 2 * 32) * RW; const float* gup = p.in[12] + (size_t)(l * 64) * RW;
        for (int i = tid; i < 2 * 32 * 3 * 64; i += 512) { const int ln = i & 63, hp = (i >> 6) % 3, dr = i / 192; const float* s = aup + (size_t)dr * RW + (2 * hp) * 64 + ln; WA[i] = pk2(s[0], s[64]); }
        for (int i = tid; i < 64 * 3 * 64; i += 512) { const int ln = i & 63, hp = (i >> 6) % 3, r = i / 192; const float* s = gup + (size_t)r * RW + (2 * hp) * 64 + ln; WG[i] = pk2(s[0], s[64]); }
    }
    __syncthreads();
    const float* mu0 = p.in[7] + (size_t)(l * 2 + 0) * NRW; const float* mu1 = mu0 + NRW;
    const float mad0 = mu0[1216 + lane], mad1 = mu1[1216 + lane], mgd0 = mu0[1280 + lane], mgd1 = mu1[1280 + lane];
    for (int g4 = widx; g4 < MROWS / 2; g4 += nw) {
        const int row0 = g4 * 2;
        float adv[2], sgv[2];
#pragma unroll
        for (int tt = 0; tt < 2; ++tt) { const int row = row0 + tt, t = row % SEQL; const bf16_t* pr = proj + (size_t)row * PS;
            const bool hp = t > 0, hn = t < SEQL - 1; const bf16_t* pp = hp ? pr - PS : pr; const bf16_t* pn = hn ? pr + PS : pr; const float fp = hp ? 1.f : 0.f, fn = hn ? 1.f : 0.f;
            const float ac = bf2f(pr[P_AD + lane]), ap = fp * bf2f(pp[P_AD + lane]), an = fn * bf2f(pn[P_AD + lane]);
            const float gc = bf2f(pr[P_GD + lane]), gp = fp * bf2f(pp[P_GD + lane]), gn = fn * bf2f(pn[P_GD + lane]);
            adv[tt] = ac + mad0 * (ap - ac) + mad1 * (an - ac);
            sgv[tt] = sigmoidf_(gc + mgd0 * (gp - gc) + mgd1 * (gn - gc)); }
        float A0[2][6], A1[2][6], G[2][6];
#pragma unroll
        for (int tt = 0; tt < 2; ++tt)
#pragma unroll
            for (int h = 0; h < 6; ++h) { A0[tt][h] = 0.f; A1[tt][h] = 0.f; G[tt][h] = 0.f; }
#pragma unroll 4
        for (int r = 0; r < 32; ++r) {
            float w0[6], w1[6];
#pragma unroll
            for (int hp = 0; hp < 3; ++hp) { const unsigned u0 = WA[(r * 3 + hp) * 64 + lane], u1 = WA[((32 + r) * 3 + hp) * 64 + lane];
                w0[2 * hp] = __uint_as_float(u0 << 16); w0[2 * hp + 1] = __uint_as_float(u0 & 0xffff0000u); w1[2 * hp] = __uint_as_float(u1 << 16); w1[2 * hp + 1] = __uint_as_float(u1 & 0xffff0000u); }
#pragma unroll
            for (int tt = 0; tt < 2; ++tt) { const float s0 = rdlane(adv[tt], r), s1 = rdlane(adv[tt], 32 + r);
#pragma unroll
                for (int h = 0; h < 6; ++h) { A0[tt][h] += s0 * w0[h]; A1[tt][h] += s1 * w1[h]; } }
        }
#pragma unroll 4
        for (int r = 0; r < 64; ++r) {
            float wg[6];
#pragma unroll
            for (int hp = 0; hp < 3; ++hp) { const unsigned u = WG[(r * 3 + hp) * 64 + lane]; wg[2 * hp] = __uint_as_float(u << 16); wg[2 * hp + 1] = __uint_as_float(u & 0xffff0000u); }
#pragma unroll
            for (int tt = 0; tt < 2; ++tt) { const float s = rdlane(sgv[tt], r);
#pragma unroll
                for (int h = 0; h < 6; ++h) G[tt][h] += s * wg[h]; }
        }
#pragma unroll
        for (int h = 0; h < 6; ++h) {
            const int c = h * 64 + lane;
            const float a00 = p.in[10][(l * 2 + 0) * RW + c], a01 = p.in[10][(l * 2 + 1) * RW + c], kac = p.in[14][l * RW + c];
            const float rk = p.in[15][(l * 6 + h) * 64 + lane], gng = p.in[16][l * RW + c], gnb = p.in[17][l * RW + c], ng = p.in[6][l * RW + c];
            const float mr0 = mu0[c], mr1 = mu1[c], mk0 = mu0[384 + c], mk1 = mu1[384 + c], mv0 = mu0[768 + c], mv1 = mu1[768 + c];
#pragma unroll
            for (int tt = 0; tt < 2; ++tt) { const int row = row0 + tt, t = row % SEQL; bf16_t* pr = proj + (size_t)row * PS;
                const bool hp = t > 0, hn = t < SEQL - 1; const bf16_t* pp = hp ? pr - PS : pr; const bf16_t* pn = hn ? pr + PS : pr; const float fp = hp ? 1.f : 0.f, fn = hn ? 1.f : 0.f;
                const float rc = bf2f(pr[P_R + c]), rp = fp * bf2f(pp[P_R + c]), rn = fn * bf2f(pn[P_R + c]);
                const float kc = bf2f(pr[P_K + c]), kp = fp * bf2f(pp[P_K + c]), kn = fn * bf2f(pn[P_K + c]);
                const float vc = bf2f(pr[P_V + c]), vp = fp * bf2f(pp[P_V + c]), vn = fn * bf2f(pn[P_V + c]);
                const float rs = rc + mr0 * (rp - rc) + mr1 * (rn - rc);
                const float ks = kc + mk0 * (kp - kc) + mk1 * (kn - kc);
                const float vs = vc + mv0 * (vp - vc) + mv1 * (vn - vc);
                const float a0 = sigmoidf_(a00 + A0[tt][h]), a1 = sigmoidf_(a01 + A1[tt][h]);
                const float kh = ks * (1.f + (0.5f * (a0 + a1) - 1.f) * kac);
                const float bsum = wave_sum(rs * kh * rk);
                const float o = bf2f(o_r[(size_t)row * RW + c]) + bf2f(o_r[((size_t)MROWS + row) * RW + c]);
                const float mean = wave_sum(o) * (1.f / 64.f); const float dlt = o - mean;
                const float var = wave_sum(dlt * dlt) * (1.f / 64.f);
                const float on = dlt * rsqrtf(var + GN_EPS) * gng + gnb;
                const float yr = (on + bsum * vs) * G[tt][h];
                const float oh = bf2f(pr[P_FF + c]) + bf2f(pr[P_FB + c]);
                const float ms = wave_sum(oh * oh) * (1.f / 64.f);
                const float gh = bf2f(pr[P_G + c]);
                const float yh = oh * rsqrtf(ms + RMS_EPS) * ng * (gh * sigmoidf_(gh));
                pr[P_I + c] = (bf16_t)f2bf(yr);
                pr[P_Q + c] = (bf16_t)f2bf(yh);
            }
        }
    }
}

__global__ void __launch_bounds__(512, 2) fwd_mega(Params p) {
    extern __shared__ __attribute__((aligned(16))) unsigned char smem_raw[];
    LAS unsigned char* lds = (LAS unsigned char*)smem_raw;
    cg::grid_group grid = cg::this_grid();
    const int tid = threadIdx.x, wave = tid >> 6, lane = tid & 63;
    const int G = gridDim.x, bid = blockIdx.x;
    const int widx = bid * 8 + wave, nw = G * 8;
    bf16_t* win_t = (bf16_t*)(p.ws + OFF_WIN); bf16_t* wout_t = (bf16_t*)(p.ws + OFF_WOUT); bf16_t* wup_t = (bf16_t*)(p.ws + OFF_WUP); bf16_t* wdn_t = (bf16_t*)(p.ws + OFF_WDN);
    bf16_t* proj = (bf16_t*)(p.ws + OFF_PROJ); bf16_t* xb = (bf16_t*)(p.ws + OFF_T); bf16_t* hid = proj;
    float* x = p.out;
    volatile LAS unsigned* xst = (volatile LAS unsigned*)(lds + 131072);
    if (tid == 0) { xst[0] = 0u; xst[1] = 0u; xst[2] = 0u; xst[3] = 0u; }
    __syncthreads();
    XcdBarrier xbar = xcd_barrier_post((unsigned*)(p.ws + OFF_BAR), xst);

    convert_weights(p, 0, lds, widx, nw);
    for (int row = widx; row < MROWS; row += nw) {
        const float* src = row < 16 * SEQL ? p.in[0] + (size_t)row * D : p.in[1] + (size_t)(row - 16 * SEQL) * D;
        ln_row(src, x + (size_t)row * D, xb + (size_t)row * D, p.in[2], p.in[3], lane);
    }
    grid.sync();
    for (int l = 0; l < DEPTH; ++l) {
        {
            pg8::Gemm g{xb, win_t, MROWS, NINP, D, D}; pg8::StaticOrder S; S.init(MROWS, NINP, G, bid);
            pg8::EpiBf16<0> E{proj + 256, PS};
            for (int rep = 0; rep < REP_GIN; ++rep) pg8::gemm_phase(lds, g, S, E);
        }
        GSYNC();
        for (int rep = 0; rep < REP_SCAN; ++rep) {
            if (bid < 144) rwkv_scan_wg(p, l, (bid & 7) * 18 + (bid >> 3), lds);
            else if (bid < 240) { if (rep == 0) hgrn_scan_wg(p, l, ((bid - 144) & 7) * 12 + ((bid - 144) >> 3), lds); }
            else { }
        }
        GSYNC();
        conv_wg(p, l, bid, G, lds);
        for (int rep = 0; rep < REP_COMB; ++rep) combine_phase(p, l, widx, nw, lds);
        GSYNC();
        {
            pg8::Gemm g{proj, wout_t, MROWS, D, D, PS}; pg8::StaticOrder S; S.init(MROWS, D, G, bid);
            pg8::EpiResid E{x, D, DN_ALPHA};
            pg8::gemm_phase(lds, g, S, E);
        }
        GSYNC();
        for (int row = widx; row < MROWS; row += 2 * nw) {
            const int r1 = row + nw;
            if (r1 < MROWS) ln_row2(x + (size_t)row * D, x + (size_t)r1 * D, x + (size_t)row * D, x + (size_t)r1 * D, xb + (size_t)row * D, xb + (size_t)r1 * D, p.in[23] + l * D, p.in[24] + l * D, lane);
            else ln_row(x + (size_t)row * D, x + (size_t)row * D, xb + (size_t)row * D, p.in[23] + l * D, p.in[24] + l * D, lane); }
        GSYNC();
        for (int third = 0; third < 3; ++third) {
            constexpr int MT = MROWS / 3;
            {   pg8::Gemm g{xb + (size_t)third * MT * D, wup_t, MT, FFN, D, D}; pg8::StaticOrder S; S.init(MT, FFN, G, bid);
                pg8::EpiBf16<1> E{hid, FFN};
                for (int rep = 0; rep < REP_UP; ++rep) pg8::gemm_phase(lds, g, S, E); }
            GSYNC();
            {   pg8::Gemm g{hid, wdn_t, MT, D, FFN, FFN}; pg8::StaticOrder S; S.init(MT, D, G, bid);
                pg8::EpiResid E{x + (size_t)third * MT * D, D, DN_ALPHA};
                pg8::gemm_phase(lds, g, S, E); }
            GSYNC();
        }
        if (l + 1 < DEPTH) convert_weights(p, l + 1, lds, widx, nw);
        for (int row = widx; row < MROWS; row += 2 * nw) {
            const int r1 = row + nw;
            if (r1 < MROWS) ln_row2(x + (size_t)row * D, x + (size_t)r1 * D, x + (size_t)row * D, x + (size_t)r1 * D, xb + (size_t)row * D, xb + (size_t)r1 * D, p.in[27] + l * D, p.in[28] + l * D, lane);
            else ln_row(x + (size_t)row * D, x + (size_t)row * D, xb + (size_t)row * D, p.in[27] + l * D, p.in[28] + l * D, lane); }
        GSYNC();
    }
}

extern "C" void kernel_launch(void* const* d_in, const int* in_sizes, int n_in, void* d_out, int out_size, void* d_ws, size_t ws_size, hipStream_t stream) {
    static int grid = 0;
    if (grid == 0) {
        if (n_in != 29 || out_size != MROWS * D || ws_size < WS_END) { fprintf(stderr, "kernel_launch: unexpected shapes (n_in %d out %d ws %zu need %zu)\n", n_in, out_size, ws_size, (size_t)WS_END); grid = -1; return; }
        int dev = 0, cus = 0, per_cu = 0;
        hipGetDevice(&dev);
        hipDeviceGetAttribute(&cus, hipDeviceAttributeMultiprocessorCount, dev);
        if (hipFuncSetAttribute((const void*)fwd_mega, hipFuncAttributeMaxDynamicSharedMemorySize, LDS_BYTES) != hipSuccess) { fprintf(stderr, "kernel_launch: hipFuncSetAttribute failed\n"); grid = -1; return; }
        hipOccupancyMaxActiveBlocksPerMultiprocessor(&per_cu, (const void*)fwd_mega, 512, LDS_BYTES);
        (void)hipGetLastError();
        if (per_cu < 1) per_cu = 1;
        grid = cus;
        if (grid != 256) fprintf(stderr, "kernel_launch: note: %d CUs\n", grid);
    }
    if (grid < 0) return;
    if (hipMemsetAsync((char*)d_ws + OFF_BAR, 0, SZ_BAR, stream) != hipSuccess) { fprintf(stderr, "kernel_launch: memset failed\n"); return; }
    Params p{};
    for (int i = 0; i < 29; ++i) p.in[i] = (const float*)d_in[i];
    p.out = (float*)d_out; p.ws = (unsigned char*)d_ws;
    void* args[] = {&p};
    hipError_t e = hipLaunchCooperativeKernel((const void*)fwd_mega, dim3(grid), dim3(512), args, LDS_BYTES, stream);
    if (e != hipSuccess) fprintf(stderr, "cooperative launch failed: %s (grid %d)\n", hipGetErrorString(e), grid);
}
```
